# Optimizing an MI355X kernel written in HIP

```python
import math
import jax, jax.numpy as jnp
from jax import lax
import numpy as np

D_MODEL = 2048
BATCH = 4
SEQ = 4096
DEPTH = 2

MIX_WIDTH = D_MODEL
DIFF_V_DIM = 128
DIFF_QK_DIM = 64
N_DIFF_HEADS = (MIX_WIDTH // 2) // DIFF_V_DIM
SB_HEAD_DIM = 128
N_SB_HEADS = (MIX_WIDTH // 2) // SB_HEAD_DIM
DIFF_QK_COLS = N_DIFF_HEADS * 2 * DIFF_QK_DIM
DIFF_V_COLS = N_DIFF_HEADS * DIFF_V_DIM
SB_COLS = N_SB_HEADS * SB_HEAD_DIM
IN_COLS = 2 * DIFF_QK_COLS + DIFF_V_COLS + 3 * SB_COLS
Q_BLOCK = 128
NUM_BUCKETS = 32
MAX_DISTANCE = 128
N_GROUPS = 4
EXPERTS_PER_GROUP = 8
N_EXPERTS = N_GROUPS * EXPERTS_PER_GROUP
TOP_K = 2
D_EXPERT = D_MODEL // 2
MOE_BLOCK = 128
LN_EPS = 1e-5
SUBLN_EPS = 1e-5
ADA_SCALE = 0.1
DEEPNORM_ALPHA = (2 * DEPTH) ** 0.25
DEEPNORM_BETA = (8 * DEPTH) ** -0.25

kernel_name = "hymba_diff_stickbreak_hmoe_deepnorm"


def layer_norm(h, g, b):
    hf = h.astype(jnp.float32)
    mu = jnp.mean(hf, axis=-1, keepdims=True)
    var = jnp.mean(jnp.square(hf - mu), axis=-1, keepdims=True)
    out = (hf - mu) * lax.rsqrt(var + LN_EPS) * g.astype(jnp.float32) + b.astype(jnp.float32)
    return out.astype(h.dtype)


def t5_bucket(rel):
    n = jnp.maximum(rel, 0)
    max_exact = NUM_BUCKETS // 2
    large = max_exact + (jnp.log(jnp.maximum(n, 1).astype(jnp.float32) / max_exact)
                         / math.log(MAX_DISTANCE / max_exact) * (NUM_BUCKETS - max_exact)).astype(jnp.int32)
    large = jnp.minimum(large, NUM_BUCKETS - 1)
    return jnp.where(n < max_exact, n, large)


def diff_attention(q, k, v, bias_table, lam, lam_init, subln_g):
    B, S, H, _, DQK = q.shape
    nqb = S // Q_BLOCK
    scale = DQK ** -0.5
    kpos = jnp.arange(S)
    qb = q.reshape(B, nqb, Q_BLOCK, H, 2, DQK).transpose(1, 0, 2, 3, 4, 5)

    def block(args):
        qi, bi = args
        qpos = bi * Q_BLOCK + jnp.arange(Q_BLOCK)
        logits = jnp.einsum('bqhmd,bkhmd->bmhqk', qi, k).astype(jnp.float32) * scale
        bias = bias_table[t5_bucket(qpos[:, None] - kpos[None, :])]
        logits = logits + jnp.transpose(bias, (3, 2, 0, 1)).astype(jnp.float32)[None]
        causal = kpos[None, :] <= qpos[:, None]
        p = jax.nn.softmax(jnp.where(causal, logits, -jnp.inf), axis=-1)
        a = p[:, 0] - lam * p[:, 1]
        return jnp.einsum('bhqk,bkhd->bqhd', a.astype(v.dtype), v)

    o = lax.map(block, (qb, jnp.arange(nqb)))
    o = o.transpose(1, 0, 2, 3, 4).reshape(B, S, H, -1)
    of = o.astype(jnp.float32)
    of = of * lax.rsqrt(jnp.mean(jnp.square(of), axis=-1, keepdims=True) + SUBLN_EPS)
    of = of * subln_g.astype(jnp.float32) * (1.0 - lam_init)
    return of.astype(v.dtype).reshape(B, S, -1)


def stick_breaking_attention(q, k, v):
    B, S, H, DH = q.shape
    nqb = S // Q_BLOCK
    scale = DH ** -0.5
    kpos = jnp.arange(S)
    qb = q.reshape(B, nqb, Q_BLOCK, H, DH).transpose(1, 0, 2, 3, 4)

    def block(args):
        qi, bi = args
        qpos = bi * Q_BLOCK + jnp.arange(Q_BLOCK)
        z = jnp.einsum('bqhd,bkhd->bhqk', qi, k).astype(jnp.float32) * scale
        strict = kpos[None, :] < qpos[:, None]
        log_keep = jnp.where(strict, jax.nn.log_sigmoid(-z), 0.0)
        suffix = lax.cumsum(log_keep, axis=3, reverse=True) - log_keep
        a = jnp.where(strict, jnp.exp(jax.nn.log_sigmoid(z) + suffix), 0.0)
        return jnp.einsum('bhqk,bkhd->bqhd', a.astype(v.dtype), v)

    o = lax.map(block, (qb, jnp.arange(nqb)))
    return o.transpose(1, 0, 2, 3, 4).reshape(B, S, H * DH)


def hierarchical_moe(u, w_group, b_group, w_router, b_router, w_gate, w_up, w_down):
    B, S, D = u.shape
    M = B * S
    xt = u.reshape(M, D)
    gprob = jax.nn.softmax((xt @ w_group + b_group).astype(jnp.float32), axis=-1)
    gp, gidx = lax.top_k(gprob, 1)
    elog = (xt @ w_router + b_router).astype(jnp.float32).reshape(M, N_GROUPS, EXPERTS_PER_GROUP)
    sel = jnp.take_along_axis(elog, gidx[:, :, None], axis=1)[:, 0]
    ev, eidx = lax.top_k(sel, TOP_K)
    ew = jax.nn.softmax(ev, axis=-1) * gp
    eid = gidx * EXPERTS_PER_GROUP + eidx

    n_assign = M * TOP_K
    e_flat = eid.reshape(-1).astype(jnp.int32)
    w_flat = ew.reshape(-1)
    tok_flat = jnp.repeat(jnp.arange(M, dtype=jnp.int32), TOP_K)
    order = jnp.argsort(e_flat)
    sorted_e = e_flat[order]
    counts = jnp.bincount(e_flat, length=N_EXPERTS)
    starts = jnp.cumsum(counts) - counts
    padded = ((counts + MOE_BLOCK - 1) // MOE_BLOCK) * MOE_BLOCK
    pends = jnp.cumsum(padded)
    pstarts = pends - padded
    dest = pstarts[sorted_e] + (jnp.arange(n_assign, dtype=jnp.int32) - starts[sorted_e])
    n_blocks = (n_assign + N_EXPERTS * (MOE_BLOCK - 1) + MOE_BLOCK - 1) // MOE_BLOCK
    P = n_blocks * MOE_BLOCK
    pad_tok = jnp.zeros((P,), jnp.int32).at[dest].set(tok_flat[order])
    pad_w = jnp.zeros((P,), jnp.float32).at[dest].set(w_flat[order])
    block_e = jnp.minimum(jnp.searchsorted(pends, jnp.arange(n_blocks, dtype=jnp.int32) * MOE_BLOCK,
                                           side='right'), N_EXPERTS - 1)
    xg = xt[pad_tok].reshape(n_blocks, MOE_BLOCK, D)

    def expert_block(args):
        xb, e = args
        h = jax.nn.silu(xb @ w_gate[e]) * (xb @ w_up[e])
        return h @ w_down[e]

    yb = lax.map(expert_block, (xg, block_e)).reshape(P, D)
    y = jnp.zeros((M, D), u.dtype).at[pad_tok].add(yb * pad_w[:, None].astype(u.dtype))
    return y.reshape(B, S, D)


def setup_inputs(seed: int = 0) -> dict:
    key = jax.random.key(seed)
    ks = jax.random.split(key, 18)
    D = D_MODEL
    nrm = jax.random.normal
    beta = DEEPNORM_BETA
    col_scale = jnp.concatenate([
        jnp.ones((2 * DIFF_QK_COLS,)), jnp.full((DIFF_V_COLS,), beta),
        jnp.ones((2 * SB_COLS,)), jnp.full((SB_COLS,), beta)])
    return {
        "x": nrm(ks[0], (BATCH, SEQ, D), jnp.float32),
        "c": nrm(ks[1], (BATCH, D), jnp.float32),
        "w_ada": nrm(ks[2], (DEPTH, D, 6 * D), jnp.float32) * (D ** -0.5) * ADA_SCALE,
        "b_ada": 0.02 * nrm(ks[3], (DEPTH, 6 * D), jnp.float32),
        "w_in": nrm(ks[4], (DEPTH, D, IN_COLS), jnp.float32) * (D ** -0.5) * col_scale,
        "diff_lambda": 0.1 * nrm(ks[5], (DEPTH, 4, DIFF_QK_DIM), jnp.float32),
        "diff_subln_g": 1.0 + 0.02 * nrm(ks[6], (DEPTH, DIFF_V_DIM), jnp.float32),
        "rel_bias": 0.2 * nrm(ks[7], (NUM_BUCKETS, N_DIFF_HEADS, 2), jnp.float32),
        "w_o": nrm(ks[8], (DEPTH, MIX_WIDTH, D), jnp.float32) * (MIX_WIDTH ** -0.5) * beta,
        "ln_g": 1.0 + 0.02 * nrm(ks[9], (DEPTH, 2, D), jnp.float32),
        "ln_b": 0.02 * nrm(ks[10], (DEPTH, 2, D), jnp.float32),
        "w_group": nrm(ks[11], (DEPTH, D, N_GROUPS), jnp.float32) * (D ** -0.5),
        "b_group": 0.01 * nrm(ks[12], (DEPTH, N_GROUPS), jnp.float32),
        "w_router": nrm(ks[13], (DEPTH, D, N_EXPERTS), jnp.float32) * (D ** -0.5),
        "b_router": 0.01 * nrm(ks[14], (DEPTH, N_EXPERTS), jnp.float32),
        "w_gate": nrm(ks[15], (DEPTH, N_EXPERTS, D, D_EXPERT), jnp.float32) * (D ** -0.5),
        "w_up": nrm(ks[16], (DEPTH, N_EXPERTS, D, D_EXPERT), jnp.float32) * (D ** -0.5),
        "w_down": nrm(ks[17], (DEPTH, N_EXPERTS, D_EXPERT, D), jnp.float32) * (D_EXPERT ** -0.5) * beta,
    }


def reference(x, c, w_ada, b_ada, w_in, diff_lambda, diff_subln_g, rel_bias, w_o, ln_g, ln_b,
              w_group, b_group, w_router, b_router, w_gate, w_up, w_down):
    B, S, D = x.shape
    splits = [DIFF_QK_COLS, 2 * DIFF_QK_COLS, 2 * DIFF_QK_COLS + DIFF_V_COLS,
              2 * DIFF_QK_COLS + DIFF_V_COLS + SB_COLS, 2 * DIFF_QK_COLS + DIFF_V_COLS + 2 * SB_COLS]
    for l in range(DEPTH):
        mod = jax.nn.silu(c) @ w_ada[l] + b_ada[l]
        sh1, sc1, g1, sh2, sc2, g2 = jnp.split(mod[:, None, :], 6, axis=-1)

        u = x * (1.0 + sc1) + sh1
        proj = u @ w_in[l]
        dq, dk, dv, sq, sk, sv = jnp.split(proj, splits, axis=-1)
        lam_init = 0.8 - 0.6 * math.exp(-0.3 * l)
        lam_p = diff_lambda[l].astype(jnp.float32)
        lam = jnp.exp(jnp.sum(lam_p[0] * lam_p[1])) - jnp.exp(jnp.sum(lam_p[2] * lam_p[3])) + lam_init
        a_out = diff_attention(
            dq.reshape(B, S, N_DIFF_HEADS, 2, DIFF_QK_DIM),
            dk.reshape(B, S, N_DIFF_HEADS, 2, DIFF_QK_DIM),
            dv.reshape(B, S, N_DIFF_HEADS, DIFF_V_DIM),
            rel_bias, lam, lam_init, diff_subln_g[l])
        b_out = stick_breaking_attention(
            sq.reshape(B, S, N_SB_HEADS, SB_HEAD_DIM),
            sk.reshape(B, S, N_SB_HEADS, SB_HEAD_DIM),
            sv.reshape(B, S, N_SB_HEADS, SB_HEAD_DIM))
        mix = jnp.concatenate([a_out, b_out], axis=-1) @ w_o[l]
        x = layer_norm(DEEPNORM_ALPHA * x + (1.0 + g1) * mix, ln_g[l, 0], ln_b[l, 0])

        u2 = x * (1.0 + sc2) + sh2
        y = hierarchical_moe(u2, w_group[l], b_group[l], w_router[l], b_router[l],
                             w_gate[l], w_up[l], w_down[l])
        x = layer_norm(DEEPNORM_ALPHA * x + (1.0 + g2) * y, ln_g[l, 1], ln_b[l, 1])
    return x
```

```cpp
#include <hip/hip_runtime.h>
#include <hip/hip_bf16.h>
#include <cstdio>
#include <cstdint>
#include <cmath>
#include <cstring>
#define MK_BGCONV 2
#define MK_BGMASK 1
#define MK_F32B_DOWN 1
#define MK_BF16RES 1
#define MK_BGSPREAD 1
#define XB_TMO      128
#define XB_XCNT(j)  (256  + 64 * (j))
#define XB_XSUB(j)  (1280 + 64 * (j))
#define XB_XGEN(j)  (2304 + 64 * (j))
#define XB_TOP      3328
#define XB_TOPGEN   3392
#define XCD_BAR_WORDS 3456
#define XB_SPIN_CAP (1u << 22)
#define LAS __attribute__((address_space(3)))

__device__ __forceinline__ unsigned xb_ld(unsigned* p)              { return __hip_atomic_load(p, __ATOMIC_RELAXED, __HIP_MEMORY_SCOPE_AGENT); }
__device__ __forceinline__ unsigned xb_add(unsigned* p, unsigned v) { return __hip_atomic_fetch_add(p, v, __ATOMIC_RELAXED, __HIP_MEMORY_SCOPE_AGENT); }
__device__ __forceinline__ unsigned xb_xcc_id() { return (unsigned)__builtin_amdgcn_s_getreg((3 << 11) | 20) & 0xFu; }
#define XB_SPIN(cond, bar) do { unsigned _sp = 0; while (cond) { __builtin_amdgcn_s_sleep(1); \
    if ((++_sp & 255u) == 0u) { if (xb_ld(&(bar)[XB_TMO])) break; if (_sp > XB_SPIN_CAP) { atomicAdd(&(bar)[XB_TMO], 1u); break; } } } } while (0)

struct XcdBarrier {
    unsigned* bar; unsigned x;
    volatile LAS unsigned* st;
};

__device__ __forceinline__ XcdBarrier xcd_barrier_post(unsigned* bar, volatile LAS unsigned* st) {
    XcdBarrier b; b.bar = bar; b.x = xb_xcc_id(); b.st = st;
    if (threadIdx.x == 0) (void)xb_add(&bar[XB_XCNT(b.x)], 1u);
    return b;
}
__device__ __forceinline__ void xcd_barrier_complete(unsigned* bar, unsigned x, unsigned& nloc, unsigned& nx) {
    const unsigned G = gridDim.x * gridDim.y * gridDim.z;
    unsigned sum, cnt, mine, sp = 0u;
    for (;;) {
        sum = 0u; cnt = 0u; mine = 0u;
#pragma unroll
        for (unsigned j = 0; j < 16; ++j) { const unsigned c = xb_ld(&bar[XB_XCNT(j)]); sum += c; cnt += (c > 0u) ? 1u : 0u; mine = (j == x) ? c : mine; }
        if (sum == G) break;
        __builtin_amdgcn_s_sleep(1);
        if ((++sp & 255u) == 0u) { if (xb_ld(&bar[XB_TMO])) break; if (sp > XB_SPIN_CAP) { atomicAdd(&bar[XB_TMO], 1u); break; } }
    }
    nloc = mine > 0u ? mine : 1u; nx = cnt > 0u ? cnt : 1u;
}

__device__ __forceinline__ void xcd_barrier(const XcdBarrier& b) {
    asm volatile("s_waitcnt vmcnt(0)" ::: "memory");
    __syncthreads();
    if (threadIdx.x == 0) {
        unsigned* bar = b.bar;
        __builtin_amdgcn_s_waitcnt(0);
        unsigned nloc = b.st[0], nx = b.st[1];
        if (nloc == 0u) { xcd_barrier_complete(bar, b.x, nloc, nx); b.st[0] = nloc; b.st[1] = nx; }
        const unsigned old = xb_add(&bar[XB_XSUB(b.x)], 1u);
        const unsigned gen = old / nloc;
        if (old + 1u == (gen + 1u) * nloc) {
            __builtin_amdgcn_fence(__ATOMIC_RELEASE, "agent");
            asm volatile("s_waitcnt vmcnt(0)" ::: "memory");
            const unsigned og = xb_add(&bar[XB_TOP], 1u);
            const unsigned tg = og / nx;
            if (og + 1u == (tg + 1u) * nx) xb_add(&bar[XB_TOPGEN], 1u);
            else XB_SPIN(xb_ld(&bar[XB_TOPGEN]) == tg, bar);
            __builtin_amdgcn_fence(__ATOMIC_ACQUIRE, "agent");
            xb_add(&bar[XB_XGEN(b.x)], 1u);
            asm volatile("s_waitcnt vmcnt(0)" ::: "memory");
        } else {
            XB_SPIN(xb_ld(&bar[XB_XGEN(b.x)]) == gen, bar);
            __builtin_amdgcn_fence(__ATOMIC_ACQUIRE, "agent");
            asm volatile("s_waitcnt vmcnt(0)" ::: "memory");
        }
    }
    __syncthreads();
}

namespace mk {
#define MK_LAS __attribute__((address_space(3)))
typedef unsigned short bf16_t;
typedef short bf16x8 __attribute__((ext_vector_type(8)));
typedef short s16x4 __attribute__((ext_vector_type(4)));
typedef float f32x2 __attribute__((ext_vector_type(2)));
typedef float f32x4 __attribute__((ext_vector_type(4)));
typedef float f32x16 __attribute__((ext_vector_type(16)));
typedef unsigned u32x2 __attribute__((ext_vector_type(2)));
typedef unsigned u32x4 __attribute__((ext_vector_type(4)));

constexpr int D = 2048, NB = 4, S = 4096, M = NB * S, INC = 6144, NE = 32, DE = 1024, NH = 8, DEPTH = 2;
constexpr int NWAVES = 8, NTHR = 512;
constexpr float LOG2E = 1.4426950408889634f;
constexpr float LN_EPS = 1e-5f, SUBLN_EPS = 1e-5f;
constexpr float ALPHA = 1.4142135623730951f;
constexpr int PMAXP = 161;
constexpr int PROWS = PMAXP * 256;
constexpr int MAXU = 8;

__device__ __forceinline__ unsigned cvt_pk_bf16(float lo, float hi) { unsigned r; asm volatile("v_cvt_pk_bf16_f32 %0, %1, %2" : "=v"(r) : "v"(lo), "v"(hi)); return r; }
typedef __bf16 bf16v2 __attribute__((ext_vector_type(2)));
__device__ __forceinline__ unsigned cvt_pk_bf16_c(float lo, float hi) { const f32x2 v = {lo, hi}; return __builtin_bit_cast(unsigned, __builtin_convertvector(v, bf16v2)); }
__device__ __forceinline__ float bf16_lo(unsigned w) { return __uint_as_float(w << 16); }
__device__ __forceinline__ float bf16_hi(unsigned w) { return __uint_as_float(w & 0xffff0000u); }
__device__ __forceinline__ float wave_sum(float v) {
#pragma unroll
    for (int o = 1; o < 64; o <<= 1) v += __shfl_xor(v, o);
    return v;
}
__device__ __forceinline__ int ltid() { int t = threadIdx.x; asm volatile("" : "+v"(t)); return t; }
__device__ __forceinline__ int crow(int r, int hi) { return (r & 3) + 8 * (r >> 2) + 4 * hi; }

constexpr int BM = 256, BK = 64, HALF = 128, HTB = HALF * BK * 2, STAGE_BYTES = 8 * HTB, NXCD = 8, WGM = 8;
__host__ __device__ __forceinline__ int lds_byte(int r, int c) { const int st = (r >> 4) * 2 + (c >> 5), rr = r & 15, cc = c & 31, ob = rr * 64 + cc * 2; return st * 1024 + (ob ^ (((ob >> 9) & 1) << 5)); }
__host__ __device__ __forceinline__ void stage_rc(int b, int& R, int& C) { const int st = b / 1024, sb = b % 1024, swz = sb ^ (((sb >> 9) & 1) << 5); R = (st >> 1) * 16 + swz / 64; C = (st & 1) * 32 + (swz % 64) / 2; }
__host__ __device__ __forceinline__ int perm32(int rho) { const int n = rho >> 4, i = rho & 15; return 8 * (i >> 2) + 4 * n + (i & 3); }

struct Unit { int pm, pn, e; };

struct SchedDense {
    static constexpr bool GATHER = false;
    const bf16_t* A; const bf16_t* Bt; int K;
    int nM, nN, nwg, G, c;
    __device__ void init(const bf16_t* A_, const bf16_t* Bt_, int Mr, int N, int K_, int G_, int c_) { A = A_; Bt = Bt_; K = K_; nM = Mr / BM; nN = N / BM; nwg = nM * nN; G = G_; c = c_; }
    __device__ __forceinline__ bool next(int i, Unit& u) const {
        const long L = (long)i * G + c; if (L >= nwg) return false;
        int wgid = (int)L; { const int q = nwg / NXCD, r = nwg % NXCD, xcd = wgid % NXCD, off = wgid / NXCD; wgid = (xcd < r ? xcd * (q + 1) : r * (q + 1) + (xcd - r) * q) + off; }
        const int nig = WGM * nN, gid = wgid / nig, fm = gid * WGM, gsz = (nM - fm) < WGM ? (nM - fm) : WGM;
        u.pm = fm + ((wgid % nig) % gsz); u.pn = (wgid % nig) / gsz; u.e = 0; return true;
    }
    __device__ __forceinline__ const char* a_base(const Unit& u) const { return (const char*)A + (size_t)u.pm * BM * K * 2; }
    __device__ __forceinline__ const char* b_base(const Unit& u) const { return (const char*)Bt + (size_t)u.pn * BM * K * 2; }
    __device__ __forceinline__ void a_voff(int, const Unit&, const int (&R)[2], const int (&C)[2], unsigned (&v0)[2], unsigned (&v1)[2]) const {
#pragma unroll
        for (int j = 0; j < 2; ++j) { v0[j] = (unsigned)(R[j] * K + C[j]) * 2u; v1[j] = v0[j] + (unsigned)(HALF * K * 2); }
    }
};
template <bool GATHER_>
struct SchedMoe {
    static constexpr bool GATHER = GATHER_;
    const bf16_t* A; const bf16_t* Bt; size_t estride; int K;
    int nunits, G, c;
    const MK_LAS int* pexp;
    const MK_LAS int* tokl;
    __device__ __forceinline__ bool next(int i, Unit& u) const {
        const int L = i * G + c; if (L >= nunits || i >= MAXU) return false;
        int wgid = L; { const int q = nunits / NXCD, r = nunits % NXCD, xcd = wgid % NXCD, off = wgid / NXCD; wgid = (xcd < r ? xcd * (q + 1) : r * (q + 1) + (xcd - r) * q) + off; }
        u.pm = wgid >> 3; u.pn = wgid & 7; u.e = pexp[u.pm]; return true;
    }
    __device__ __forceinline__ const char* a_base(const Unit& u) const { return GATHER ? (const char*)A : (const char*)A + (size_t)u.pm * BM * K * 2; }
    __device__ __forceinline__ const char* b_base(const Unit& u) const { return (const char*)Bt + ((size_t)u.e * estride + (size_t)u.pn * BM * K) * 2; }
    __device__ __forceinline__ unsigned a_off1(int i, int half, int R, int C) const {
        if (GATHER) return (unsigned)(tokl[i * 256 + half * HALF + R] * K + C) * 2u;
        return (unsigned)((R + half * HALF) * K + C) * 2u;
    }
    __device__ __forceinline__ void a_voff(int i, const Unit&, const int (&R)[2], const int (&C)[2], unsigned (&v0)[2], unsigned (&v1)[2]) const {
#pragma unroll
        for (int j = 0; j < 2; ++j) {
            if (GATHER) { const int t0 = tokl[i * 256 + R[j]], t1 = tokl[i * 256 + HALF + R[j]];
                v0[j] = (unsigned)(t0 * K + C[j]) * 2u; v1[j] = (unsigned)(t1 * K + C[j]) * 2u; }
            else { v0[j] = (unsigned)(R[j] * K + C[j]) * 2u; v1[j] = v0[j] + (unsigned)(HALF * K * 2); }
        }
    }
};

struct EpiProj {
    static constexpr bool PERM = true;
    bf16_t* O;
    __device__ __forceinline__ void operator()(const f32x4 (&acc)[2][2][4][2], const Unit& u, int wr, int wc, int fr, int fq) const {
        const int row0 = u.pm * BM + wr * 64 + fr, col0 = u.pn * BM + wc * 32 + 8 * fq;
        const float s = (u.pn < 4) ? 0.125f * LOG2E : ((u.pn >= 12 && u.pn < 16) ? 0.08838834764831845f * LOG2E : 1.0f);
#pragma unroll
        for (int ai = 0; ai < 2; ++ai)
#pragma unroll
            for (int m = 0; m < 4; ++m) { bf16_t* rowp = O + (size_t)(row0 + ai * HALF + m * 16) * INC + col0;
#pragma unroll
                for (int bj = 0; bj < 2; ++bj) { const f32x4 v0 = acc[ai][bj][m][0] * s, v1 = acc[ai][bj][m][1] * s;
                    u32x4 w; w.x = cvt_pk_bf16(v0[0], v0[1]); w.y = cvt_pk_bf16(v0[2], v0[3]); w.z = cvt_pk_bf16(v1[0], v1[1]); w.w = cvt_pk_bf16(v1[2], v1[3]);
                    *(u32x4*)(rowp + bj * HALF) = w; } }
    }
};
struct EpiWo {
    static constexpr bool PERM = false;
    const float* x; const float* gate; float* H;
    __device__ __forceinline__ void operator()(const f32x4 (&acc)[2][2][4][2], const Unit& u, int wr, int wc, int fr, int fq) const {
        const int row0 = u.pm * BM + wr * 64 + fr, col0 = u.pn * BM + wc * 32 + 4 * fq;
        const float* gp = gate + (size_t)(u.pm >> 4) * 6 * D + col0;
        f32x4 gv[2][2];
#pragma unroll
        for (int bj = 0; bj < 2; ++bj)
#pragma unroll
            for (int n = 0; n < 2; ++n) gv[bj][n] = *(const f32x4*)(gp + bj * HALF + n * 16) + 1.0f;
#pragma unroll
        for (int ai = 0; ai < 2; ++ai)
#pragma unroll
            for (int m = 0; m < 4; ++m) { const size_t off = (size_t)(row0 + ai * HALF + m * 16) * D + col0;
#pragma unroll
                for (int bj = 0; bj < 2; ++bj)
#pragma unroll
                    for (int n = 0; n < 2; ++n) { const f32x4 xv = *(const f32x4*)(x + off + bj * HALF + n * 16);
                        *(f32x4*)(H + off + bj * HALF + n * 16) = xv * ALPHA + gv[bj][n] * acc[ai][bj][m][n]; } }
    }
};
struct EpiGU {
    static constexpr bool PERM = true;
    bf16_t* Hb;
    __device__ __forceinline__ void operator()(const f32x4 (&acc)[2][2][4][2], const Unit& u, int wr, int wc, int fr, int fq) const {
        const int row0 = u.pm * BM + wr * 64 + fr, col0 = u.pn * HALF + wc * 32 + 8 * fq;
#pragma unroll
        for (int ai = 0; ai < 2; ++ai)
#pragma unroll
            for (int m = 0; m < 4; ++m) { bf16_t* rowp = Hb + (size_t)(row0 + ai * HALF + m * 16) * DE + col0;
                float h[8];
#pragma unroll
                for (int n = 0; n < 2; ++n)
#pragma unroll
                    for (int j = 0; j < 4; ++j) { const float g = acc[ai][0][m][n][j], up = acc[ai][1][m][n][j];
                        h[n * 4 + j] = g * __builtin_amdgcn_rcpf(1.0f + __builtin_amdgcn_exp2f(-g * LOG2E)) * up; }
                u32x4 w; w.x = cvt_pk_bf16(h[0], h[1]); w.y = cvt_pk_bf16(h[2], h[3]); w.z = cvt_pk_bf16(h[4], h[5]); w.w = cvt_pk_bf16(h[6], h[7]);
                *(u32x4*)rowp = w; }
    }
};
struct EpiDown {
    static constexpr bool PERM = true;
    bf16_t* Y;
    __device__ __forceinline__ void operator()(const f32x4 (&acc)[2][2][4][2], const Unit& u, int wr, int wc, int fr, int fq) const {
        const int row0 = u.pm * BM + wr * 64 + fr, col0 = u.pn * BM + wc * 32 + 8 * fq;
#pragma unroll
        for (int ai = 0; ai < 2; ++ai)
#pragma unroll
            for (int m = 0; m < 4; ++m) { bf16_t* rowp = Y + (size_t)(row0 + ai * HALF + m * 16) * D + col0;
#pragma unroll
                for (int bj = 0; bj < 2; ++bj) { const f32x4 v0 = acc[ai][bj][m][0], v1 = acc[ai][bj][m][1];
                    u32x4 w; w.x = cvt_pk_bf16(v0[0], v0[1]); w.y = cvt_pk_bf16(v0[2], v0[3]); w.z = cvt_pk_bf16(v1[0], v1[1]); w.w = cvt_pk_bf16(v1[2], v1[3]);
                    *(u32x4*)(rowp + bj * HALF) = w; } }
    }
};

template <class Epi, class Sched>
__device__ __forceinline__ void gemm_phase(MK_LAS unsigned char* lds, const int K, const Sched& S, const Epi& E) {
    const int tid = ltid(), wid = __builtin_amdgcn_readfirstlane(tid >> 6), lane = tid & 63, wr = wid >> 2, wc = wid & 3, fr = lane & 15, fq = lane >> 4;
    const int nt = K / BK;
    int Rr[2], Cc[2]; unsigned voffB[2];
#pragma unroll
    for (int i = 0; i < 2; ++i) { int R, C; stage_rc(tid * 16 + i * 8192, R, C); const int Rb = Epi::PERM ? ((R & ~31) + perm32(R & 31)) : R;
        Rr[i] = R; Cc[i] = C; voffB[i] = (unsigned)(Rb * K + C) * 2u; }
    const size_t kstep = (size_t)(BK * 2);
    const size_t hstep = (size_t)HALF * K * 2;
    const unsigned ldsw = (unsigned)wid * 1024u;
    const int aoff = lds_byte(wr * 64 + fr, fq * 8), boff = lds_byte(wc * 32 + fr, fq * 8);
#define PG8_SA(b, h) (((b) * 2 + (h)) * HTB)
#define PG8_SB(b, h) ((4 + (b) * 2 + (h)) * HTB)
#define PG8_STAGE(bufoff, gbase, voff) do { _Pragma("unroll") for (int _i = 0; _i < 2; ++_i) \
        __builtin_amdgcn_global_load_lds((const unsigned*)((const char*)(gbase) + (voff)[_i]), (MK_LAS unsigned*)(lds + (bufoff) + ldsw + _i * 8192), 16, 0, 0); } while (0)
#define PG8_LDA(dst, b, h) do { _Pragma("unroll") for (int m = 0; m < 4; ++m) _Pragma("unroll") for (int k = 0; k < 2; ++k) dst[m][k] = *(const MK_LAS bf16x8*)(lds + PG8_SA(b, h) + aoff + m * 2048 + k * 1024); } while (0)
#define PG8_LDB(dst, b, h) do { _Pragma("unroll") for (int n = 0; n < 2; ++n) _Pragma("unroll") for (int k = 0; k < 2; ++k) dst[n][k] = *(const MK_LAS bf16x8*)(lds + PG8_SB(b, h) + boff + n * 2048 + k * 1024); } while (0)
#define PG8_MMA(ai, bj, At, Bt) do { __builtin_amdgcn_s_setprio(1); _Pragma("unroll") for (int m = 0; m < 4; ++m) _Pragma("unroll") for (int n = 0; n < 2; ++n) _Pragma("unroll") for (int k = 0; k < 2; ++k) \
        acc[ai][bj][m][n] = __builtin_amdgcn_mfma_f32_16x16x32_bf16(Bt[n][k], At[m][k], acc[ai][bj][m][n], 0, 0, 0); __builtin_amdgcn_s_setprio(0); } while (0)
#define PG8_WAIT_V(n) asm volatile("s_waitcnt vmcnt(" #n ")" ::: "memory")
#define PG8_WAIT_L(n) asm volatile("s_waitcnt lgkmcnt(" #n ")" ::: "memory")
#define PG8_BAR __builtin_amdgcn_s_barrier()
#define PG8_SCHED __builtin_amdgcn_sched_barrier(0)
    Unit cur, nxt; int ui = 0;
    if (!S.next(0, cur)) return;
    unsigned cv0[2], cv1[2], nv0[2], nv1[2];
    S.a_voff(0, cur, Rr, Cc, cv0, cv1);
    f32x4 acc[2][2][4][2];
#pragma unroll
    for (int a = 0; a < 2; ++a)
#pragma unroll
        for (int b = 0; b < 2; ++b)
#pragma unroll
            for (int m = 0; m < 4; ++m)
#pragma unroll
                for (int n = 0; n < 2; ++n) acc[a][b][m][n] = (f32x4){0.f, 0.f, 0.f, 0.f};
    bf16x8 At[4][2], B0[2][2], B1[2][2];
    const char* cA = S.a_base(cur); const char* cB = S.b_base(cur);
    PG8_STAGE(PG8_SB(0, 0), cB, voffB); PG8_STAGE(PG8_SB(0, 1), cB + hstep, voffB); PG8_STAGE(PG8_SA(0, 0), cA, cv0); PG8_STAGE(PG8_SA(0, 1), cA, cv1);
    if (wr == 1) PG8_BAR;
    PG8_WAIT_V(2); PG8_BAR;
    PG8_STAGE(PG8_SB(1, 0), cB + kstep, voffB); PG8_STAGE(PG8_SA(1, 0), cA + kstep, cv0); PG8_STAGE(PG8_SB(1, 1), cB + hstep + kstep, voffB);
    PG8_WAIT_V(6); PG8_BAR;
    for (;;) {
        const bool has_next = S.next(ui + 1, nxt);
        const char* nA = cA; const char* nB = cB;
#pragma unroll
        for (int j = 0; j < 2; ++j) { nv0[j] = cv0[j]; nv1[j] = cv1[j]; }
        if (has_next) { nA = S.a_base(nxt); nB = S.b_base(nxt); S.a_voff(ui + 1, nxt, Rr, Cc, nv0, nv1); }
        for (int t = 0; t < nt; t += 2) {
            const bool last = (t == nt - 2);
            const char* a1 = cA + (size_t)(t + 1) * kstep;
            const char* a2 = last ? nA : cA + (size_t)(t + 2) * kstep; const char* b2 = last ? nB : cB + (size_t)(t + 2) * kstep;
            const char* a3 = a2 + kstep; const char* b3 = b2 + kstep;
            unsigned x0[2], x1[2];
#pragma unroll
            for (int j = 0; j < 2; ++j) { x0[j] = last ? nv0[j] : cv0[j]; x1[j] = last ? nv1[j] : cv1[j]; }
            PG8_LDB(B0, 0, 0); PG8_LDB(B1, 0, 1); PG8_SCHED; PG8_LDA(At, 0, 0); PG8_STAGE(PG8_SA(1, 1), a1, cv1);
            PG8_WAIT_V(8); PG8_WAIT_L(0); PG8_BAR; PG8_MMA(0, 0, At, B0); PG8_MMA(0, 1, At, B1); PG8_BAR; PG8_SCHED;
            PG8_LDA(At, 0, 1); PG8_STAGE(PG8_SB(0, 0), b2, voffB); PG8_STAGE(PG8_SB(0, 1), b2 + hstep, voffB); PG8_STAGE(PG8_SA(0, 0), a2, x0);
            PG8_WAIT_V(8); PG8_WAIT_L(0); PG8_BAR; PG8_MMA(1, 0, At, B0); PG8_MMA(1, 1, At, B1); PG8_BAR; PG8_SCHED;
            PG8_LDB(B0, 1, 0); PG8_LDB(B1, 1, 1); PG8_SCHED; PG8_LDA(At, 1, 0); PG8_STAGE(PG8_SA(0, 1), a2, x1);
            PG8_WAIT_V(8); PG8_WAIT_L(0); PG8_BAR; PG8_MMA(0, 0, At, B0); PG8_MMA(0, 1, At, B1); PG8_BAR; PG8_SCHED;
            PG8_LDA(At, 1, 1); PG8_STAGE(PG8_SB(1, 0), b3, voffB); PG8_STAGE(PG8_SB(1, 1), b3 + hstep, voffB); PG8_STAGE(PG8_SA(1, 0), a3, x0);
            PG8_WAIT_V(8); PG8_WAIT_L(0); PG8_BAR; PG8_MMA(1, 0, At, B0); PG8_MMA(1, 1, At, B1); PG8_BAR; PG8_SCHED;
        }
        if (wr == 0) PG8_BAR;
        E(acc, cur, wr, wc, fr, fq);
        if (!has_next) break;
#pragma unroll
        for (int a = 0; a < 2; ++a)
#pragma unroll
            for (int b = 0; b < 2; ++b)
#pragma unroll
                for (int m = 0; m < 4; ++m)
#pragma unroll
                    for (int n = 0; n < 2; ++n) acc[a][b][m][n] = (f32x4){0.f, 0.f, 0.f, 0.f};
        cur = nxt; cA = nA; cB = nB; ++ui;
#pragma unroll
        for (int j = 0; j < 2; ++j) { cv0[j] = nv0[j]; cv1[j] = nv1[j]; }
        if (wr == 1) PG8_BAR;
    }
    PG8_WAIT_V(0);
    PG8_BAR;
#undef PG8_SA
#undef PG8_SB
#undef PG8_STAGE
#undef PG8_LDA
#undef PG8_LDB
#undef PG8_MMA
#undef PG8_WAIT_V
#undef PG8_WAIT_L
#undef PG8_BAR
#undef PG8_SCHED
}
__device__ __forceinline__ const char* uniform_ptr(const char* p) { const unsigned long long v = (unsigned long long)p; const unsigned lo = __builtin_amdgcn_readfirstlane((unsigned)v), hi = __builtin_amdgcn_readfirstlane((unsigned)(v >> 32)); return (const char*)(((unsigned long long)hi << 32) | lo); }
__host__ __device__ __forceinline__ int invperm32(int c) { return ((c >> 2) & 1) * 16 + (c >> 3) * 4 + (c & 3); }
struct BPatch {
    unsigned voff;
    unsigned ldsoff;
};
struct BSrcDown {
    const float* W; size_t estride; int ldb;
    __device__ __forceinline__ void patch(int tid, bool perm, BPatch& P) const {
        const int lane = tid & 63, w = tid >> 6, kr0 = 8 * w, n0 = 4 * lane;
        P.voff = (unsigned)(kr0 * ldb + n0) * 4u;
        { const int n = n0, h = n >> 7, R = n & 127, slot = perm ? ((R & ~31) + invperm32(R & 31)) : R; P.ldsoff = (unsigned)(h * HTB + lds_byte(slot, kr0)); }
    }
    __device__ __forceinline__ const char* base(const Unit& u, int  ) const { const int e = __builtin_amdgcn_readfirstlane(u.e), pn = __builtin_amdgcn_readfirstlane(u.pn); return (const char*)(W + (size_t)e * estride + (size_t)pn * BM); }
    __device__ __forceinline__ size_t rowbytes() const { return (size_t)ldb * 4; }
};

struct BSrcUp {
    const float* Wg; const float* Wu; size_t estride; int ldb;
    __device__ __forceinline__ void patch(int tid, bool perm, BPatch& P) const {
        const int lane = tid & 63, w = tid >> 6, s_ = w & 1, kr0 = 16 * (w >> 1) + 8 * (lane >> 5), c0 = 4 * (lane & 31);
        P.voff = (unsigned)(kr0 * ldb + c0) * 4u;
        { const int R = c0, slot = perm ? ((R & ~31) + invperm32(R & 31)) : R; P.ldsoff = (unsigned)(s_ * HTB + lds_byte(slot, kr0)); }
    }
    __device__ __forceinline__ const char* base(const Unit& u, int wave) const { const int e = __builtin_amdgcn_readfirstlane(u.e), pn = __builtin_amdgcn_readfirstlane(u.pn), sel = __builtin_amdgcn_readfirstlane(wave & 1);
        const unsigned long long m = 0ull - (unsigned long long)(unsigned)sel;
        const float* src = (const float*)(((unsigned long long)Wg & ~m) | ((unsigned long long)Wu & m)); return (const char*)(src + (size_t)e * estride + (size_t)pn * HALF); }
    __device__ __forceinline__ size_t rowbytes() const { return (size_t)ldb * 4; }
};

template <int VAR = 0, class Epi, class Sched, class BSrc>
__device__ __forceinline__ void gemm_phase_fb(MK_LAS unsigned char* lds, const int K, const Sched& S, const BSrc& Bs_, const Epi& E) {
    const int tid = ltid(), wid = __builtin_amdgcn_readfirstlane(tid >> 6), lane = tid & 63, wr = wid >> 2, wc = wid & 3, fr = lane & 15, fq = lane >> 4;
    const int nt = K / BK;
    BPatch P; Bs_.patch(tid, Epi::PERM, P);
    const size_t kstep = (size_t)(BK * 2);
    const size_t rowb = Bs_.rowbytes(), ktb = rowb * BK;
    const unsigned ldsw = (unsigned)wid * 1024u;
    const int aoff = lds_byte(wr * 64 + fr, fq * 8), boff = lds_byte(wc * 32 + fr, fq * 8);
#define PG8_SA(b, h) (((b) * 2 + (h)) * HTB)
#define PG8_SB(b, h) ((4 + (b) * 2 + (h)) * HTB)
#define PG8_STAGE(bufoff, gbase, voff) do { _Pragma("unroll") for (int _i = 0; _i < 2; ++_i) \
        __builtin_amdgcn_global_load_lds((const unsigned*)((const char*)(gbase) + (voff)[_i]), (MK_LAS unsigned*)(lds + (bufoff) + ldsw + _i * 8192), 16, 0, 0); } while (0)
#define PG8_LDA(dst, b, h) do { _Pragma("unroll") for (int m = 0; m < 4; ++m) _Pragma("unroll") for (int k = 0; k < 2; ++k) dst[m][k] = *(const MK_LAS bf16x8*)(lds + PG8_SA(b, h) + aoff + m * 2048 + k * 1024); } while (0)
#define PG8_LDB(dst, b, h) do { _Pragma("unroll") for (int n = 0; n < 2; ++n) _Pragma("unroll") for (int k = 0; k < 2; ++k) dst[n][k] = *(const MK_LAS bf16x8*)(lds + PG8_SB(b, h) + boff + n * 2048 + k * 1024); } while (0)
#define PG8_MMA(ai, bj, At, Bt) do { __builtin_amdgcn_s_setprio(1); _Pragma("unroll") for (int m = 0; m < 4; ++m) _Pragma("unroll") for (int n = 0; n < 2; ++n) _Pragma("unroll") for (int k = 0; k < 2; ++k) \
        acc[ai][bj][m][n] = __builtin_amdgcn_mfma_f32_16x16x32_bf16(Bt[n][k], At[m][k], acc[ai][bj][m][n], 0, 0, 0); __builtin_amdgcn_s_setprio(0); } while (0)
#define PG8_WAIT_V(n) asm volatile("s_waitcnt vmcnt(" #n ")" ::: "memory")
#define PG8_WAIT_L(n) asm volatile("s_waitcnt lgkmcnt(" #n ")" ::: "memory")
#define PG8_BAR __builtin_amdgcn_s_barrier()
#define PG8_SCHED __builtin_amdgcn_sched_barrier(0)
    f32x4 br[8];
#define BF_LOAD(ptr) do { const char* _p = uniform_ptr(ptr); \
        _Pragma("unroll") for (int _j = 0; _j < 8; ++_j) asm volatile("global_load_dwordx4 %0, %1, %2" : "=v"(br[_j]) : "v"(P.voff), "s"(_p + (size_t)_j * rowb) : "memory"); } while (0)
#define BF_CONSUME(NLEFT, b) do { asm volatile("s_waitcnt vmcnt(" #NLEFT ")" : "+v"(br[0]), "+v"(br[1]), "+v"(br[2]), "+v"(br[3]), "+v"(br[4]), "+v"(br[5]), "+v"(br[6]), "+v"(br[7]) :: "memory"); \
        _Pragma("unroll") for (int _i = 0; _i < 4; ++_i) { u32x4 _w; _w.x = cvt_pk_bf16(br[0][_i], br[1][_i]); _w.y = cvt_pk_bf16(br[2][_i], br[3][_i]); _w.z = cvt_pk_bf16(br[4][_i], br[5][_i]); _w.w = cvt_pk_bf16(br[6][_i], br[7][_i]); \
            *(MK_LAS u32x4*)(lds + PG8_SB(b, 0) + P.ldsoff + _i * 64) = _w; } } while (0)
#define BF_FILL(g, b, nptr) do { \
        if ((g) < 20) { if (VAR != 2 && VAR != 3) { const int _c = (g) / 5, _w = (g) % 5; \
            if (_w < 4) fw[_w] = cvt_pk_bf16_c(br[2 * _w][_c], br[2 * _w + 1][_c]); \
            else *(MK_LAS u32x4*)(lds + PG8_SB(b, 0) + P.ldsoff + _c * 64) = (u32x4){fw[0], fw[1], fw[2], fw[3]}; } } \
        else if ((g) < 28 && VAR != 3) { const int _j = (g) - 20; asm volatile("global_load_dwordx4 %0, %1, %2" : "=v"(br[_j]) : "v"(P.voff), "s"(nptr + (size_t)_j * rowb) : "memory"); } } while (0)
#define BF_MMA_FILL(b, nextp) do { const char* _np = uniform_ptr(nextp); unsigned fw[4]; BPatch P; Bs_.patch(ltid(), Epi::PERM, P); \
        asm volatile("s_waitcnt vmcnt(4)" : "+v"(br[0]), "+v"(br[1]), "+v"(br[2]), "+v"(br[3]), "+v"(br[4]), "+v"(br[5]), "+v"(br[6]), "+v"(br[7]) :: "memory"); \
        __builtin_amdgcn_s_setprio(1); \
        _Pragma("unroll") for (int _g = 0; _g < 32; ++_g) { const int _bj = _g >> 4, _m = (_g >> 2) & 3, _n = (_g >> 1) & 1, _k = _g & 1; \
            if (_bj == 0) acc[1][0][_m][_n] = __builtin_amdgcn_mfma_f32_16x16x32_bf16(B0[_n][_k], At[_m][_k], acc[1][0][_m][_n], 0, 0, 0); \
            else acc[1][1][_m][_n] = __builtin_amdgcn_mfma_f32_16x16x32_bf16(B1[_n][_k], At[_m][_k], acc[1][1][_m][_n], 0, 0, 0); \
            BF_FILL(_g, b, _np); \
            __builtin_amdgcn_sched_barrier(0); } \
        __builtin_amdgcn_s_setprio(0); } while (0)
    Unit cur, nxt; int ui = 0;
    if (!S.next(0, cur)) return;
#define AV(dst, unit, half) do { _Pragma("unroll") for (int _j = 0; _j < 2; ++_j) { int _R, _C; stage_rc(ltid() * 16 + _j * 8192, _R, _C); dst[_j] = S.a_off1((unit), (half), _R, _C); } } while (0)
    unsigned cv0[2], cv1[2], nv0[2], nv1[2];
    AV(cv0, 0, 0); AV(cv1, 0, 1);
    f32x4 acc[2][2][4][2];
#pragma unroll
    for (int a = 0; a < 2; ++a)
#pragma unroll
        for (int b = 0; b < 2; ++b)
#pragma unroll
            for (int m = 0; m < 4; ++m)
#pragma unroll
                for (int n = 0; n < 2; ++n) acc[a][b][m][n] = (f32x4){0.f, 0.f, 0.f, 0.f};
    bf16x8 At[4][2], B0[2][2], B1[2][2];
    const char* cA = S.a_base(cur); const char* cB = Bs_.base(cur, wid);
    BF_LOAD(cB); PG8_STAGE(PG8_SA(0, 0), cA, cv0); PG8_STAGE(PG8_SA(0, 1), cA, cv1);
    BF_CONSUME(4, 0);
    BF_LOAD(cB + ktb); PG8_STAGE(PG8_SA(1, 0), cA + kstep, cv0);
    BF_CONSUME(2, 1);
    BF_LOAD(cB + 2 * ktb);
    PG8_WAIT_V(8); PG8_WAIT_L(0);
    if (wr == 1) PG8_BAR;
    PG8_BAR; PG8_BAR;
    for (;;) {
        const bool has_next = S.next(ui + 1, nxt);
        const char* nA = cA; const char* nB = cB;
        if (has_next) { nA = S.a_base(nxt); nB = Bs_.base(nxt, wid); }
        const int un = has_next ? ui + 1 : ui;
        if constexpr (Sched::GATHER) { AV(nv0, un, 0); AV(nv1, un, 1); }
        for (int t = 0; t < nt; t += 2) {
            const bool last = (t == nt - 2);
            const char* a1 = cA + (size_t)(t + 1) * kstep;
            const char* a2 = last ? nA : cA + (size_t)(t + 2) * kstep;
            const char* a3 = a2 + kstep;
            const int km = (VAR == 1) ? 1 : -1;
            const char* b3 = (t + 3 < nt) ? cB + (size_t)((t + 3) & km) * ktb : nB + (size_t)(t + 3 - nt) * ktb;
            const char* b4 = (t + 4 < nt) ? cB + (size_t)((t + 4) & km) * ktb : nB + (size_t)(t + 4 - nt) * ktb;
#define AOFF_H0(_i) (Sched::GATHER ? (last ? nv0[_i] : cv0[_i]) : cv0[_i])
#define AOFF_H1(_i) (Sched::GATHER ? (last ? nv1[_i] : cv1[_i]) : cv0[_i] + (unsigned)(HALF * K * 2))
#define AOFF_C1(_i) (Sched::GATHER ? cv1[_i] : cv0[_i] + (unsigned)(HALF * K * 2))
#define PG8_STAGEF(bufoff, gbase, OFF) do { _Pragma("unroll") for (int _i = 0; _i < 2; ++_i) \
        __builtin_amdgcn_global_load_lds((const unsigned*)((const char*)(gbase) + OFF(_i)), (MK_LAS unsigned*)(lds + (bufoff) + ldsw + _i * 8192), 16, 0, 0); } while (0)
            PG8_LDB(B0, 0, 0); PG8_LDB(B1, 0, 1); PG8_SCHED; PG8_LDA(At, 0, 0); PG8_STAGEF(PG8_SA(1, 1), a1, AOFF_C1);
            PG8_WAIT_V(12); PG8_WAIT_L(0); PG8_BAR; PG8_MMA(0, 0, At, B0); PG8_MMA(0, 1, At, B1); PG8_BAR; PG8_SCHED;
            PG8_LDA(At, 0, 1); PG8_STAGEF(PG8_SA(0, 0), a2, AOFF_H0);
            PG8_WAIT_L(0); PG8_BAR; BF_MMA_FILL(0, b3); PG8_BAR; PG8_SCHED;
            PG8_LDB(B0, 1, 0); PG8_LDB(B1, 1, 1); PG8_SCHED; PG8_LDA(At, 1, 0); PG8_STAGEF(PG8_SA(0, 1), a2, AOFF_H1);
            PG8_WAIT_V(12); PG8_WAIT_L(0); PG8_BAR; PG8_MMA(0, 0, At, B0); PG8_MMA(0, 1, At, B1); PG8_BAR; PG8_SCHED;
            PG8_LDA(At, 1, 1); PG8_STAGEF(PG8_SA(1, 0), a3, AOFF_H0);
            PG8_WAIT_L(0); PG8_BAR; BF_MMA_FILL(1, b4); PG8_BAR; PG8_SCHED;
        }
        if (wr == 0) PG8_BAR;
        E(acc, cur, wr, wc, fr, fq);
        if (!has_next) break;
#pragma unroll
        for (int a = 0; a < 2; ++a)
#pragma unroll
            for (int b = 0; b < 2; ++b)
#pragma unroll
                for (int m = 0; m < 4; ++m)
#pragma unroll
                    for (int n = 0; n < 2; ++n) acc[a][b][m][n] = (f32x4){0.f, 0.f, 0.f, 0.f};
        cur = nxt; cA = nA; cB = nB; ++ui;
        if constexpr (Sched::GATHER) {
#pragma unroll
            for (int j = 0; j < 2; ++j) { cv0[j] = nv0[j]; cv1[j] = nv1[j]; } }
        if (wr == 1) PG8_BAR;
    }
    asm volatile("s_waitcnt vmcnt(0)" : "+v"(br[0]), "+v"(br[1]), "+v"(br[2]), "+v"(br[3]), "+v"(br[4]), "+v"(br[5]), "+v"(br[6]), "+v"(br[7]) :: "memory");
    PG8_BAR;
#undef BF_LOAD
#undef AOFF_H0
#undef AOFF_H1
#undef AOFF_C1
#undef PG8_STAGEF
#undef BF_FILL
#undef BF_MMA_FILL
#undef AV
#undef BF_CONSUME
#undef PG8_SA
#undef PG8_SB
#undef PG8_STAGE
#undef PG8_LDA
#undef PG8_LDB
#undef PG8_MMA
#undef PG8_WAIT_V
#undef PG8_WAIT_L
#undef PG8_BAR
#undef PG8_SCHED
}
struct In { const float *x, *c, *w_ada, *b_ada, *w_in, *lam, *subg, *relb, *w_o, *ln_g, *ln_b, *w_group, *b_group, *w_router, *b_router, *w_gate, *w_up, *w_down; };
struct Ws {
    unsigned* ctl;
    float* mod;
    bf16_t* wt_in;
    bf16_t* wt_o;
    bf16_t* wt_gu;
    bf16_t* wt_d;
    bf16_t* ab;
    bf16_t* proj;
    bf16_t* mixin;
    bf16_t* mixb;
    float* x1;
    float* xa;
    bf16_t* Hb;
    bf16_t* Yb;
    int* tok_of;
    int* tokinfo;
    float* tokw;
    bf16_t* wt_rh;
    bf16_t* wt_rl;
    bf16_t* ablo;
};
constexpr int CTL_CNT = 4096;
constexpr int CTL_WORDS = 8192;

constexpr int LDS_AUX = 131072;
constexpr int LDS_PEXP = LDS_AUX;
constexpr int LDS_PBASE = LDS_AUX + 768;
constexpr int LDS_CNT = LDS_AUX + 1024;
constexpr int LDS_TOKL = LDS_AUX + 2048;
constexpr int LDS_BTAB = LDS_AUX + 2048 + 8192;
constexpr int LDS_MISC = LDS_BTAB + 1088;
constexpr int LDS_BYTES = 147456;
constexpr int LDS_FLAGS = LDS_MISC + 64;
static_assert(LDS_FLAGS + 64 <= LDS_BYTES, "LDS map");

struct Frame { MK_LAS unsigned char* lds; int tid, lane, wave, G, vcu; };

__device__ __forceinline__ void conv_item(const float* __restrict__ W, int K, int N, bf16_t* __restrict__ WT, int k0, int n0, int drow0, MK_LAS float* scr, int lane) {
    const int n4 = (lane & 15) * 4, kq = lane >> 4;
    f32x4 v[16];
#pragma unroll
    for (int i = 0; i < 16; ++i) v[i] = *(const f32x4*)(W + (size_t)(k0 + kq + 4 * i) * N + n0 + n4);
#pragma unroll
    for (int i = 0; i < 16; ++i) { MK_LAS float* p = scr + (kq + 4 * i) * 65 + n4; p[0] = v[i][0]; p[1] = v[i][1]; p[2] = v[i][2]; p[3] = v[i][3]; }
    asm volatile("s_waitcnt lgkmcnt(0)" ::: "memory");
    const int c = lane & 7;
#pragma unroll
    for (int j = 0; j < 8; ++j) { const int n = (lane >> 3) + 8 * j; const MK_LAS float* s = scr + (8 * c) * 65 + n;
        u32x4 o; o.x = cvt_pk_bf16(s[0 * 65], s[1 * 65]); o.y = cvt_pk_bf16(s[2 * 65], s[3 * 65]); o.z = cvt_pk_bf16(s[4 * 65], s[5 * 65]); o.w = cvt_pk_bf16(s[6 * 65], s[7 * 65]);
        *(u32x4*)(WT + (size_t)(drow0 + n) * K + k0 + 8 * c) = o; }
    asm volatile("s_waitcnt lgkmcnt(0)" ::: "memory");
}
#if (defined(MK_F32B_DOWN) && defined(MK_F32B_UP)) || defined(MK_BGCONV)
constexpr int CI_E = 0;
#elif defined(MK_F32B_DOWN)
constexpr int CI_E = 1024;
#else
constexpr int CI_E = 1536;
#endif
constexpr int CI_IN = 3072, CI_O = 1024, CI_LAYER = CI_IN + CI_O + NE * CI_E;
__device__ __forceinline__ void conv_dispatch(const In& in, const Ws& w, int l, int r, MK_LAS float* scr, int lane) {
    if (r < CI_IN) { const int kb = r / 96, nb = r % 96; conv_item(in.w_in + (size_t)l * D * INC, D, INC, w.wt_in + (size_t)l * INC * D, kb * 64, nb * 64, nb * 64, scr, lane); return; }
    r -= CI_IN;
    if (r < CI_O) { const int kb = r / 32, nb = r % 32; conv_item(in.w_o + (size_t)l * D * D, D, D, w.wt_o + (size_t)l * D * D, kb * 64, nb * 64, nb * 64, scr, lane); return; }
    r -= CI_O;
    if (CI_E == 0) return;
    const int e = r / (CI_E ? CI_E : 1); r -= e * CI_E;
    const size_t le = (size_t)l * NE + e;
    if (r < 512) { const int kb = r / 16, nb = r % 16, n0 = nb * 64; conv_item(in.w_gate + le * D * DE, D, DE, w.wt_gu + le * 2048 * D, kb * 64, n0, ((n0 >> 7) << 8) + (n0 & 127), scr, lane); return; }
    r -= 512;
    if (r < 512) { const int kb = r / 16, nb = r % 16, n0 = nb * 64; conv_item(in.w_up + le * D * DE, D, DE, w.wt_gu + le * 2048 * D, kb * 64, n0, ((n0 >> 7) << 8) + 128 + (n0 & 127), scr, lane); return; }
    r -= 512;
#ifndef MK_F32B_DOWN
    { const int kb = r / 32, nb = r % 32; conv_item(in.w_down + le * DE * D, DE, D, w.wt_d + le * D * DE, kb * 64, nb * 64, nb * 64, scr, lane); }
#endif
}
__device__ __forceinline__ void phase_convert(const Frame& F, const In& in, const Ws& w, int it_lo, int it_hi) {
    MK_LAS float* scr = (MK_LAS float*)(F.lds + F.wave * 16640);
    const int gw = F.vcu * NWAVES + F.wave, NGW = F.G * NWAVES;
    for (int it = gw + it_lo; it < it_hi; it += NGW) conv_dispatch(in, w, it / CI_LAYER, it % CI_LAYER, scr, F.lane);
}

__device__ __forceinline__ void phase_mod(const Frame& F, const In& in, const Ws& w) {
    MK_LAS float* sc = (MK_LAS float*)(F.lds + 133120 - 133120);
    MK_LAS float* red = (MK_LAS float*)(F.lds + 32768);
    __syncthreads();
    for (int i = F.tid; i < NB * D; i += NTHR) { const float cv = in.c[i]; sc[i] = cv / (1.0f + __expf(-cv)); }
    __syncthreads();
    for (int item = F.vcu; item < 256; item += F.G) {
        const int l = item >> 7, n0 = (item & 127) * 96;
        const int cq = F.tid % 24, ks = F.tid / 24;
        if (ks < 16) {
            const float* wp = in.w_ada + (size_t)l * D * 6 * D + (size_t)(ks * 128) * 6 * D + n0 + cq * 4;
            f32x4 a0 = {0.f, 0.f, 0.f, 0.f}, a1 = a0, a2 = a0, a3 = a0;
#pragma unroll 8
            for (int k = 0; k < 128; ++k) { const f32x4 wv = *(const f32x4*)(wp + (size_t)k * 6 * D); const int kk = ks * 128 + k;
                a0 += wv * sc[kk]; a1 += wv * sc[D + kk]; a2 += wv * sc[2 * D + kk]; a3 += wv * sc[3 * D + kk]; }
            MK_LAS f32x4* rp = (MK_LAS f32x4*)red + (ks * 24 + cq) * 4;
            rp[0] = a0; rp[1] = a1; rp[2] = a2; rp[3] = a3;
        }
        __syncthreads();
        if (F.tid < 384) {
            const int q = F.tid / 16, bb = (F.tid >> 2) & 3, comp = F.tid & 3;
            float s = 0.f;
#pragma unroll
            for (int k2 = 0; k2 < 16; ++k2) s += red[((k2 * 24 + q) * 4 + bb) * 4 + comp];
            const int n = n0 + q * 4 + comp;
            w.mod[((size_t)l * NB + bb) * 6 * D + n] = s + in.b_ada[l * 6 * D + n];
        }
        __syncthreads();
    }
}

__device__ __forceinline__ void phase_modulate(const Frame& F, const float* __restrict__ x, const float* __restrict__ modl, bf16_t* __restrict__ ub) {
    const int gw = F.vcu * NWAVES + F.wave, NGW = F.G * NWAVES;
    for (int t = gw; t < M; t += NGW) {
        const float* mb = modl + (size_t)(t / S) * 6 * D;
        const float* xr = x + (size_t)t * D;
        bf16_t* ur = ub + (size_t)t * D;
#pragma unroll
        for (int j = 0; j < 8; ++j) { const int col = j * 256 + F.lane * 4;
            const f32x4 xv = *(const f32x4*)(xr + col), sh = *(const f32x4*)(mb + col), scv = *(const f32x4*)(mb + D + col);
            const f32x4 u = xv * (scv + 1.0f) + sh;
            u32x2 o; o.x = cvt_pk_bf16(u[0], u[1]); o.y = cvt_pk_bf16(u[2], u[3]);
            *(u32x2*)(ur + col) = o; }
    }
}

__device__ __forceinline__ int t5_bucket(int n) {
    if (n < 16) return n;
    const float v = logf((float)n / 16.0f) / 2.0794415416798357f * 16.0f;
    const int large = 16 + (int)v;
    return large < 31 ? large : 31;
}
__device__ __forceinline__ float permswap_other(float v) {
    auto rr = __builtin_amdgcn_permlane32_swap(__float_as_uint(v), __float_as_uint(v), false, false);
    return (__lane_id() & 32) ? __uint_as_float(rr[0]) : __uint_as_float(rr[1]);
}

#ifdef MK_BGCONV
constexpr int BG_ITEMS = (MK_BGCONV == 2 ? 2 : 3) * 65536;
#ifndef MK_BGMASK
#define MK_BGMASK 0
#endif
struct BgConv { const float* wg; const float* wu; const float* wd; bf16_t* tgu; bf16_t* td; int next, step, cur, mode; f32x2 p[8]; };
struct BgAddr { const float* src; bf16_t* dst; int N, K; };
__device__ __forceinline__ BgAddr bg_addr(const BgConv& g, int r, int lane) {
    r = __builtin_amdgcn_readfirstlane(r);
    const int mat = r >> 16, e = (r >> 11) & 31, kg = lane & 7, np = lane >> 3;
    BgAddr a;
    if (mat < 2) { const int kb = (r >> 6) & 31, n0 = (r & 63) * 16;
        const unsigned long long m = 0ull - (unsigned long long)(unsigned)mat;
        const float* W = (const float*)(((unsigned long long)g.wg & ~m) | ((unsigned long long)g.wu & m));
        a.N = DE; a.K = D;
        a.src = W + (size_t)e * D * DE + (size_t)(kb * 64 + 8 * kg) * DE + n0 + 2 * np;
        a.dst = g.tgu + (size_t)e * 2048 * D + (size_t)(((n0 >> 7) << 8) + (n0 & 127) + mat * 128 + 2 * np) * D + kb * 64 + 8 * kg;
    } else { const int kb = (r >> 7) & 15, n0 = (r & 127) * 16;
        a.N = D; a.K = DE;
        a.src = g.wd + (size_t)e * DE * D + (size_t)(kb * 64 + 8 * kg) * D + n0 + 2 * np;
        a.dst = g.td + (size_t)e * D * DE + (size_t)(n0 + 2 * np) * DE + kb * 64 + 8 * kg;
    }
    return a;
}
__device__ __forceinline__ void bg_load(BgConv& g, int lane) {
    const bool live = g.next < BG_ITEMS; const int r = live ? g.next : BG_ITEMS - 1;
    const BgAddr a = bg_addr(g, r, lane);
    if (g.mode != 2) {
#pragma unroll
    for (int j = 0; j < 8; ++j) g.p[j] = *(const __attribute__((address_space(1))) f32x2*)(unsigned long long)(a.src + (size_t)j * a.N); }
    g.cur = live ? g.next : -1; if (live) g.next += g.step;
}
__device__ __forceinline__ void bg_store(BgConv& g, int lane) {
    if (g.cur >= 0 && g.mode == 1) {
#pragma unroll
        for (int j = 0; j < 8; ++j) asm volatile("" :: "v"(g.p[j]));
        g.cur = -1; }
    if (g.cur >= 0) { const BgAddr a = bg_addr(g, g.cur, lane);
        u32x4 o0, o1;
        o0.x = cvt_pk_bf16(g.p[0][0], g.p[1][0]); o0.y = cvt_pk_bf16(g.p[2][0], g.p[3][0]); o0.z = cvt_pk_bf16(g.p[4][0], g.p[5][0]); o0.w = cvt_pk_bf16(g.p[6][0], g.p[7][0]);
        o1.x = cvt_pk_bf16(g.p[0][1], g.p[1][1]); o1.y = cvt_pk_bf16(g.p[2][1], g.p[3][1]); o1.z = cvt_pk_bf16(g.p[4][1], g.p[5][1]); o1.w = cvt_pk_bf16(g.p[6][1], g.p[7][1]);
        *(u32x4*)(a.dst) = o0; *(u32x4*)(a.dst + a.K) = o1; g.cur = -1; }
}
#define BG_PARAM , BgConv& bgc
#define BG_ARG , bgc
#else
#define BG_PARAM
#define BG_ARG
#endif

template <int MODE>
__device__ __forceinline__ void attn_pass(MK_LAS unsigned char* lds, const bf16_t* __restrict__ base  , int qcol, int kcol, int vcol, int qb,
                                          const MK_LAS float* btab, f32x16 (&O)[4], float& lsum BG_PARAM) {
    constexpr int DQK = MODE ? 128 : 64, ND0 = DQK / 16, KSTR = DQK * 2 + 16, VSTR = 320, KBYTES = 64 * KSTR, VBYTES = 64 * VSTR, BUF = KBYTES + VBYTES;
    constexpr int NKP = MODE ? 2 : 1;
    const int tid = ltid(), lane = tid & 63, wid = __builtin_amdgcn_readfirstlane(tid >> 6), r32 = lane & 31, hi = lane >> 5;
    const int q0 = qb * 256, qw0 = q0 + wid * 32, q = qw0 + r32;
    const int nt = 4 * qb + 4;
    bf16x8 qf[ND0];
#pragma unroll
    for (int d0 = 0; d0 < ND0; ++d0) qf[d0] = *(const bf16x8*)(base + (size_t)q * INC + qcol + d0 * 16 + hi * 8);
#pragma unroll
    for (int db = 0; db < 4; ++db)
#pragma unroll
        for (int r = 0; r < 16; ++r) O[db][r] = 0.f;
    float mref = 0.f; lsum = 0.f;
    float carry = 0.f;
    MK_LAS unsigned* flags = (MK_LAS unsigned*)(lds + LDS_FLAGS);
    const int krow = MODE ? (tid >> 4) : (tid >> 3), kch = MODE ? (tid & 15) : (tid & 7);
    const int vrow = tid >> 4, vch = tid & 15;
    const bf16_t* kg = base + (size_t)krow * INC + kcol + kch * 8;
    const bf16_t* vg = base + (size_t)vrow * INC + vcol + vch * 8;
    const unsigned kl = krow * KSTR + kch * 16, vl = KBYTES + vrow * VSTR + vch * 16;
    u32x4 kreg[NKP], vreg[2];
#define AT_GLOAD(j) do { const size_t _ro = (size_t)(j) * 64 * INC; \
        _Pragma("unroll") for (int _i = 0; _i < NKP; ++_i) kreg[_i] = *(const u32x4*)(kg + _ro + (size_t)_i * 32 * INC); \
        _Pragma("unroll") for (int _i = 0; _i < 2; ++_i) vreg[_i] = *(const u32x4*)(vg + _ro + (size_t)_i * 32 * INC); } while (0)
#define AT_LWRITE(bufo) do { \
        _Pragma("unroll") for (int _i = 0; _i < NKP; ++_i) *(MK_LAS u32x4*)(lds + (bufo) + kl + _i * 32 * KSTR) = kreg[_i]; \
        _Pragma("unroll") for (int _i = 0; _i < 2; ++_i) *(MK_LAS u32x4*)(lds + (bufo) + vl + _i * 32 * VSTR) = vreg[_i]; } while (0)
    const unsigned ka = r32 * KSTR + hi * 16;
    const unsigned va = KBYTES + (4 * hi + ((lane & 15) >> 2)) * VSTR + (((lane >> 4) & 1) * 16 + (lane & 3) * 4) * 2;
    { const int j0 = MODE ? nt - 1 : 0; AT_GLOAD(j0); AT_LWRITE(0); }
    __syncthreads();
#ifdef MK_BGCONV
#pragma unroll
    for (int d0 = 0; d0 < ND0; ++d0) asm volatile("" : "+v"(qf[d0]));
#endif
#ifdef MK_BGCONV
#pragma unroll (MODE ? 1 : 2)
#endif
    for (int it = 0; it < nt; ++it) {
        const int j = MODE ? nt - 1 - it : it;
        const unsigned bo = (unsigned)(it & 1) * BUF;
#ifdef MK_BGCONV
        if (MODE == 0 && !(it & MK_BGMASK)) bg_store(bgc, lane);
#endif
        if (it + 1 < nt) { const int jn = MODE ? j - 1 : j + 1; AT_GLOAD(jn); }
#ifdef MK_BGCONV
#ifdef MK_BGSPREAD
        const bool bgact = (MODE == 0) && !(it & MK_BGMASK);
        BgAddr bga; bga.src = nullptr; bga.N = 0;
        if (bgact) { const bool live = bgc.next < BG_ITEMS; const int r = live ? bgc.next : BG_ITEMS - 1; bga = bg_addr(bgc, r, lane); bgc.cur = live ? bgc.next : -1; if (live) bgc.next += bgc.step; }
#define BG_LD(jj) do { if (bgact) { asm volatile("" :: "v"(bgc.p[jj]));        \
            bgc.p[jj] = *(const __attribute__((address_space(1))) f32x2*)(unsigned long long)(bga.src + (size_t)(jj) * bga.N); } } while (0)
#define BG_FENCE() __builtin_amdgcn_sched_barrier(0)
        BG_FENCE();
#else
        if (MODE == 0 && !(it & MK_BGMASK)) bg_load(bgc, lane);
#define BG_LD(jj) do { } while (0)
#define BG_FENCE() do { } while (0)
#endif
#else
#define BG_LD(jj) do { } while (0)
#define BG_FENCE() do { } while (0)
#endif
        const bool skip = MODE ? (64 * j >= qw0 + 32) : (64 * j > qw0 + 31);
        f32x16 sT[2]; bf16x8 pf[2][2];
        if (!skip) {
            const float cinit = MODE ? 0.f : -mref;
#pragma unroll
            for (int kb = 0; kb < 2; ++kb) {
                bf16x8 kf[ND0];
#pragma unroll
                for (int d0 = 0; d0 < ND0; ++d0) kf[d0] = *(const MK_LAS bf16x8*)(lds + bo + ka + kb * 32 * KSTR + d0 * 32);
#pragma unroll
                for (int r = 0; r < 16; ++r) sT[kb][r] = cinit;
                __builtin_amdgcn_sched_barrier(0);
#pragma unroll
                for (int d0 = 0; d0 < ND0; ++d0) sT[kb] = __builtin_amdgcn_mfma_f32_32x32x16_bf16(kf[d0], qf[d0], sT[kb], 0, 0, 0);
            }
        }
        BG_FENCE(); BG_LD(0); BG_LD(1); BG_LD(2); BG_FENCE();
        if (!skip) {
            const int kbase = 64 * j + 4 * hi;
            if (MODE == 0) {
                if (j >= 4 * qb - 2) {
#pragma unroll
                    for (int kb = 0; kb < 2; ++kb)
#pragma unroll
                        for (int r = 0; r < 16; ++r) { int rel = q - (kbase + 32 * kb + (r & 3) + 8 * (r >> 2)); rel = rel < 0 ? 0 : (rel > 128 ? 128 : rel); sT[kb][r] += btab[rel]; }
                }
                if (j >= 4 * qb) {
#pragma unroll
                    for (int kb = 0; kb < 2; ++kb)
#pragma unroll
                        for (int r = 0; r < 16; ++r) { const int key = kbase + 32 * kb + (r & 3) + 8 * (r >> 2); if (key > q) sT[kb][r] = -INFINITY; }
                }
                float ma = fmaxf(fmaxf(sT[0][0], sT[0][1]), sT[1][0]), mb = fmaxf(fmaxf(sT[0][2], sT[0][3]), sT[1][1]);
                ma = fmaxf(fmaxf(ma, sT[1][2]), sT[1][3]);
#pragma unroll
                for (int r = 4; r < 16; r += 4) { ma = fmaxf(fmaxf(ma, sT[0][r]), sT[0][r + 1]); mb = fmaxf(fmaxf(mb, sT[0][r + 2]), sT[0][r + 3]);
                    ma = fmaxf(fmaxf(ma, sT[1][r]), sT[1][r + 1]); mb = fmaxf(fmaxf(mb, sT[1][r + 2]), sT[1][r + 3]); }
                float grow = fmaxf(ma, mb);
                grow = fmaxf(grow, permswap_other(grow));
                if (it == 0 || !__all(grow <= 8.0f)) {
                    const float delta = (it == 0) ? grow : fmaxf(grow, 0.f);
                    const float alpha = __builtin_amdgcn_exp2f(-delta);
                    mref += delta; lsum *= alpha;
#pragma unroll
                    for (int kb = 0; kb < 2; ++kb)
#pragma unroll
                        for (int r = 0; r < 16; ++r) sT[kb][r] -= delta;
#pragma unroll
                    for (int db = 0; db < 4; ++db)
#pragma unroll
                        for (int r = 0; r < 16; ++r) O[db][r] *= alpha;
                }
                f32x2 ps2 = {0.f, 0.f};
#pragma unroll
                for (int kb = 0; kb < 2; ++kb)
#pragma unroll
                    for (int r = 0; r < 16; r += 2) { const float p0 = __builtin_amdgcn_exp2f(sT[kb][r]), p1 = __builtin_amdgcn_exp2f(sT[kb][r + 1]); sT[kb][r] = p0; sT[kb][r + 1] = p1; ps2 += (f32x2){p0, p1}; }
                lsum += ps2[0] + ps2[1];
            } else {
                const bool band = (j >= 4 * qb);
                float suf = carry;
#pragma unroll
                for (int kb = 1; kb >= 0; --kb) {
                    float Lr[16], gs[4], pg[4];
#pragma unroll
                    for (int g4 = 0; g4 < 4; ++g4) {
                        float sgrp = 0.f;
#pragma unroll
                        for (int i = 0; i < 4; ++i) { const int r = g4 * 4 + i; const float z = sT[kb][r];
                            float L = -(fmaxf(z, 0.f) + __builtin_amdgcn_logf(1.0f + __builtin_amdgcn_exp2f(-fabsf(z))));
                            if (band) { const int key = kbase + 32 * kb + i + 8 * g4; if (key >= q) L = 0.f; }
                            Lr[r] = L; sgrp += L; }
                        gs[g4] = sgrp;
                    }
#pragma unroll
                    for (int g4 = 0; g4 < 4; ++g4) pg[g4] = permswap_other(gs[g4]);
#pragma unroll
                    for (int g4 = 3; g4 >= 0; --g4) {
                        float cacc = suf + (hi == 0 ? pg[g4] : 0.f);
#pragma unroll
                        for (int i = 3; i >= 0; --i) { const int r = g4 * 4 + i; cacc += Lr[r]; const float z = sT[kb][r];
                            float a = __builtin_amdgcn_exp2f(z + cacc);
                            if (band) { const int key = kbase + 32 * kb + i + 8 * g4; if (key >= q) a = 0.f; }
                            sT[kb][r] = a; }
                        suf += gs[g4] + pg[g4];
                    }
                }
                carry = suf;
            }
#pragma unroll
            for (int kb = 0; kb < 2; ++kb)
#pragma unroll
                for (int s = 0; s < 2; ++s) { u32x4 w; w.x = cvt_pk_bf16(sT[kb][8 * s + 0], sT[kb][8 * s + 1]); w.y = cvt_pk_bf16(sT[kb][8 * s + 2], sT[kb][8 * s + 3]);
                    w.z = cvt_pk_bf16(sT[kb][8 * s + 4], sT[kb][8 * s + 5]); w.w = cvt_pk_bf16(sT[kb][8 * s + 6], sT[kb][8 * s + 7]); pf[kb][s] = __builtin_bit_cast(bf16x8, w); }
        }
        BG_FENCE(); BG_LD(3); BG_LD(4); BG_LD(5); BG_FENCE();
        if (!skip) {
            {
                bf16x8 af[3];
#define AT_VFRAG(m, dst) do { const MK_LAS unsigned char* _vp = lds + bo + va + (32 * (((m) >> 1) & 1) + 16 * ((m) & 1)) * VSTR + ((m) >> 2) * 64; \
                    const s16x4 _a0 = __builtin_bit_cast(s16x4, __builtin_amdgcn_ds_read_tr16_b64_v4i16((MK_LAS s16x4*)_vp)); \
                    const s16x4 _a1 = __builtin_bit_cast(s16x4, __builtin_amdgcn_ds_read_tr16_b64_v4i16((MK_LAS s16x4*)(_vp + 8 * VSTR))); \
                    dst[0] = _a0[0]; dst[1] = _a0[1]; dst[2] = _a0[2]; dst[3] = _a0[3]; dst[4] = _a1[0]; dst[5] = _a1[1]; dst[6] = _a1[2]; dst[7] = _a1[3]; } while (0)
                AT_VFRAG(0, af[0]); AT_VFRAG(1, af[1]);
                __builtin_amdgcn_sched_barrier(0);
#pragma unroll
                for (int m = 0; m < 16; ++m) {
                    if (m + 2 < 16) AT_VFRAG(m + 2, af[(m + 2) % 3]);
                    __builtin_amdgcn_sched_barrier(0);
                    O[m >> 2] = __builtin_amdgcn_mfma_f32_32x32x16_bf16(af[m % 3], pf[(m >> 1) & 1][m & 1], O[m >> 2], 0, 0, 0);
                    __builtin_amdgcn_sched_barrier(0);
                }
#undef AT_VFRAG
            }
        }
        BG_FENCE(); BG_LD(6); BG_LD(7); BG_FENCE();
#undef BG_LD
#undef BG_FENCE
        if (it + 1 < nt) AT_LWRITE((unsigned)((it + 1) & 1) * BUF);
        if (MODE == 1) { const bool dead = __all(carry < -160.0f); if (lane == 0) flags[(it & 1) * 8 + wid] = dead ? 1u : 0u; }
        __syncthreads();
        if (MODE == 1) {
            const u32x4 f0 = *(const MK_LAS u32x4*)(flags + (it & 1) * 8), f1 = *(const MK_LAS u32x4*)(flags + (it & 1) * 8 + 4);
            if ((f0.x & f0.y & f0.z & f0.w & f1.x & f1.y & f1.z & f1.w) != 0u) break;
        }
    }
#ifdef MK_BGCONV
    if (MODE == 0) bg_store(bgc, lane);
#endif
#undef AT_GLOAD
#undef AT_LWRITE
}

__device__ __forceinline__ void attn_unit_diff(const Frame& F, const bf16_t* __restrict__ proj, bf16_t* __restrict__ mixin, int b, int h, int qb,
                                               const float* __restrict__ relb, const float* __restrict__ lamp, float lam_init, const float* __restrict__ subg BG_PARAM) {
    MK_LAS float* btab = (MK_LAS float*)(F.lds + LDS_BTAB);
    MK_LAS float* misc = (MK_LAS float*)(F.lds + LDS_MISC);
    if (F.tid < 264) { const int m = F.tid / 132, i = F.tid % 132;
        float v = 0.f;
        if (i < 128) v = (relb[(t5_bucket(i) * NH + h) * 2 + m] - relb[(31 * NH + h) * 2 + m]) * LOG2E;
        btab[m * 132 + i] = v; }
    if (F.wave == 7) { float a = lamp[F.lane] * lamp[64 + F.lane], c2 = lamp[128 + F.lane] * lamp[192 + F.lane]; a = wave_sum(a); c2 = wave_sum(c2);
        if (F.lane == 0) misc[4] = expf(a) - expf(c2) + lam_init; }
    __syncthreads();
    const float lam = misc[4];
    const bf16_t* base = proj + (size_t)b * S * INC;
    const int hi = F.lane >> 5, r32 = F.lane & 31;
    f32x16 O[4]; float ls;
    MK_LAS u32x4* stash = (MK_LAS u32x4*)(F.lds + 59392) + F.tid;
    attn_pass<0>(F.lds, base, (2 * h) * 64, 1024 + (2 * h) * 64, 2048 + h * 128, qb, btab, O, ls BG_ARG);
    { const float inv = 1.0f / (ls + permswap_other(ls));
#pragma unroll
        for (int db = 0; db < 4; ++db)
#pragma unroll
            for (int r = 0; r < 16; r += 8) { u32x4 pk;
                pk.x = cvt_pk_bf16(O[db][r] * inv, O[db][r + 1] * inv); pk.y = cvt_pk_bf16(O[db][r + 2] * inv, O[db][r + 3] * inv);
                pk.z = cvt_pk_bf16(O[db][r + 4] * inv, O[db][r + 5] * inv); pk.w = cvt_pk_bf16(O[db][r + 6] * inv, O[db][r + 7] * inv);
                stash[(db * 2 + (r >> 3)) * NTHR] = pk; } }
    attn_pass<0>(F.lds, base, (2 * h + 1) * 64, 1024 + (2 * h + 1) * 64, 2048 + h * 128, qb, btab + 132, O, ls BG_ARG);
    const float inv1 = lam / (ls + permswap_other(ls));
    float ss = 0.f;
#pragma unroll
    for (int db = 0; db < 4; ++db)
#pragma unroll
        for (int r8 = 0; r8 < 16; r8 += 8) { const u32x4 pk = stash[(db * 2 + (r8 >> 3)) * NTHR];
#pragma unroll
            for (int i = 0; i < 4; ++i) { const unsigned w = pk[i]; const int r = r8 + 2 * i;
                const float oa = bf16_lo(w) - O[db][r] * inv1, ob = bf16_hi(w) - O[db][r + 1] * inv1;
                O[db][r] = oa; O[db][r + 1] = ob; ss += oa * oa + ob * ob; } }
    ss += permswap_other(ss);
    const float rn = rsqrtf(ss * (1.0f / 128.0f) + SUBLN_EPS) * (1.0f - lam_init);
    const int q = qb * 256 + F.wave * 32 + r32;
    bf16_t* orow = mixin + (size_t)(b * S + q) * D + h * 128;
#pragma unroll
    for (int db = 0; db < 4; ++db)
#pragma unroll
        for (int g4 = 0; g4 < 4; ++g4) { const int d0 = 32 * db + 8 * g4 + 4 * hi; const f32x4 gv = *(const f32x4*)(subg + d0);
            u32x2 o; o.x = cvt_pk_bf16(O[db][4 * g4] * rn * gv[0], O[db][4 * g4 + 1] * rn * gv[1]); o.y = cvt_pk_bf16(O[db][4 * g4 + 2] * rn * gv[2], O[db][4 * g4 + 3] * rn * gv[3]);
            *(u32x2*)(orow + d0) = o; }
}
__device__ __forceinline__ void attn_unit_sb(const Frame& F, const bf16_t* __restrict__ proj, bf16_t* __restrict__ mixin, int b, int h, int qb) {
    const bf16_t* base = proj + (size_t)b * S * INC;
    const int hi = F.lane >> 5, r32 = F.lane & 31;
    f32x16 O[4]; float ls;
#ifdef MK_BGCONV
    BgConv bgc; bgc.next = BG_ITEMS; bgc.cur = -1; bgc.step = 0; bgc.mode = 0;
#pragma unroll
    for (int j = 0; j < 8; ++j) bgc.p[j] = (f32x2){0.f, 0.f};
#endif
    attn_pass<1>(F.lds, base, 3072 + h * 128, 4096 + h * 128, 5120 + h * 128, qb, nullptr, O, ls BG_ARG);
    const int q = qb * 256 + F.wave * 32 + r32;
    bf16_t* orow = mixin + (size_t)(b * S + q) * D + 1024 + h * 128;
#pragma unroll
    for (int db = 0; db < 4; ++db)
#pragma unroll
        for (int g4 = 0; g4 < 4; ++g4) { const int d0 = 32 * db + 8 * g4 + 4 * hi;
            u32x2 o; o.x = cvt_pk_bf16(O[db][4 * g4], O[db][4 * g4 + 1]); o.y = cvt_pk_bf16(O[db][4 * g4 + 2], O[db][4 * g4 + 3]);
            *(u32x2*)(orow + d0) = o; }
}
__device__ __forceinline__ void phase_attention(const Frame& F, const In& in, const Ws& w, int l, int mask = 3) {
    const float lam_init = 0.8f - 0.6f * expf(-0.3f * (float)l);
#ifdef MK_BGCONV
    BgConv bgc; bgc.wg = in.w_gate + (size_t)l * NE * D * DE; bgc.wu = in.w_up + (size_t)l * NE * D * DE; bgc.wd = in.w_down + (size_t)l * NE * DE * D;
    bgc.tgu = w.wt_gu + (size_t)l * NE * 2048 * D; bgc.td = w.wt_d + (size_t)l * NE * D * DE;
    bgc.next = ((mask & 1) && !(mask & 4)) ? (int)blockIdx.x * NWAVES + F.wave : BG_ITEMS; bgc.step = F.G * NWAVES; bgc.cur = -1; bgc.mode = mask >> 4;
#pragma unroll
    for (int j = 0; j < 8; ++j) bgc.p[j] = (f32x2){0.f, 0.f};
#endif
    for (int it = F.vcu; it < 512; it += F.G) {
        const int sb = it >> 8, i = it & 255, bh = i >> 3, pr = i & 7, b = bh >> 3, h = bh & 7;
        if (!((mask >> sb) & 1)) continue;
        if (!sb) {
            attn_unit_diff(F, w.proj, w.mixin, b, h, 15 - pr, in.relb, in.lam + l * 256, lam_init, in.subg + l * 128 BG_ARG);
            attn_unit_diff(F, w.proj, w.mixin, b, h, pr, in.relb, in.lam + l * 256, lam_init, in.subg + l * 128 BG_ARG);
        } else {
            attn_unit_sb(F, w.proj, w.mixin, b, h, 15 - pr);
            attn_unit_sb(F, w.proj, w.mixin, b, h, pr);
        }
    }
#ifdef MK_BGCONV
    while (bgc.next < BG_ITEMS) { bg_load(bgc, F.lane); bg_store(bgc, F.lane); }
#endif
}

#define ROWF4(base, j) ((f32x4*)((char*)(base) + (((j) < 4) ? of0 : of1) + ((j) & 3) * 1024))
#define ROWH4(base, j) ((u32x2*)((char*)(base) + oh0 + (j) * 512))
__device__ __forceinline__ void phase_router_t(const Frame& F, const In& in, const Ws& w) {
    const int gt = F.vcu * NTHR + F.tid, NGT = F.G * NTHR;
    for (int i = gt; i < DEPTH * 48 * D; i += NGT) { const int l = i / (48 * D), r = i % (48 * D), n = r / D, k = r % D;
        const float v = n < 4 ? in.w_group[((size_t)l * D + k) * 4 + n] : (n < 36 ? in.w_router[((size_t)l * D + k) * 32 + (n - 4)] : 0.f);
        const unsigned hi = cvt_pk_bf16(v, 0.f) & 0xffffu; const float lo = v - __uint_as_float(hi << 16);
        w.wt_rh[i] = (bf16_t)hi; w.wt_rl[i] = (bf16_t)(cvt_pk_bf16(lo, 0.f) & 0xffffu); }
}
__device__ __forceinline__ void phase_ln1_route(const Frame& F, const In& in, const Ws& w, int l) {
    const float* modl = w.mod + (size_t)l * NB * 6 * D;
    const float* lng = in.ln_g + (size_t)(l * 2) * D; const float* lnb = in.ln_b + (size_t)(l * 2) * D;
    const float* xin = l == 0 ? in.x : w.xa;
    const bf16_t* wh = w.wt_rh + (size_t)l * 48 * D; const bf16_t* wlo = w.wt_rl + (size_t)l * 48 * D;
    const float* bg = in.b_group + l * 4; const float* br = in.b_router + l * 32;
    int* cnt = (int*)(w.ctl + CTL_CNT) + l * 32;
    MK_LAS float* lg = (MK_LAS float*)F.lds;
    MK_LAS float* part = (MK_LAS float*)(F.lds + 16384);
    for (int pass = F.vcu; pass < M / 64; pass += F.G) {
        const int t0 = pass * 64;
        {
            const int tw = t0 + F.wave * 8;
            const float* mb = modl + (size_t)(tw / S) * 6 * D;
            const unsigned of0 = (unsigned)F.lane * 16u, of1 = of0 + 4096u, oh0 = (unsigned)F.lane * 8u;
            f32x4 xv[8]; u32x2 mv[8];
#ifdef MK_BF16RES
            u32x2 xh[8];
            const bf16_t* xinh = (const bf16_t*)w.xa;
#define LN1_LOADX(t_) do { if (l == 0) { const float* xr = xin + (size_t)(t_) * D; _Pragma("unroll") for (int j = 0; j < 8; ++j) xv[j] = *ROWF4(xr, j); } \
                           else { const bf16_t* xr = xinh + (size_t)(t_) * D; _Pragma("unroll") for (int j = 0; j < 8; ++j) xh[j] = *ROWH4(xr, j); } } while (0)
#define LN1_X(j) (l == 0 ? xv[j] : (f32x4){bf16_lo(xh[j].x), bf16_hi(xh[j].x), bf16_lo(xh[j].y), bf16_hi(xh[j].y)})
#else
#define LN1_LOADX(t_) do { const float* xr = xin + (size_t)(t_) * D; _Pragma("unroll") for (int j = 0; j < 8; ++j) xv[j] = *ROWF4(xr, j); } while (0)
#define LN1_X(j) xv[j]
#endif
            { const bf16_t* mr = w.mixb + (size_t)tw * D; LN1_LOADX(tw);
#pragma unroll
              for (int j = 0; j < 8; ++j) { mv[j] = *ROWH4(mr, j); } }
#pragma unroll 1
            for (int i = 0; i < 8; ++i) {
                const int t = tw + i;
                f32x4 v[8]; float s = 0.f;
#pragma unroll
                for (int j = 0; j < 8; ++j) { const f32x4 g1 = *ROWF4(mb + 2 * D, j) + 1.0f;
                    f32x4 mx; mx[0] = bf16_lo(mv[j].x); mx[1] = bf16_hi(mv[j].x); mx[2] = bf16_lo(mv[j].y); mx[3] = bf16_hi(mv[j].y);
                    v[j] = LN1_X(j) * ALPHA + g1 * mx; s += (v[j][0] + v[j][1]) + (v[j][2] + v[j][3]); }
                if (i < 7) {
                    const bf16_t* mr = w.mixb + (size_t)(t + 1) * D; LN1_LOADX(t + 1);
#pragma unroll
                    for (int j = 0; j < 8; ++j) { mv[j] = *ROWH4(mr, j); }
                }
                const float mu = wave_sum(s) * (1.0f / D);
                float s2 = 0.f;
#pragma unroll
                for (int j = 0; j < 8; ++j) { v[j] = v[j] - mu; s2 += (v[j][0] * v[j][0] + v[j][1] * v[j][1]) + (v[j][2] * v[j][2] + v[j][3] * v[j][3]); }
                const float rs = rsqrtf(wave_sum(s2) * (1.0f / D) + LN_EPS);
                float* x1r = w.x1 + (size_t)t * D; bf16_t* abr = w.ab + (size_t)t * D; bf16_t* alr = w.ablo + (size_t)t * D;
#pragma unroll
                for (int j = 0; j < 8; ++j) {
                    const f32x4 gg = *ROWF4(lng, j), bb = *ROWF4(lnb, j);
                    const f32x4 xo = v[j] * rs * gg + bb;
#ifdef MK_BF16RES
                    { u32x2 xp; xp.x = cvt_pk_bf16(xo[0], xo[1]); xp.y = cvt_pk_bf16(xo[2], xo[3]); *ROWH4((bf16_t*)w.x1 + (size_t)t * D, j) = xp; }
#else
                    *ROWF4(x1r, j) = xo;
#endif
                    const f32x4 sh = *ROWF4(mb + 3 * D, j), scv = *ROWF4(mb + 4 * D, j);
                    const f32x4 u = xo * (scv + 1.0f) + sh;
                    u32x2 o; o.x = cvt_pk_bf16(u[0], u[1]); o.y = cvt_pk_bf16(u[2], u[3]);
                    *ROWH4(abr, j) = o;
                    u32x2 ol; ol.x = cvt_pk_bf16(u[0] - bf16_lo(o.x), u[1] - bf16_hi(o.x)); ol.y = cvt_pk_bf16(u[2] - bf16_lo(o.y), u[3] - bf16_hi(o.y));
                    *ROWH4(alr, j) = ol; }
            }
        }
#undef LN1_LOADX
#undef LN1_X
        asm volatile("s_waitcnt vmcnt(0)" ::: "memory");
        __syncthreads();
        {
            const int rt = F.wave & 3, kh = F.wave >> 2, fr = F.lane & 15, fq = F.lane >> 4;
            const bf16_t* ah = w.ab + (size_t)(t0 + rt * 16 + fr) * D + kh * 1024 + fq * 8;
            const bf16_t* al = w.ablo + (size_t)(t0 + rt * 16 + fr) * D + kh * 1024 + fq * 8;
            const bf16_t* bh = wh + (size_t)fr * D + kh * 1024 + fq * 8;
            const bf16_t* bl = wlo + (size_t)fr * D + kh * 1024 + fq * 8;
            f32x4 acc[3];
#pragma unroll
            for (int nt = 0; nt < 3; ++nt) acc[nt] = (f32x4){0.f, 0.f, 0.f, 0.f};
#pragma unroll 4
            for (int sidx = 0; sidx < 32; ++sidx) {
                const bf16x8 fah = *(const bf16x8*)(ah + sidx * 32), fal = *(const bf16x8*)(al + sidx * 32);
#pragma unroll
                for (int nt = 0; nt < 3; ++nt) { const bf16x8 fbh = *(const bf16x8*)(bh + (size_t)nt * 16 * D + sidx * 32), fbl = *(const bf16x8*)(bl + (size_t)nt * 16 * D + sidx * 32);
                    acc[nt] = __builtin_amdgcn_mfma_f32_16x16x32_bf16(fah, fbh, acc[nt], 0, 0, 0);
                    acc[nt] = __builtin_amdgcn_mfma_f32_16x16x32_bf16(fah, fbl, acc[nt], 0, 0, 0);
                    acc[nt] = __builtin_amdgcn_mfma_f32_16x16x32_bf16(fal, fbh, acc[nt], 0, 0, 0); }
            }
            if (kh == 1) {
#pragma unroll
                for (int nt = 0; nt < 3; ++nt) *(MK_LAS f32x4*)(part + ((rt * 3 + nt) * 64 + F.lane) * 4) = acc[nt];
            }
            __syncthreads();
            if (kh == 0) {
#pragma unroll
                for (int nt = 0; nt < 3; ++nt) { const f32x4 o = acc[nt] + *(const MK_LAS f32x4*)(part + ((rt * 3 + nt) * 64 + F.lane) * 4);
#pragma unroll
                    for (int r = 0; r < 4; ++r) lg[(rt * 16 + fq * 4 + r) * 49 + nt * 16 + fr] = o[r]; }
            }
            __syncthreads();
        }
        if (F.tid < 64) {
            const int t = t0 + F.tid; const MK_LAS float* lr = lg + F.tid * 49;
            float gl[4]; int gi = 0;
#pragma unroll
            for (int i = 0; i < 4; ++i) gl[i] = lr[i] + bg[i];
            float gm = gl[0];
#pragma unroll
            for (int i = 1; i < 4; ++i) if (gl[i] > gm) { gm = gl[i]; gi = i; }
            float gsum = 0.f;
#pragma unroll
            for (int i = 0; i < 4; ++i) gsum += expf(gl[i] - gm);
            const float gp = 1.0f / gsum;
            float el[8];
#pragma unroll
            for (int j = 0; j < 8; ++j) el[j] = lr[4 + gi * 8 + j] + br[gi * 8 + j];
            int i0 = 0; float v0 = el[0];
#pragma unroll
            for (int j = 1; j < 8; ++j) if (el[j] > v0) { v0 = el[j]; i0 = j; }
            int i1 = 0; float v1 = -INFINITY;
#pragma unroll
            for (int j = 0; j < 8; ++j) if (j != i0 && el[j] > v1) { v1 = el[j]; i1 = j; }
            const float e1 = expf(v1 - v0);
            const float w0 = gp / (1.0f + e1), w1 = gp * e1 / (1.0f + e1);
            const int ea = gi * 8 + i0, eb = gi * 8 + i1;
            const int ra = atomicAdd(&cnt[ea], 1), rb = atomicAdd(&cnt[eb], 1);
            w.tok_of[ea * M + ra] = t; w.tok_of[eb * M + rb] = t;
            *(int4*)(w.tokinfo + 4 * t) = make_int4(ea, ra, eb, rb);
            *(float2*)(w.tokw + 2 * t) = make_float2(w0, w1);
        }
        __syncthreads();
    }
}

__device__ __forceinline__ void moe_tables(const Frame& F, const Ws& w, int l) {
    MK_LAS int* pexp = (MK_LAS int*)(F.lds + LDS_PEXP);
    MK_LAS int* pbase = (MK_LAS int*)(F.lds + LDS_PBASE);
    MK_LAS int* cl = (MK_LAS int*)(F.lds + LDS_CNT);
    const int* cnt = (const int*)(w.ctl + CTL_CNT) + l * 32;
    __syncthreads();
    if (F.tid < 32) cl[F.tid] = cnt[F.tid];
    __syncthreads();
    if (F.tid == 0) { int p = 0; for (int e = 0; e < NE; ++e) { pbase[e] = p; const int np = (cl[e] + 255) >> 8; for (int i = 0; i < np; ++i) pexp[p + i] = e; p += np; } pbase[NE] = p; }
    __syncthreads();
}
template <class Sched>
__device__ __forceinline__ void moe_gather_table(const Frame& F, const Ws& w, const Sched& Sc) {
    MK_LAS int* tokl = (MK_LAS int*)(F.lds + LDS_TOKL);
    const MK_LAS int* pbase = (const MK_LAS int*)(F.lds + LDS_PBASE);
    const MK_LAS int* cl = (const MK_LAS int*)(F.lds + LDS_CNT);
    for (int i = 0; i < MAXU; ++i) { Unit u; if (!Sc.next(i, u)) break;
        if (F.tid < 256) { const int e = u.e; int rank = (u.pm - pbase[e]) * 256 + F.tid; const int ce = cl[e]; rank = rank < ce ? rank : ce - 1;
            tokl[i * 256 + F.tid] = w.tok_of[e * M + rank]; } }
    __syncthreads();
}

__device__ __forceinline__ void phase_ln2(const Frame& F, const In& in, const Ws& w, int l, float* __restrict__ xout, const float* __restrict__ nmod) {
    const float* modl = w.mod + (size_t)l * NB * 6 * D;
    const float* lng = in.ln_g + (size_t)(l * 2 + 1) * D; const float* lnb = in.ln_b + (size_t)(l * 2 + 1) * D;
    const MK_LAS int* pbase = (const MK_LAS int*)(F.lds + LDS_PBASE);
    const int gw = F.vcu * NWAVES + F.wave, NGW = F.G * NWAVES;
    const unsigned of0 = (unsigned)F.lane * 16u, of1 = of0 + 4096u, oh0 = (unsigned)F.lane * 8u;
    for (int tb = gw * 8; tb < M; tb += NGW * 8) {
        const int bidx = tb / S;
        const float* mb = modl + (size_t)bidx * 6 * D;
#ifdef MK_BF16RES
        u32x2 xv[8], ya[8], yb[8]; float2 tw, tw_n;
#define LN2_LOADX(_xr, j) xv[j] = *ROWH4((const bf16_t*)w.x1 + (size_t)(_xr) * D, j)
#define LN2_X(j) ((f32x4){bf16_lo(xv[j].x), bf16_hi(xv[j].x), bf16_lo(xv[j].y), bf16_hi(xv[j].y)})
#else
        f32x4 xv[8]; u32x2 ya[8], yb[8]; float2 tw, tw_n;
#define LN2_LOADX(_xr, j) xv[j] = *ROWF4(w.x1 + (size_t)(_xr) * D, j)
#define LN2_X(j) xv[j]
#endif
#define LN2_FETCH(t) do { const int4 _ti = *(const int4*)(w.tokinfo + 4 * (t)); tw_n = *(const float2*)(w.tokw + 2 * (t)); \
            const int _r0 = __builtin_amdgcn_readfirstlane(pbase[_ti.x] * 256 + _ti.y), _r1 = __builtin_amdgcn_readfirstlane(pbase[_ti.z] * 256 + _ti.w); \
            const bf16_t* _y0 = w.Yb + (size_t)_r0 * D; const bf16_t* _y1 = w.Yb + (size_t)_r1 * D; \
            _Pragma("unroll") for (int j = 0; j < 8; ++j) { LN2_LOADX(t, j); ya[j] = *ROWH4(_y0, j); yb[j] = *ROWH4(_y1, j); } } while (0)
        LN2_FETCH(tb); tw = tw_n;
#pragma unroll 1
        for (int i = 0; i < 8; ++i) {
            const int t = tb + i;
            f32x4 v[8]; float s = 0.f;
#pragma unroll
            for (int j = 0; j < 8; ++j) {
                const u32x2 a = ya[j], c2 = yb[j];
                f32x4 y; y[0] = tw.x * bf16_lo(a.x) + tw.y * bf16_lo(c2.x); y[1] = tw.x * bf16_hi(a.x) + tw.y * bf16_hi(c2.x);
                y[2] = tw.x * bf16_lo(a.y) + tw.y * bf16_lo(c2.y); y[3] = tw.x * bf16_hi(a.y) + tw.y * bf16_hi(c2.y);
                const f32x4 g2 = *ROWF4(mb + 5 * D, j) + 1.0f;
                v[j] = LN2_X(j) * ALPHA + g2 * y;
                s += (v[j][0] + v[j][1]) + (v[j][2] + v[j][3]); }
            if (i < 7) { LN2_FETCH(t + 1); }
            const float mu = wave_sum(s) * (1.0f / D);
            float s2 = 0.f;
#pragma unroll
            for (int j = 0; j < 8; ++j) { v[j] = v[j] - mu; s2 += (v[j][0] * v[j][0] + v[j][1] * v[j][1]) + (v[j][2] * v[j][2] + v[j][3] * v[j][3]); }
            const float rs = rsqrtf(wave_sum(s2) * (1.0f / D) + LN_EPS);
            float* xor_ = xout + (size_t)t * D; bf16_t* abr = w.ab + (size_t)t * D;
#pragma unroll
            for (int j = 0; j < 8; ++j) {
                const f32x4 gg = *ROWF4(lng, j), bb = *ROWF4(lnb, j);
                const f32x4 xo = v[j] * rs * gg + bb;
#ifdef MK_BF16RES
                if (nmod) { u32x2 xp; xp.x = cvt_pk_bf16(xo[0], xo[1]); xp.y = cvt_pk_bf16(xo[2], xo[3]); *ROWH4((bf16_t*)xout + (size_t)t * D, j) = xp; }
                else *ROWF4(xor_, j) = xo;
#else
                *ROWF4(xor_, j) = xo;
#endif
                if (nmod) { const float* nb = nmod + (size_t)bidx * 6 * D; const f32x4 sh = *ROWF4(nb, j), scv = *ROWF4(nb + D, j);
                    const f32x4 u = xo * (scv + 1.0f) + sh; u32x2 o; o.x = cvt_pk_bf16(u[0], u[1]); o.y = cvt_pk_bf16(u[2], u[3]); *ROWH4(abr, j) = o; }
            }
            tw = tw_n;
        }
#undef LN2_FETCH
#undef LN2_LOADX
#undef LN2_X
    }
}
struct Args { In in; Ws w; float* out; int l, cv_lo, cv_hi, pad; };

__device__ __forceinline__ Frame make_frame(unsigned char* lds_generic) {
    Frame F; F.lds = (MK_LAS unsigned char*)lds_generic;
    F.tid = ltid(); F.lane = F.tid & 63; F.wave = __builtin_amdgcn_readfirstlane(F.tid >> 6);
    F.G = gridDim.x; { const int bx = blockIdx.x; F.vcu = (F.G % 8 == 0) ? (bx % 8) * (F.G / 8) + bx / 8 : bx; }
    return F;
}

template <int PH>
__device__ __forceinline__ void run_phase(const Frame& F, const Args& a, int l) {
    const In& in = a.in; const Ws& w = a.w;
    if constexpr (PH == 0) { phase_convert(F, in, w, a.cv_lo, a.cv_hi); phase_mod(F, in, w); phase_router_t(F, in, w); }
    if constexpr (PH == 1) { phase_modulate(F, in.x, w.mod, w.ab); }
    if constexpr (PH == 2) { SchedDense Sd; Sd.init(w.ab, w.wt_in + (size_t)l * INC * D, M, INC, D, F.G, (int)blockIdx.x); EpiProj E{w.proj}; gemm_phase(F.lds, D, Sd, E); }
    if constexpr (PH == 3) { phase_attention(F, in, w, l); }
    if constexpr (PH == 31) { phase_attention(F, in, w, l, 1); }
    if constexpr (PH == 32) { phase_attention(F, in, w, l, 2); }
    if constexpr (PH == 34) { phase_attention(F, in, w, l, 3 | 16); }
    if constexpr (PH == 35) { phase_attention(F, in, w, l, 3 | 32); }
    if constexpr (PH == 33) { phase_attention(F, in, w, l, 7); }
    if constexpr (PH == 4) { SchedDense Sd; Sd.init(w.mixin, w.wt_o + (size_t)l * D * D, M, D, D, F.G, (int)blockIdx.x);
        EpiDown E{w.mixb}; gemm_phase(F.lds, D, Sd, E); }
    if constexpr (PH == 5) { phase_ln1_route(F, in, w, l); }
    if constexpr (PH == 6) { moe_tables(F, w, l);
        SchedMoe<true> Sm; Sm.A = w.ab; Sm.Bt = w.wt_gu + (size_t)l * NE * 2048 * D; Sm.estride = (size_t)2048 * D; Sm.K = D;
        Sm.nunits = ((const MK_LAS int*)(F.lds + LDS_PBASE))[NE] * 8; Sm.G = F.G; Sm.c = (int)blockIdx.x;
        Sm.pexp = (const MK_LAS int*)(F.lds + LDS_PEXP); Sm.tokl = (const MK_LAS int*)(F.lds + LDS_TOKL);
        moe_gather_table(F, w, Sm);
#ifdef MK_F32B_UP
        BSrcUp Bu{in.w_gate + (size_t)l * NE * D * DE, in.w_up + (size_t)l * NE * D * DE, (size_t)D * DE, DE};
        EpiGU E{w.Hb}; gemm_phase_fb(F.lds, D, Sm, Bu, E); }
#else
        EpiGU E{w.Hb}; gemm_phase(F.lds, D, Sm, E); }
#endif
    if constexpr (PH >= 60 && PH <= 69) { moe_tables(F, w, l);
        SchedMoe<true> Sm; Sm.A = w.ab; Sm.Bt = w.wt_gu + (size_t)l * NE * 2048 * D; Sm.estride = (size_t)2048 * D; Sm.K = D;
        Sm.nunits = ((const MK_LAS int*)(F.lds + LDS_PBASE))[NE] * 8; Sm.G = F.G; Sm.c = (int)blockIdx.x;
        Sm.pexp = (const MK_LAS int*)(F.lds + LDS_PEXP); Sm.tokl = (const MK_LAS int*)(F.lds + LDS_TOKL);
        moe_gather_table(F, w, Sm);
        BSrcUp Bu{in.w_gate + (size_t)l * NE * D * DE, in.w_up + (size_t)l * NE * D * DE, (size_t)D * DE, DE};
        EpiGU E{w.wt_gu}; gemm_phase_fb<PH - 60>(F.lds, D, Sm, Bu, E); }
    if constexpr (PH >= 70 && PH <= 79) { moe_tables(F, w, l);
        SchedMoe<false> Sm; Sm.A = w.Hb; Sm.Bt = w.wt_d + (size_t)l * NE * D * DE; Sm.estride = (size_t)D * DE; Sm.K = DE;
        Sm.nunits = ((const MK_LAS int*)(F.lds + LDS_PBASE))[NE] * 8; Sm.G = F.G; Sm.c = (int)blockIdx.x;
        Sm.pexp = (const MK_LAS int*)(F.lds + LDS_PEXP); Sm.tokl = nullptr;
        BSrcDown Bd{in.w_down + (size_t)l * NE * DE * D, (size_t)DE * D, D};
        EpiDown E{w.wt_gu}; gemm_phase_fb<PH - 70>(F.lds, DE, Sm, Bd, E); }
    if constexpr (PH == 7) { moe_tables(F, w, l);
        SchedMoe<false> Sm; Sm.A = w.Hb; Sm.Bt = w.wt_d + (size_t)l * NE * D * DE; Sm.estride = (size_t)D * DE; Sm.K = DE;
        Sm.nunits = ((const MK_LAS int*)(F.lds + LDS_PBASE))[NE] * 8; Sm.G = F.G; Sm.c = (int)blockIdx.x;
        Sm.pexp = (const MK_LAS int*)(F.lds + LDS_PEXP); Sm.tokl = nullptr;
#ifdef MK_F32B_DOWN
        BSrcDown Bd{in.w_down + (size_t)l * NE * DE * D, (size_t)DE * D, D};
        EpiDown E{w.Yb}; gemm_phase_fb(F.lds, DE, Sm, Bd, E); }
#else
        EpiDown E{w.Yb}; gemm_phase(F.lds, DE, Sm, E); }
#endif
    if constexpr (PH == 8) { moe_tables(F, w, l);
        phase_ln2(F, in, w, l, l == DEPTH - 1 ? a.out : w.xa, l == DEPTH - 1 ? nullptr : w.mod + (size_t)(l + 1) * NB * 6 * D); }
}

template <int PH>
__global__ void __launch_bounds__(NTHR, 2) k_phase(Args a) {
    extern __shared__ __attribute__((aligned(16))) unsigned char lds_raw[];
    const Frame F = make_frame(lds_raw);
    run_phase<PH>(F, a, a.l);
}

static inline Ws carve(char* base, size_t& end, int nlw = DEPTH) {
    Ws w; size_t o = 0;
    auto take = [&](size_t bytes) { char* p = base + o; o += (bytes + 255) & ~(size_t)255; return p; };
    w.ctl = (unsigned*)take((size_t)CTL_WORDS * 4);
    w.mod = (float*)take((size_t)DEPTH * NB * 6 * D * 4);
    w.wt_in = (bf16_t*)take((size_t)nlw * INC * D * 2);
    w.wt_o = (bf16_t*)take((size_t)nlw * D * D * 2);
    w.ab = (bf16_t*)take((size_t)M * D * 2);
    w.proj = (bf16_t*)take((size_t)M * INC * 2);
    w.mixin = (bf16_t*)take((size_t)M * D * 2);
    w.mixb = (bf16_t*)take((size_t)M * D * 2);
    w.ablo = (bf16_t*)take((size_t)M * D * 2);
    w.x1 = (float*)take((size_t)M * D * 4);
    w.xa = (float*)take((size_t)M * D * 4);
    w.Hb = (bf16_t*)take((size_t)PROWS * DE * 2);
    w.Yb = (bf16_t*)take((size_t)PROWS * D * 2);
    w.tok_of = (int*)take((size_t)NE * M * 4);
    w.tokinfo = (int*)take((size_t)M * 16);
    w.tokw = (float*)take((size_t)M * 8);
    w.wt_rh = (bf16_t*)take((size_t)DEPTH * 48 * D * 2);
    w.wt_rl = (bf16_t*)take((size_t)DEPTH * 48 * D * 2);
    w.wt_gu = (bf16_t*)take((size_t)nlw * NE * 2048 * D * 2);
    w.wt_d = (bf16_t*)take((size_t)nlw * NE * D * DE * 2);
    end = o; return w;
}
static inline In make_in(void* const* d_in) {
    In in; const float* const* p = (const float* const*)d_in;
    in.x = p[0]; in.c = p[1]; in.w_ada = p[2]; in.b_ada = p[3]; in.w_in = p[4]; in.lam = p[5]; in.subg = p[6]; in.relb = p[7]; in.w_o = p[8]; in.ln_g = p[9]; in.ln_b = p[10];
    in.w_group = p[11]; in.b_group = p[12]; in.w_router = p[13]; in.b_router = p[14]; in.w_gate = p[15]; in.w_up = p[16]; in.w_down = p[17];
    return in;
}
template <int PH>
static inline void launch_phase(const Args& a, int grid, hipStream_t st) {
    static bool attr = false;
    if (!attr) { attr = true; (void)hipFuncSetAttribute((const void*)k_phase<PH>, hipFuncAttributeMaxDynamicSharedMemorySize, LDS_BYTES); }
    hipLaunchKernelGGL(k_phase<PH>, dim3(grid), dim3(NTHR), LDS_BYTES, st, a);
}
}
namespace mk {
typedef const __attribute__((address_space(4))) Args* KArgsPtr;
__device__ __forceinline__ void load_args(Args& a) {
    KArgsPtr p = (KArgsPtr)__builtin_amdgcn_kernarg_segment_ptr();
    asm volatile("" : "+s"(p));
    __builtin_memcpy(&a, p, sizeof(Args));
}
#ifndef MK_REPEAT_PH
#define MK_REPEAT_PH -1
#endif
#define MK_PHASE1(PH, l) do { Args _a; load_args(_a); const Frame _F = make_frame(lds_raw); run_phase<PH>(_F, _a, (l)); } while (0)
#ifndef MK_REPEAT_AS
#define MK_REPEAT_AS MK_REPEAT_PH
#endif
#ifndef MK_REPEAT_N
#define MK_REPEAT_N 1
#endif
#define MK_PHASE(PH, l) do { MK_PHASE1(PH, l); if ((PH) == MK_REPEAT_PH && (l) == 0) { MK_BARRIER(); MK_PHASE1(MK_REPEAT_AS, l); if (MK_REPEAT_N > 1) { MK_BARRIER(); MK_PHASE1(MK_REPEAT_AS, l); } } } while (0)
#define MK_BARRIER() do { Args _a; load_args(_a); XcdBarrier _b; _b.bar = _a.w.ctl; _b.x = xb_xcc_id(); _b.st = (volatile LAS unsigned*)(F.lds + LDS_MISC); xcd_barrier(_b); } while (0)
__global__ void __launch_bounds__(NTHR, 2) k_mega(Args a) {
    extern __shared__ __attribute__((aligned(16))) unsigned char lds_raw[];
    const Frame F = make_frame(lds_raw);
    if (F.tid < 16) ((MK_LAS unsigned*)(F.lds + LDS_MISC))[F.tid] = 0u;
    __syncthreads();
    (void)xcd_barrier_post(a.w.ctl, (volatile LAS unsigned*)(F.lds + LDS_MISC));
    MK_PHASE(0, 0); MK_BARRIER();
    MK_PHASE(1, 0); MK_BARRIER();
#define MK_LAYER(l, last) do { \
        MK_PHASE(2, l); MK_BARRIER(); MK_PHASE(3, l); MK_BARRIER(); MK_PHASE(4, l); MK_BARRIER(); MK_PHASE(5, l); MK_BARRIER(); \
        MK_PHASE(6, l); MK_BARRIER(); MK_PHASE(7, l); MK_BARRIER(); MK_PHASE(8, l); if (!(last)) MK_BARRIER(); } while (0)
    MK_LAYER(0, false);
    MK_LAYER(1, true);
}
}

extern "C" void kernel_launch(void* const* d_in, const int* in_sizes, int n_in, void* d_out, int out_size, void* d_ws, size_t ws_size, hipStream_t stream) {
    static int grid = 0;
    if (grid == 0) {
        int dev = 0, cus = 0, per_cu = 0;
        (void)hipGetDevice(&dev); (void)hipDeviceGetAttribute(&cus, hipDeviceAttributeMultiprocessorCount, dev);
        if (hipFuncSetAttribute((const void*)mk::k_mega, hipFuncAttributeMaxDynamicSharedMemorySize, mk::LDS_BYTES) != hipSuccess) { fprintf(stderr, "kernel_launch: hipFuncSetAttribute failed\n"); grid = -1; return; }
        if (hipOccupancyMaxActiveBlocksPerMultiprocessor(&per_cu, (const void*)mk::k_mega, mk::NTHR, mk::LDS_BYTES) != hipSuccess || per_cu < 1)
            fprintf(stderr, "kernel_launch: occupancy query reports %d workgroups per CU\n", per_cu);
        (void)hipGetLastError();
        grid = cus > 0 ? cus : 256;
    }
    if (grid < 0) return;
    size_t end = 0;
    mk::Ws w = mk::carve((char*)d_ws, end, mk::DEPTH);
    if (end > ws_size) { fprintf(stderr, "kernel_launch: workspace too small: need %zu, have %zu\n", end, ws_size); return; }
    (void)hipMemsetAsync(w.ctl, 0, (size_t)mk::CTL_WORDS * 4, stream);
    mk::Args a; memset(&a, 0, sizeof(a));
    a.in = mk::make_in(d_in); a.w = w; a.out = (float*)d_out; a.l = 0; a.cv_lo = 0; a.cv_hi = mk::DEPTH * mk::CI_LAYER;
#ifdef MK_MULTI
    mk::launch_phase<0>(a, grid, stream); mk::launch_phase<1>(a, grid, stream);
    for (int l = 0; l < mk::DEPTH; ++l) { a.l = l;
        mk::launch_phase<2>(a, grid, stream); mk::launch_phase<3>(a, grid, stream); mk::launch_phase<4>(a, grid, stream); mk::launch_phase<5>(a, grid, stream);
        mk::launch_phase<6>(a, grid, stream); mk::launch_phase<7>(a, grid, stream); mk::launch_phase<8>(a, grid, stream); }
#else
    hipLaunchKernelGGL(mk::k_mega, dim3(grid), dim3(mk::NTHR), mk::LDS_BYTES, stream, a);
#endif
}
```

```cpp
#include <hip/hip_runtime.h>
#include <hip/hip_bf16.h>
#include <cstdio>
#include <cstdint>
#include <cmath>
#include <cstring>
#define MK_BGCONV 2
#define MK_BGMASK 1
#define MK_F32B_DOWN 1
#define MK_BF16RES 1
#define MK_BGSPREAD 1
#define MK_RANKAGG 1
#define XB_TMO      128
#define XB_XCNT(j)  (256  + 64 * (j))
#define XB_XSUB(j)  (1280 + 64 * (j))
#define XB_XGEN(j)  (2304 + 64 * (j))
#define XB_TOP      3328
#define XB_TOPGEN   3392
#define XCD_BAR_WORDS 3456
#define XB_SPIN_CAP (1u << 22)
#define LAS __attribute__((address_space(3)))

__device__ __forceinline__ unsigned xb_ld(unsigned* p)              { return __hip_atomic_load(p, __ATOMIC_RELAXED, __HIP_MEMORY_SCOPE_AGENT); }
__device__ __forceinline__ unsigned xb_add(unsigned* p, unsigned v) { return __hip_atomic_fetch_add(p, v, __ATOMIC_RELAXED, __HIP_MEMORY_SCOPE_AGENT); }
__device__ __forceinline__ unsigned xb_xcc_id() { return (unsigned)__builtin_amdgcn_s_getreg((3 << 11) | 20) & 0xFu; }
#define XB_SPIN(cond, bar) do { unsigned _sp = 0; while (cond) { __builtin_amdgcn_s_sleep(1); \
    if ((++_sp & 255u) == 0u) { if (xb_ld(&(bar)[XB_TMO])) break; if (_sp > XB_SPIN_CAP) { atomicAdd(&(bar)[XB_TMO], 1u); break; } } } } while (0)

struct XcdBarrier {
    unsigned* bar; unsigned x;
    volatile LAS unsigned* st;
};

__device__ __forceinline__ XcdBarrier xcd_barrier_post(unsigned* bar, volatile LAS unsigned* st) {
    XcdBarrier b; b.bar = bar; b.x = xb_xcc_id(); b.st = st;
    if (threadIdx.x == 0) (void)xb_add(&bar[XB_XCNT(b.x)], 1u);
    return b;
}
__device__ __forceinline__ void xcd_barrier_complete(unsigned* bar, unsigned x, unsigned& nloc, unsigned& nx) {
    const unsigned G = gridDim.x * gridDim.y * gridDim.z;
    unsigned sum, cnt, mine, sp = 0u;
    for (;;) {
        sum = 0u; cnt = 0u; mine = 0u;
#pragma unroll
        for (unsigned j = 0; j < 16; ++j) { const unsigned c = xb_ld(&bar[XB_XCNT(j)]); sum += c; cnt += (c > 0u) ? 1u : 0u; mine = (j == x) ? c : mine; }
        if (sum == G) break;
        __builtin_amdgcn_s_sleep(1);
        if ((++sp & 255u) == 0u) { if (xb_ld(&bar[XB_TMO])) break; if (sp > XB_SPIN_CAP) { atomicAdd(&bar[XB_TMO], 1u); break; } }
    }
    nloc = mine > 0u ? mine : 1u; nx = cnt > 0u ? cnt : 1u;
}

__device__ __forceinline__ void xcd_barrier(const XcdBarrier& b) {
    asm volatile("s_waitcnt vmcnt(0)" ::: "memory");
    __syncthreads();
    if (threadIdx.x == 0) {
        unsigned* bar = b.bar;
        __builtin_amdgcn_s_waitcnt(0);
        unsigned nloc = b.st[0], nx = b.st[1];
        if (nloc == 0u) { xcd_barrier_complete(bar, b.x, nloc, nx); b.st[0] = nloc; b.st[1] = nx; }
        const unsigned old = xb_add(&bar[XB_XSUB(b.x)], 1u);
        const unsigned gen = old / nloc;
        if (old + 1u == (gen + 1u) * nloc) {
            __builtin_amdgcn_fence(__ATOMIC_RELEASE, "agent");
            asm volatile("s_waitcnt vmcnt(0)" ::: "memory");
            const unsigned og = xb_add(&bar[XB_TOP], 1u);
            const unsigned tg = og / nx;
            if (og + 1u == (tg + 1u) * nx) xb_add(&bar[XB_TOPGEN], 1u);
            else XB_SPIN(xb_ld(&bar[XB_TOPGEN]) == tg, bar);
            __builtin_amdgcn_fence(__ATOMIC_ACQUIRE, "agent");
            xb_add(&bar[XB_XGEN(b.x)], 1u);
            asm volatile("s_waitcnt vmcnt(0)" ::: "memory");
        } else {
            XB_SPIN(xb_ld(&bar[XB_XGEN(b.x)]) == gen, bar);
            __builtin_amdgcn_fence(__ATOMIC_ACQUIRE, "agent");
            asm volatile("s_waitcnt vmcnt(0)" ::: "memory");
        }
    }
    __syncthreads();
}

namespace mk {
#define MK_LAS __attribute__((address_space(3)))
typedef unsigned short bf16_t;
typedef short bf16x8 __attribute__((ext_vector_type(8)));
typedef short s16x4 __attribute__((ext_vector_type(4)));
typedef float f32x2 __attribute__((ext_vector_type(2)));
typedef float f32x4 __attribute__((ext_vector_type(4)));
typedef float f32x16 __attribute__((ext_vector_type(16)));
typedef unsigned u32x2 __attribute__((ext_vector_type(2)));
typedef unsigned u32x4 __attribute__((ext_vector_type(4)));

constexpr int D = 2048, NB = 4, S = 4096, M = NB * S, INC = 6144, NE = 32, DE = 1024, NH = 8, DEPTH = 2;
constexpr int NWAVES = 8, NTHR = 512;
constexpr float LOG2E = 1.4426950408889634f;
constexpr float LN_EPS = 1e-5f, SUBLN_EPS = 1e-5f;
constexpr float ALPHA = 1.4142135623730951f;
constexpr int PMAXP = 161;
constexpr int PROWS = PMAXP * 256;
constexpr int MAXU = 8;

__device__ __forceinline__ unsigned cvt_pk_bf16(float lo, float hi) { unsigned r; asm volatile("v_cvt_pk_bf16_f32 %0, %1, %2" : "=v"(r) : "v"(lo), "v"(hi)); return r; }
typedef __bf16 bf16v2 __attribute__((ext_vector_type(2)));
__device__ __forceinline__ unsigned cvt_pk_bf16_c(float lo, float hi) { const f32x2 v = {lo, hi}; return __builtin_bit_cast(unsigned, __builtin_convertvector(v, bf16v2)); }
__device__ __forceinline__ float bf16_lo(unsigned w) { return __uint_as_float(w << 16); }
__device__ __forceinline__ float bf16_hi(unsigned w) { return __uint_as_float(w & 0xffff0000u); }
__device__ __forceinline__ float wave_sum(float v) {
#pragma unroll
    for (int o = 1; o < 64; o <<= 1) v += __shfl_xor(v, o);
    return v;
}
__device__ __forceinline__ int ltid() { int t = threadIdx.x; asm volatile("" : "+v"(t)); return t; }
__device__ __forceinline__ int crow(int r, int hi) { return (r & 3) + 8 * (r >> 2) + 4 * hi; }

constexpr int BM = 256, BK = 64, HALF = 128, HTB = HALF * BK * 2, STAGE_BYTES = 8 * HTB, NXCD = 8, WGM = 8;
__host__ __device__ __forceinline__ int lds_byte(int r, int c) { const int st = (r >> 4) * 2 + (c >> 5), rr = r & 15, cc = c & 31, ob = rr * 64 + cc * 2; return st * 1024 + (ob ^ (((ob >> 9) & 1) << 5)); }
__host__ __device__ __forceinline__ void stage_rc(int b, int& R, int& C) { const int st = b / 1024, sb = b % 1024, swz = sb ^ (((sb >> 9) & 1) << 5); R = (st >> 1) * 16 + swz / 64; C = (st & 1) * 32 + (swz % 64) / 2; }
__host__ __device__ __forceinline__ int perm32(int rho) { const int n = rho >> 4, i = rho & 15; return 8 * (i >> 2) + 4 * n + (i & 3); }

struct Unit { int pm, pn, e; };

struct SchedDense {
    static constexpr bool GATHER = false;
    const bf16_t* A; const bf16_t* Bt; int K;
    int nM, nN, nwg, G, c;
    __device__ void init(const bf16_t* A_, const bf16_t* Bt_, int Mr, int N, int K_, int G_, int c_) { A = A_; Bt = Bt_; K = K_; nM = Mr / BM; nN = N / BM; nwg = nM * nN; G = G_; c = c_; }
    __device__ __forceinline__ bool next(int i, Unit& u) const {
        const long L = (long)i * G + c; if (L >= nwg) return false;
        int wgid = (int)L; { const int q = nwg / NXCD, r = nwg % NXCD, xcd = wgid % NXCD, off = wgid / NXCD; wgid = (xcd < r ? xcd * (q + 1) : r * (q + 1) + (xcd - r) * q) + off; }
        const int nig = WGM * nN, gid = wgid / nig, fm = gid * WGM, gsz = (nM - fm) < WGM ? (nM - fm) : WGM;
        u.pm = fm + ((wgid % nig) % gsz); u.pn = (wgid % nig) / gsz; u.e = 0; return true;
    }
    __device__ __forceinline__ const char* a_base(const Unit& u) const { return (const char*)A + (size_t)u.pm * BM * K * 2; }
    __device__ __forceinline__ const char* b_base(const Unit& u) const { return (const char*)Bt + (size_t)u.pn * BM * K * 2; }
    __device__ __forceinline__ void a_voff(int, const Unit&, const int (&R)[2], const int (&C)[2], unsigned (&v0)[2], unsigned (&v1)[2]) const {
#pragma unroll
        for (int j = 0; j < 2; ++j) { v0[j] = (unsigned)(R[j] * K + C[j]) * 2u; v1[j] = v0[j] + (unsigned)(HALF * K * 2); }
    }
};
template <bool GATHER_>
struct SchedMoe {
    static constexpr bool GATHER = GATHER_;
    const bf16_t* A; const bf16_t* Bt; size_t estride; int K;
    int nunits, G, c;
    const MK_LAS int* pexp;
    const MK_LAS int* tokl;
    __device__ __forceinline__ bool next(int i, Unit& u) const {
        const int L = i * G + c; if (L >= nunits || i >= MAXU) return false;
        int wgid = L; { const int q = nunits / NXCD, r = nunits % NXCD, xcd = wgid % NXCD, off = wgid / NXCD; wgid = (xcd < r ? xcd * (q + 1) : r * (q + 1) + (xcd - r) * q) + off; }
        u.pm = wgid >> 3; u.pn = wgid & 7; u.e = pexp[u.pm]; return true;
    }
    __device__ __forceinline__ const char* a_base(const Unit& u) const { return GATHER ? (const char*)A : (const char*)A + (size_t)u.pm * BM * K * 2; }
    __device__ __forceinline__ const char* b_base(const Unit& u) const { return (const char*)Bt + ((size_t)u.e * estride + (size_t)u.pn * BM * K) * 2; }
    __device__ __forceinline__ unsigned a_off1(int i, int half, int R, int C) const {
        if (GATHER) return (unsigned)(tokl[i * 256 + half * HALF + R] * K + C) * 2u;
        return (unsigned)((R + half * HALF) * K + C) * 2u;
    }
    __device__ __forceinline__ void a_voff(int i, const Unit&, const int (&R)[2], const int (&C)[2], unsigned (&v0)[2], unsigned (&v1)[2]) const {
#pragma unroll
        for (int j = 0; j < 2; ++j) {
            if (GATHER) { const int t0 = tokl[i * 256 + R[j]], t1 = tokl[i * 256 + HALF + R[j]];
                v0[j] = (unsigned)(t0 * K + C[j]) * 2u; v1[j] = (unsigned)(t1 * K + C[j]) * 2u; }
            else { v0[j] = (unsigned)(R[j] * K + C[j]) * 2u; v1[j] = v0[j] + (unsigned)(HALF * K * 2); }
        }
    }
};

struct EpiProj {
    static constexpr bool PERM = true;
    bf16_t* O;
    __device__ __forceinline__ void operator()(const f32x4 (&acc)[2][2][4][2], const Unit& u, int wr, int wc, int fr, int fq) const {
        const int row0 = u.pm * BM + wr * 64 + fr, col0 = u.pn * BM + wc * 32 + 8 * fq;
        const float s = (u.pn < 4) ? 0.125f * LOG2E : ((u.pn >= 12 && u.pn < 16) ? 0.08838834764831845f * LOG2E : 1.0f);
#pragma unroll
        for (int ai = 0; ai < 2; ++ai)
#pragma unroll
            for (int m = 0; m < 4; ++m) { bf16_t* rowp = O + (size_t)(row0 + ai * HALF + m * 16) * INC + col0;
#pragma unroll
                for (int bj = 0; bj < 2; ++bj) { const f32x4 v0 = acc[ai][bj][m][0] * s, v1 = acc[ai][bj][m][1] * s;
                    u32x4 w; w.x = cvt_pk_bf16(v0[0], v0[1]); w.y = cvt_pk_bf16(v0[2], v0[3]); w.z = cvt_pk_bf16(v1[0], v1[1]); w.w = cvt_pk_bf16(v1[2], v1[3]);
                    *(u32x4*)(rowp + bj * HALF) = w; } }
    }
};
struct EpiWo {
    static constexpr bool PERM = false;
    const float* x; const float* gate; float* H;
    __device__ __forceinline__ void operator()(const f32x4 (&acc)[2][2][4][2], const Unit& u, int wr, int wc, int fr, int fq) const {
        const int row0 = u.pm * BM + wr * 64 + fr, col0 = u.pn * BM + wc * 32 + 4 * fq;
        const float* gp = gate + (size_t)(u.pm >> 4) * 6 * D + col0;
        f32x4 gv[2][2];
#pragma unroll
        for (int bj = 0; bj < 2; ++bj)
#pragma unroll
            for (int n = 0; n < 2; ++n) gv[bj][n] = *(const f32x4*)(gp + bj * HALF + n * 16) + 1.0f;
#pragma unroll
        for (int ai = 0; ai < 2; ++ai)
#pragma unroll
            for (int m = 0; m < 4; ++m) { const size_t off = (size_t)(row0 + ai * HALF + m * 16) * D + col0;
#pragma unroll
                for (int bj = 0; bj < 2; ++bj)
#pragma unroll
                    for (int n = 0; n < 2; ++n) { const f32x4 xv = *(const f32x4*)(x + off + bj * HALF + n * 16);
                        *(f32x4*)(H + off + bj * HALF + n * 16) = xv * ALPHA + gv[bj][n] * acc[ai][bj][m][n]; } }
    }
};
struct EpiGU {
    static constexpr bool PERM = true;
    bf16_t* Hb;
    __device__ __forceinline__ void operator()(const f32x4 (&acc)[2][2][4][2], const Unit& u, int wr, int wc, int fr, int fq) const {
        const int row0 = u.pm * BM + wr * 64 + fr, col0 = u.pn * HALF + wc * 32 + 8 * fq;
#pragma unroll
        for (int ai = 0; ai < 2; ++ai)
#pragma unroll
            for (int m = 0; m < 4; ++m) { bf16_t* rowp = Hb + (size_t)(row0 + ai * HALF + m * 16) * DE + col0;
                float h[8];
#pragma unroll
                for (int n = 0; n < 2; ++n)
#pragma unroll
                    for (int j = 0; j < 4; ++j) { const float g = acc[ai][0][m][n][j], up = acc[ai][1][m][n][j];
                        h[n * 4 + j] = g * __builtin_amdgcn_rcpf(1.0f + __builtin_amdgcn_exp2f(-g * LOG2E)) * up; }
                u32x4 w; w.x = cvt_pk_bf16(h[0], h[1]); w.y = cvt_pk_bf16(h[2], h[3]); w.z = cvt_pk_bf16(h[4], h[5]); w.w = cvt_pk_bf16(h[6], h[7]);
                *(u32x4*)rowp = w; }
    }
};
struct EpiDown {
    static constexpr bool PERM = true;
    bf16_t* Y;
    __device__ __forceinline__ void operator()(const f32x4 (&acc)[2][2][4][2], const Unit& u, int wr, int wc, int fr, int fq) const {
        const int row0 = u.pm * BM + wr * 64 + fr, col0 = u.pn * BM + wc * 32 + 8 * fq;
#pragma unroll
        for (int ai = 0; ai < 2; ++ai)
#pragma unroll
            for (int m = 0; m < 4; ++m) { bf16_t* rowp = Y + (size_t)(row0 + ai * HALF + m * 16) * D + col0;
#pragma unroll
                for (int bj = 0; bj < 2; ++bj) { const f32x4 v0 = acc[ai][bj][m][0], v1 = acc[ai][bj][m][1];
                    u32x4 w; w.x = cvt_pk_bf16(v0[0], v0[1]); w.y = cvt_pk_bf16(v0[2], v0[3]); w.z = cvt_pk_bf16(v1[0], v1[1]); w.w = cvt_pk_bf16(v1[2], v1[3]);
                    *(u32x4*)(rowp + bj * HALF) = w; } }
    }
};

template <class Epi, class Sched>
__device__ __forceinline__ void gemm_phase(MK_LAS unsigned char* lds, const int K, const Sched& S, const Epi& E) {
    const int tid = ltid(), wid = __builtin_amdgcn_readfirstlane(tid >> 6), lane = tid & 63, wr = wid >> 2, wc = wid & 3, fr = lane & 15, fq = lane >> 4;
    const int nt = K / BK;
    int Rr[2], Cc[2]; unsigned voffB[2];
#pragma unroll
    for (int i = 0; i < 2; ++i) { int R, C; stage_rc(tid * 16 + i * 8192, R, C); const int Rb = Epi::PERM ? ((R & ~31) + perm32(R & 31)) : R;
        Rr[i] = R; Cc[i] = C; voffB[i] = (unsigned)(Rb * K + C) * 2u; }
    const size_t kstep = (size_t)(BK * 2);
    const size_t hstep = (size_t)HALF * K * 2;
    const unsigned ldsw = (unsigned)wid * 1024u;
    const int aoff = lds_byte(wr * 64 + fr, fq * 8), boff = lds_byte(wc * 32 + fr, fq * 8);
#define PG8_SA(b, h) (((b) * 2 + (h)) * HTB)
#define PG8_SB(b, h) ((4 + (b) * 2 + (h)) * HTB)
#define PG8_STAGE(bufoff, gbase, voff) do { _Pragma("unroll") for (int _i = 0; _i < 2; ++_i) \
        __builtin_amdgcn_global_load_lds((const unsigned*)((const char*)(gbase) + (voff)[_i]), (MK_LAS unsigned*)(lds + (bufoff) + ldsw + _i * 8192), 16, 0, 0); } while (0)
#define PG8_LDA(dst, b, h) do { _Pragma("unroll") for (int m = 0; m < 4; ++m) _Pragma("unroll") for (int k = 0; k < 2; ++k) dst[m][k] = *(const MK_LAS bf16x8*)(lds + PG8_SA(b, h) + aoff + m * 2048 + k * 1024); } while (0)
#define PG8_LDB(dst, b, h) do { _Pragma("unroll") for (int n = 0; n < 2; ++n) _Pragma("unroll") for (int k = 0; k < 2; ++k) dst[n][k] = *(const MK_LAS bf16x8*)(lds + PG8_SB(b, h) + boff + n * 2048 + k * 1024); } while (0)
#define PG8_MMA(ai, bj, At, Bt) do { __builtin_amdgcn_s_setprio(1); _Pragma("unroll") for (int m = 0; m < 4; ++m) _Pragma("unroll") for (int n = 0; n < 2; ++n) _Pragma("unroll") for (int k = 0; k < 2; ++k) \
        acc[ai][bj][m][n] = __builtin_amdgcn_mfma_f32_16x16x32_bf16(Bt[n][k], At[m][k], acc[ai][bj][m][n], 0, 0, 0); __builtin_amdgcn_s_setprio(0); } while (0)
#define PG8_WAIT_V(n) asm volatile("s_waitcnt vmcnt(" #n ")" ::: "memory")
#define PG8_WAIT_L(n) asm volatile("s_waitcnt lgkmcnt(" #n ")" ::: "memory")
#define PG8_BAR __builtin_amdgcn_s_barrier()
#define PG8_SCHED __builtin_amdgcn_sched_barrier(0)
    Unit cur, nxt; int ui = 0;
    if (!S.next(0, cur)) return;
    unsigned cv0[2], cv1[2], nv0[2], nv1[2];
    S.a_voff(0, cur, Rr, Cc, cv0, cv1);
    f32x4 acc[2][2][4][2];
#pragma unroll
    for (int a = 0; a < 2; ++a)
#pragma unroll
        for (int b = 0; b < 2; ++b)
#pragma unroll
            for (int m = 0; m < 4; ++m)
#pragma unroll
                for (int n = 0; n < 2; ++n) acc[a][b][m][n] = (f32x4){0.f, 0.f, 0.f, 0.f};
    bf16x8 At[4][2], B0[2][2], B1[2][2];
    const char* cA = S.a_base(cur); const char* cB = S.b_base(cur);
    PG8_STAGE(PG8_SB(0, 0), cB, voffB); PG8_STAGE(PG8_SB(0, 1), cB + hstep, voffB); PG8_STAGE(PG8_SA(0, 0), cA, cv0); PG8_STAGE(PG8_SA(0, 1), cA, cv1);
    if (wr == 1) PG8_BAR;
    PG8_WAIT_V(2); PG8_BAR;
    PG8_STAGE(PG8_SB(1, 0), cB + kstep, voffB); PG8_STAGE(PG8_SA(1, 0), cA + kstep, cv0); PG8_STAGE(PG8_SB(1, 1), cB + hstep + kstep, voffB);
    PG8_WAIT_V(6); PG8_BAR;
    for (;;) {
        const bool has_next = S.next(ui + 1, nxt);
        const char* nA = cA; const char* nB = cB;
#pragma unroll
        for (int j = 0; j < 2; ++j) { nv0[j] = cv0[j]; nv1[j] = cv1[j]; }
        if (has_next) { nA = S.a_base(nxt); nB = S.b_base(nxt); S.a_voff(ui + 1, nxt, Rr, Cc, nv0, nv1); }
        for (int t = 0; t < nt; t += 2) {
            const bool last = (t == nt - 2);
            const char* a1 = cA + (size_t)(t + 1) * kstep;
            const char* a2 = last ? nA : cA + (size_t)(t + 2) * kstep; const char* b2 = last ? nB : cB + (size_t)(t + 2) * kstep;
            const char* a3 = a2 + kstep; const char* b3 = b2 + kstep;
            unsigned x0[2], x1[2];
#pragma unroll
            for (int j = 0; j < 2; ++j) { x0[j] = last ? nv0[j] : cv0[j]; x1[j] = last ? nv1[j] : cv1[j]; }
            PG8_LDB(B0, 0, 0); PG8_LDB(B1, 0, 1); PG8_SCHED; PG8_LDA(At, 0, 0); PG8_STAGE(PG8_SA(1, 1), a1, cv1);
            PG8_WAIT_V(8); PG8_WAIT_L(0); PG8_BAR; PG8_MMA(0, 0, At, B0); PG8_MMA(0, 1, At, B1); PG8_BAR; PG8_SCHED;
            PG8_LDA(At, 0, 1); PG8_STAGE(PG8_SB(0, 0), b2, voffB); PG8_STAGE(PG8_SB(0, 1), b2 + hstep, voffB); PG8_STAGE(PG8_SA(0, 0), a2, x0);
            PG8_WAIT_V(8); PG8_WAIT_L(0); PG8_BAR; PG8_MMA(1, 0, At, B0); PG8_MMA(1, 1, At, B1); PG8_BAR; PG8_SCHED;
            PG8_LDB(B0, 1, 0); PG8_LDB(B1, 1, 1); PG8_SCHED; PG8_LDA(At, 1, 0); PG8_STAGE(PG8_SA(0, 1), a2, x1);
            PG8_WAIT_V(8); PG8_WAIT_L(0); PG8_BAR; PG8_MMA(0, 0, At, B0); PG8_MMA(0, 1, At, B1); PG8_BAR; PG8_SCHED;
            PG8_LDA(At, 1, 1); PG8_STAGE(PG8_SB(1, 0), b3, voffB); PG8_STAGE(PG8_SB(1, 1), b3 + hstep, voffB); PG8_STAGE(PG8_SA(1, 0), a3, x0);
            PG8_WAIT_V(8); PG8_WAIT_L(0); PG8_BAR; PG8_MMA(1, 0, At, B0); PG8_MMA(1, 1, At, B1); PG8_BAR; PG8_SCHED;
        }
        if (wr == 0) PG8_BAR;
        E(acc, cur, wr, wc, fr, fq);
        if (!has_next) break;
#pragma unroll
        for (int a = 0; a < 2; ++a)
#pragma unroll
            for (int b = 0; b < 2; ++b)
#pragma unroll
                for (int m = 0; m < 4; ++m)
#pragma unroll
                    for (int n = 0; n < 2; ++n) acc[a][b][m][n] = (f32x4){0.f, 0.f, 0.f, 0.f};
        cur = nxt; cA = nA; cB = nB; ++ui;
#pragma unroll
        for (int j = 0; j < 2; ++j) { cv0[j] = nv0[j]; cv1[j] = nv1[j]; }
        if (wr == 1) PG8_BAR;
    }
    PG8_WAIT_V(0);
    PG8_BAR;
#undef PG8_SA
#undef PG8_SB
#undef PG8_STAGE
#undef PG8_LDA
#undef PG8_LDB
#undef PG8_MMA
#undef PG8_WAIT_V
#undef PG8_WAIT_L
#undef PG8_BAR
#undef PG8_SCHED
}
__device__ __forceinline__ const char* uniform_ptr(const char* p) { const unsigned long long v = (unsigned long long)p; const unsigned lo = __builtin_amdgcn_readfirstlane((unsigned)v), hi = __builtin_amdgcn_readfirstlane((unsigned)(v >> 32)); return (const char*)(((unsigned long long)hi << 32) | lo); }
__host__ __device__ __forceinline__ int invperm32(int c) { return ((c >> 2) & 1) * 16 + (c >> 3) * 4 + (c & 3); }
struct BPatch {
    unsigned voff;
    unsigned ldsoff;
};
struct BSrcDown {
    const float* W; size_t estride; int ldb;
    __device__ __forceinline__ void patch(int tid, bool perm, BPatch& P) const {
        const int lane = tid & 63, w = tid >> 6, kr0 = 8 * w, n0 = 4 * lane;
        P.voff = (unsigned)(kr0 * ldb + n0) * 4u;
        { const int n = n0, h = n >> 7, R = n & 127, slot = perm ? ((R & ~31) + invperm32(R & 31)) : R; P.ldsoff = (unsigned)(h * HTB + lds_byte(slot, kr0)); }
    }
    __device__ __forceinline__ const char* base(const Unit& u, int  ) const { const int e = __builtin_amdgcn_readfirstlane(u.e), pn = __builtin_amdgcn_readfirstlane(u.pn); return (const char*)(W + (size_t)e * estride + (size_t)pn * BM); }
    __device__ __forceinline__ size_t rowbytes() const { return (size_t)ldb * 4; }
};

struct BSrcUp {
    const float* Wg; const float* Wu; size_t estride; int ldb;
    __device__ __forceinline__ void patch(int tid, bool perm, BPatch& P) const {
        const int lane = tid & 63, w = tid >> 6, s_ = w & 1, kr0 = 16 * (w >> 1) + 8 * (lane >> 5), c0 = 4 * (lane & 31);
        P.voff = (unsigned)(kr0 * ldb + c0) * 4u;
        { const int R = c0, slot = perm ? ((R & ~31) + invperm32(R & 31)) : R; P.ldsoff = (unsigned)(s_ * HTB + lds_byte(slot, kr0)); }
    }
    __device__ __forceinline__ const char* base(const Unit& u, int wave) const { const int e = __builtin_amdgcn_readfirstlane(u.e), pn = __builtin_amdgcn_readfirstlane(u.pn), sel = __builtin_amdgcn_readfirstlane(wave & 1);
        const unsigned long long m = 0ull - (unsigned long long)(unsigned)sel;
        const float* src = (const float*)(((unsigned long long)Wg & ~m) | ((unsigned long long)Wu & m)); return (const char*)(src + (size_t)e * estride + (size_t)pn * HALF); }
    __device__ __forceinline__ size_t rowbytes() const { return (size_t)ldb * 4; }
};

template <int VAR = 0, class Epi, class Sched, class BSrc>
__device__ __forceinline__ void gemm_phase_fb(MK_LAS unsigned char* lds, const int K, const Sched& S, const BSrc& Bs_, const Epi& E) {
    const int tid = ltid(), wid = __builtin_amdgcn_readfirstlane(tid >> 6), lane = tid & 63, wr = wid >> 2, wc = wid & 3, fr = lane & 15, fq = lane >> 4;
    const int nt = K / BK;
    BPatch P; Bs_.patch(tid, Epi::PERM, P);
    const size_t kstep = (size_t)(BK * 2);
    const size_t rowb = Bs_.rowbytes(), ktb = rowb * BK;
    const unsigned ldsw = (unsigned)wid * 1024u;
    const int aoff = lds_byte(wr * 64 + fr, fq * 8), boff = lds_byte(wc * 32 + fr, fq * 8);
#define PG8_SA(b, h) (((b) * 2 + (h)) * HTB)
#define PG8_SB(b, h) ((4 + (b) * 2 + (h)) * HTB)
#define PG8_STAGE(bufoff, gbase, voff) do { _Pragma("unroll") for (int _i = 0; _i < 2; ++_i) \
        __builtin_amdgcn_global_load_lds((const unsigned*)((const char*)(gbase) + (voff)[_i]), (MK_LAS unsigned*)(lds + (bufoff) + ldsw + _i * 8192), 16, 0, 0); } while (0)
#define PG8_LDA(dst, b, h) do { _Pragma("unroll") for (int m = 0; m < 4; ++m) _Pragma("unroll") for (int k = 0; k < 2; ++k) dst[m][k] = *(const MK_LAS bf16x8*)(lds + PG8_SA(b, h) + aoff + m * 2048 + k * 1024); } while (0)
#define PG8_LDB(dst, b, h) do { _Pragma("unroll") for (int n = 0; n < 2; ++n) _Pragma("unroll") for (int k = 0; k < 2; ++k) dst[n][k] = *(const MK_LAS bf16x8*)(lds + PG8_SB(b, h) + boff + n * 2048 + k * 1024); } while (0)
#define PG8_MMA(ai, bj, At, Bt) do { __builtin_amdgcn_s_setprio(1); _Pragma("unroll") for (int m = 0; m < 4; ++m) _Pragma("unroll") for (int n = 0; n < 2; ++n) _Pragma("unroll") for (int k = 0; k < 2; ++k) \
        acc[ai][bj][m][n] = __builtin_amdgcn_mfma_f32_16x16x32_bf16(Bt[n][k], At[m][k], acc[ai][bj][m][n], 0, 0, 0); __builtin_amdgcn_s_setprio(0); } while (0)
#define PG8_WAIT_V(n) asm volatile("s_waitcnt vmcnt(" #n ")" ::: "memory")
#define PG8_WAIT_L(n) asm volatile("s_waitcnt lgkmcnt(" #n ")" ::: "memory")
#define PG8_BAR __builtin_amdgcn_s_barrier()
#define PG8_SCHED __builtin_amdgcn_sched_barrier(0)
    f32x4 br[8];
#define BF_LOAD(ptr) do { const char* _p = uniform_ptr(ptr); \
        _Pragma("unroll") for (int _j = 0; _j < 8; ++_j) asm volatile("global_load_dwordx4 %0, %1, %2" : "=v"(br[_j]) : "v"(P.voff), "s"(_p + (size_t)_j * rowb) : "memory"); } while (0)
#define BF_CONSUME(NLEFT, b) do { asm volatile("s_waitcnt vmcnt(" #NLEFT ")" : "+v"(br[0]), "+v"(br[1]), "+v"(br[2]), "+v"(br[3]), "+v"(br[4]), "+v"(br[5]), "+v"(br[6]), "+v"(br[7]) :: "memory"); \
        _Pragma("unroll") for (int _i = 0; _i < 4; ++_i) { u32x4 _w; _w.x = cvt_pk_bf16(br[0][_i], br[1][_i]); _w.y = cvt_pk_bf16(br[2][_i], br[3][_i]); _w.z = cvt_pk_bf16(br[4][_i], br[5][_i]); _w.w = cvt_pk_bf16(br[6][_i], br[7][_i]); \
            *(MK_LAS u32x4*)(lds + PG8_SB(b, 0) + P.ldsoff + _i * 64) = _w; } } while (0)
#define BF_FILL(g, b, nptr) do { \
        if ((g) < 20) { if (VAR != 2 && VAR != 3) { const int _c = (g) / 5, _w = (g) % 5; \
            if (_w < 4) fw[_w] = cvt_pk_bf16_c(br[2 * _w][_c], br[2 * _w + 1][_c]); \
            else *(MK_LAS u32x4*)(lds + PG8_SB(b, 0) + P.ldsoff + _c * 64) = (u32x4){fw[0], fw[1], fw[2], fw[3]}; } } \
        else if ((g) < 28 && VAR != 3) { const int _j = (g) - 20; asm volatile("global_load_dwordx4 %0, %1, %2" : "=v"(br[_j]) : "v"(P.voff), "s"(nptr + (size_t)_j * rowb) : "memory"); } } while (0)
#define BF_MMA_FILL(b, nextp) do { const char* _np = uniform_ptr(nextp); unsigned fw[4]; BPatch P; Bs_.patch(ltid(), Epi::PERM, P); \
        asm volatile("s_waitcnt vmcnt(4)" : "+v"(br[0]), "+v"(br[1]), "+v"(br[2]), "+v"(br[3]), "+v"(br[4]), "+v"(br[5]), "+v"(br[6]), "+v"(br[7]) :: "memory"); \
        __builtin_amdgcn_s_setprio(1); \
        _Pragma("unroll") for (int _g = 0; _g < 32; ++_g) { const int _bj = _g >> 4, _m = (_g >> 2) & 3, _n = (_g >> 1) & 1, _k = _g & 1; \
            if (_bj == 0) acc[1][0][_m][_n] = __builtin_amdgcn_mfma_f32_16x16x32_bf16(B0[_n][_k], At[_m][_k], acc[1][0][_m][_n], 0, 0, 0); \
            else acc[1][1][_m][_n] = __builtin_amdgcn_mfma_f32_16x16x32_bf16(B1[_n][_k], At[_m][_k], acc[1][1][_m][_n], 0, 0, 0); \
            BF_FILL(_g, b, _np); \
            __builtin_amdgcn_sched_barrier(0); } \
        __builtin_amdgcn_s_setprio(0); } while (0)
    Unit cur, nxt; int ui = 0;
    if (!S.next(0, cur)) return;
#define AV(dst, unit, half) do { _Pragma("unroll") for (int _j = 0; _j < 2; ++_j) { int _R, _C; stage_rc(ltid() * 16 + _j * 8192, _R, _C); dst[_j] = S.a_off1((unit), (half), _R, _C); } } while (0)
    unsigned cv0[2], cv1[2], nv0[2], nv1[2];
    AV(cv0, 0, 0); AV(cv1, 0, 1);
    f32x4 acc[2][2][4][2];
#pragma unroll
    for (int a = 0; a < 2; ++a)
#pragma unroll
        for (int b = 0; b < 2; ++b)
#pragma unroll
            for (int m = 0; m < 4; ++m)
#pragma unroll
                for (int n = 0; n < 2; ++n) acc[a][b][m][n] = (f32x4){0.f, 0.f, 0.f, 0.f};
    bf16x8 At[4][2], B0[2][2], B1[2][2];
    const char* cA = S.a_base(cur); const char* cB = Bs_.base(cur, wid);
    BF_LOAD(cB); PG8_STAGE(PG8_SA(0, 0), cA, cv0); PG8_STAGE(PG8_SA(0, 1), cA, cv1);
    BF_CONSUME(4, 0);
    BF_LOAD(cB + ktb); PG8_STAGE(PG8_SA(1, 0), cA + kstep, cv0);
    BF_CONSUME(2, 1);
    BF_LOAD(cB + 2 * ktb);
    PG8_WAIT_V(8); PG8_WAIT_L(0);
    if (wr == 1) PG8_BAR;
    PG8_BAR; PG8_BAR;
    for (;;) {
        const bool has_next = S.next(ui + 1, nxt);
        const char* nA = cA; const char* nB = cB;
        if (has_next) { nA = S.a_base(nxt); nB = Bs_.base(nxt, wid); }
        const int un = has_next ? ui + 1 : ui;
        if constexpr (Sched::GATHER) { AV(nv0, un, 0); AV(nv1, un, 1); }
        for (int t = 0; t < nt; t += 2) {
            const bool last = (t == nt - 2);
            const char* a1 = cA + (size_t)(t + 1) * kstep;
            const char* a2 = last ? nA : cA + (size_t)(t + 2) * kstep;
            const char* a3 = a2 + kstep;
            const int km = (VAR == 1) ? 1 : -1;
            const char* b3 = (t + 3 < nt) ? cB + (size_t)((t + 3) & km) * ktb : nB + (size_t)(t + 3 - nt) * ktb;
            const char* b4 = (t + 4 < nt) ? cB + (size_t)((t + 4) & km) * ktb : nB + (size_t)(t + 4 - nt) * ktb;
#define AOFF_H0(_i) (Sched::GATHER ? (last ? nv0[_i] : cv0[_i]) : cv0[_i])
#define AOFF_H1(_i) (Sched::GATHER ? (last ? nv1[_i] : cv1[_i]) : cv0[_i] + (unsigned)(HALF * K * 2))
#define AOFF_C1(_i) (Sched::GATHER ? cv1[_i] : cv0[_i] + (unsigned)(HALF * K * 2))
#define PG8_STAGEF(bufoff, gbase, OFF) do { _Pragma("unroll") for (int _i = 0; _i < 2; ++_i) \
        __builtin_amdgcn_global_load_lds((const unsigned*)((const char*)(gbase) + OFF(_i)), (MK_LAS unsigned*)(lds + (bufoff) + ldsw + _i * 8192), 16, 0, 0); } while (0)
            PG8_LDB(B0, 0, 0); PG8_LDB(B1, 0, 1); PG8_SCHED; PG8_LDA(At, 0, 0); PG8_STAGEF(PG8_SA(1, 1), a1, AOFF_C1);
            PG8_WAIT_V(12); PG8_WAIT_L(0); PG8_BAR; PG8_MMA(0, 0, At, B0); PG8_MMA(0, 1, At, B1); PG8_BAR; PG8_SCHED;
            PG8_LDA(At, 0, 1); PG8_STAGEF(PG8_SA(0, 0), a2, AOFF_H0);
            PG8_WAIT_L(0); PG8_BAR; BF_MMA_FILL(0, b3); PG8_BAR; PG8_SCHED;
            PG8_LDB(B0, 1, 0); PG8_LDB(B1, 1, 1); PG8_SCHED; PG8_LDA(At, 1, 0); PG8_STAGEF(PG8_SA(0, 1), a2, AOFF_H1);
            PG8_WAIT_V(12); PG8_WAIT_L(0); PG8_BAR; PG8_MMA(0, 0, At, B0); PG8_MMA(0, 1, At, B1); PG8_BAR; PG8_SCHED;
            PG8_LDA(At, 1, 1); PG8_STAGEF(PG8_SA(1, 0), a3, AOFF_H0);
            PG8_WAIT_L(0); PG8_BAR; BF_MMA_FILL(1, b4); PG8_BAR; PG8_SCHED;
        }
        if (wr == 0) PG8_BAR;
        E(acc, cur, wr, wc, fr, fq);
        if (!has_next) break;
#pragma unroll
        for (int a = 0; a < 2; ++a)
#pragma unroll
            for (int b = 0; b < 2; ++b)
#pragma unroll
                for (int m = 0; m < 4; ++m)
#pragma unroll
                    for (int n = 0; n < 2; ++n) acc[a][b][m][n] = (f32x4){0.f, 0.f, 0.f, 0.f};
        cur = nxt; cA = nA; cB = nB; ++ui;
        if constexpr (Sched::GATHER) {
#pragma unroll
            for (int j = 0; j < 2; ++j) { cv0[j] = nv0[j]; cv1[j] = nv1[j]; } }
        if (wr == 1) PG8_BAR;
    }
    asm volatile("s_waitcnt vmcnt(0)" : "+v"(br[0]), "+v"(br[1]), "+v"(br[2]), "+v"(br[3]), "+v"(br[4]), "+v"(br[5]), "+v"(br[6]), "+v"(br[7]) :: "memory");
    PG8_BAR;
#undef BF_LOAD
#undef AOFF_H0
#undef AOFF_H1
#undef AOFF_C1
#undef PG8_STAGEF
#undef BF_FILL
#undef BF_MMA_FILL
#undef AV
#undef BF_CONSUME
#undef PG8_SA
#undef PG8_SB
#undef PG8_STAGE
#undef PG8_LDA
#undef PG8_LDB
#undef PG8_MMA
#undef PG8_WAIT_V
#undef PG8_WAIT_L
#undef PG8_BAR
#undef PG8_SCHED
}
struct In { const float *x, *c, *w_ada, *b_ada, *w_in, *lam, *subg, *relb, *w_o, *ln_g, *ln_b, *w_group, *b_group, *w_router, *b_router, *w_gate, *w_up, *w_down; };
struct Ws {
    unsigned* ctl;
    float* mod;
    bf16_t* wt_in;
    bf16_t* wt_o;
    bf16_t* wt_gu;
    bf16_t* wt_d;
    bf16_t* ab;
    bf16_t* proj;
    bf16_t* mixin;
    bf16_t* mixb;
    float* x1;
    float* xa;
    bf16_t* Hb;
    bf16_t* Yb;
    int* tok_of;
    int* tokinfo;
    float* tokw;
    bf16_t* wt_rh;
    bf16_t* wt_rl;
    bf16_t* ablo;
};
constexpr int CTL_CNT = 4096;
constexpr int CTL_WORDS = 8192;

constexpr int LDS_AUX = 131072;
constexpr int LDS_PEXP = LDS_AUX;
constexpr int LDS_PBASE = LDS_AUX + 768;
constexpr int LDS_CNT = LDS_AUX + 1024;
constexpr int LDS_TOKL = LDS_AUX + 2048;
constexpr int LDS_BTAB = LDS_AUX + 2048 + 8192;
constexpr int LDS_MISC = LDS_BTAB + 1088;
constexpr int LDS_BYTES = 147456;
constexpr int LDS_FLAGS = LDS_MISC + 64;
static_assert(LDS_FLAGS + 64 <= LDS_BYTES, "LDS map");

struct Frame { MK_LAS unsigned char* lds; int tid, lane, wave, G, vcu; };

__device__ __forceinline__ void conv_item(const float* __restrict__ W, int K, int N, bf16_t* __restrict__ WT, int k0, int n0, int drow0, MK_LAS float* scr, int lane) {
    const int n4 = (lane & 15) * 4, kq = lane >> 4;
    f32x4 v[16];
#pragma unroll
    for (int i = 0; i < 16; ++i) v[i] = *(const f32x4*)(W + (size_t)(k0 + kq + 4 * i) * N + n0 + n4);
#pragma unroll
    for (int i = 0; i < 16; ++i) { MK_LAS float* p = scr + (kq + 4 * i) * 65 + n4; p[0] = v[i][0]; p[1] = v[i][1]; p[2] = v[i][2]; p[3] = v[i][3]; }
    asm volatile("s_waitcnt lgkmcnt(0)" ::: "memory");
    const int c = lane & 7;
#pragma unroll
    for (int j = 0; j < 8; ++j) { const int n = (lane >> 3) + 8 * j; const MK_LAS float* s = scr + (8 * c) * 65 + n;
        u32x4 o; o.x = cvt_pk_bf16(s[0 * 65], s[1 * 65]); o.y = cvt_pk_bf16(s[2 * 65], s[3 * 65]); o.z = cvt_pk_bf16(s[4 * 65], s[5 * 65]); o.w = cvt_pk_bf16(s[6 * 65], s[7 * 65]);
        *(u32x4*)(WT + (size_t)(drow0 + n) * K + k0 + 8 * c) = o; }
    asm volatile("s_waitcnt lgkmcnt(0)" ::: "memory");
}
#if (defined(MK_F32B_DOWN) && defined(MK_F32B_UP)) || defined(MK_BGCONV)
constexpr int CI_E = 0;
#elif defined(MK_F32B_DOWN)
constexpr int CI_E = 1024;
#else
constexpr int CI_E = 1536;
#endif
constexpr int CI_IN = 3072, CI_O = 1024, CI_LAYER = CI_IN + CI_O + NE * CI_E;
__device__ __forceinline__ void conv_dispatch(const In& in, const Ws& w, int l, int r, MK_LAS float* scr, int lane) {
    if (r < CI_IN) { const int kb = r / 96, nb = r % 96; conv_item(in.w_in + (size_t)l * D * INC, D, INC, w.wt_in + (size_t)l * INC * D, kb * 64, nb * 64, nb * 64, scr, lane); return; }
    r -= CI_IN;
    if (r < CI_O) { const int kb = r / 32, nb = r % 32; conv_item(in.w_o + (size_t)l * D * D, D, D, w.wt_o + (size_t)l * D * D, kb * 64, nb * 64, nb * 64, scr, lane); return; }
    r -= CI_O;
    if (CI_E == 0) return;
    const int e = r / (CI_E ? CI_E : 1); r -= e * CI_E;
    const size_t le = (size_t)l * NE + e;
    if (r < 512) { const int kb = r / 16, nb = r % 16, n0 = nb * 64; conv_item(in.w_gate + le * D * DE, D, DE, w.wt_gu + le * 2048 * D, kb * 64, n0, ((n0 >> 7) << 8) + (n0 & 127), scr, lane); return; }
    r -= 512;
    if (r < 512) { const int kb = r / 16, nb = r % 16, n0 = nb * 64; conv_item(in.w_up + le * D * DE, D, DE, w.wt_gu + le * 2048 * D, kb * 64, n0, ((n0 >> 7) << 8) + 128 + (n0 & 127), scr, lane); return; }
    r -= 512;
#ifndef MK_F32B_DOWN
    { const int kb = r / 32, nb = r % 32; conv_item(in.w_down + le * DE * D, DE, D, w.wt_d + le * D * DE, kb * 64, nb * 64, nb * 64, scr, lane); }
#endif
}
__device__ __forceinline__ void phase_convert(const Frame& F, const In& in, const Ws& w, int it_lo, int it_hi) {
    MK_LAS float* scr = (MK_LAS float*)(F.lds + F.wave * 16640);
    const int gw = F.vcu * NWAVES + F.wave, NGW = F.G * NWAVES;
    for (int it = gw + it_lo; it < it_hi; it += NGW) conv_dispatch(in, w, it / CI_LAYER, it % CI_LAYER, scr, F.lane);
}

__device__ __forceinline__ void phase_mod(const Frame& F, const In& in, const Ws& w) {
    MK_LAS float* sc = (MK_LAS float*)(F.lds + 133120 - 133120);
    MK_LAS float* red = (MK_LAS float*)(F.lds + 32768);
    __syncthreads();
    for (int i = F.tid; i < NB * D; i += NTHR) { const float cv = in.c[i]; sc[i] = cv / (1.0f + __expf(-cv)); }
    __syncthreads();
    for (int item = F.vcu; item < 256; item += F.G) {
        const int l = item >> 7, n0 = (item & 127) * 96;
        const int cq = F.tid % 24, ks = F.tid / 24;
        if (ks < 16) {
            const float* wp = in.w_ada + (size_t)l * D * 6 * D + (size_t)(ks * 128) * 6 * D + n0 + cq * 4;
            f32x4 a0 = {0.f, 0.f, 0.f, 0.f}, a1 = a0, a2 = a0, a3 = a0;
#pragma unroll 8
            for (int k = 0; k < 128; ++k) { const f32x4 wv = *(const f32x4*)(wp + (size_t)k * 6 * D); const int kk = ks * 128 + k;
                a0 += wv * sc[kk]; a1 += wv * sc[D + kk]; a2 += wv * sc[2 * D + kk]; a3 += wv * sc[3 * D + kk]; }
            MK_LAS f32x4* rp = (MK_LAS f32x4*)red + (ks * 24 + cq) * 4;
            rp[0] = a0; rp[1] = a1; rp[2] = a2; rp[3] = a3;
        }
        __syncthreads();
        if (F.tid < 384) {
            const int q = F.tid / 16, bb = (F.tid >> 2) & 3, comp = F.tid & 3;
            float s = 0.f;
#pragma unroll
            for (int k2 = 0; k2 < 16; ++k2) s += red[((k2 * 24 + q) * 4 + bb) * 4 + comp];
            const int n = n0 + q * 4 + comp;
            w.mod[((size_t)l * NB + bb) * 6 * D + n] = s + in.b_ada[l * 6 * D + n];
        }
        __syncthreads();
    }
}

__device__ __forceinline__ void phase_modulate(const Frame& F, const float* __restrict__ x, const float* __restrict__ modl, bf16_t* __restrict__ ub) {
    const int gw = F.vcu * NWAVES + F.wave, NGW = F.G * NWAVES;
    for (int t = gw; t < M; t += NGW) {
        const float* mb = modl + (size_t)(t / S) * 6 * D;
        const float* xr = x + (size_t)t * D;
        bf16_t* ur = ub + (size_t)t * D;
#pragma unroll
        for (int j = 0; j < 8; ++j) { const int col = j * 256 + F.lane * 4;
            const f32x4 xv = *(const f32x4*)(xr + col), sh = *(const f32x4*)(mb + col), scv = *(const f32x4*)(mb + D + col);
            const f32x4 u = xv * (scv + 1.0f) + sh;
            u32x2 o; o.x = cvt_pk_bf16(u[0], u[1]); o.y = cvt_pk_bf16(u[2], u[3]);
            *(u32x2*)(ur + col) = o; }
    }
}

__device__ __forceinline__ int t5_bucket(int n) {
    if (n < 16) return n;
    const float v = logf((float)n / 16.0f) / 2.0794415416798357f * 16.0f;
    const int large = 16 + (int)v;
    return large < 31 ? large : 31;
}
__device__ __forceinline__ float permswap_other(float v) {
    auto rr = __builtin_amdgcn_permlane32_swap(__float_as_uint(v), __float_as_uint(v), false, false);
    return (__lane_id() & 32) ? __uint_as_float(rr[0]) : __uint_as_float(rr[1]);
}

#ifdef MK_BGCONV
constexpr int BG_ITEMS = (MK_BGCONV == 2 ? 2 : 3) * 65536;
#ifndef MK_BGMASK
#define MK_BGMASK 0
#endif
struct BgConv { const float* wg; const float* wu; const float* wd; bf16_t* tgu; bf16_t* td; int next, step, cur, mode; f32x2 p[8]; };
struct BgAddr { const float* src; bf16_t* dst; int N, K; };
__device__ __forceinline__ BgAddr bg_addr(const BgConv& g, int r, int lane) {
    r = __builtin_amdgcn_readfirstlane(r);
    const int mat = r >> 16, e = (r >> 11) & 31, kg = lane & 7, np = lane >> 3;
    BgAddr a;
    if (mat < 2) { const int kb = (r >> 6) & 31, n0 = (r & 63) * 16;
        const unsigned long long m = 0ull - (unsigned long long)(unsigned)mat;
        const float* W = (const float*)(((unsigned long long)g.wg & ~m) | ((unsigned long long)g.wu & m));
        a.N = DE; a.K = D;
        a.src = W + (size_t)e * D * DE + (size_t)(kb * 64 + 8 * kg) * DE + n0 + 2 * np;
        a.dst = g.tgu + (size_t)e * 2048 * D + (size_t)(((n0 >> 7) << 8) + (n0 & 127) + mat * 128 + 2 * np) * D + kb * 64 + 8 * kg;
    } else { const int kb = (r >> 7) & 15, n0 = (r & 127) * 16;
        a.N = D; a.K = DE;
        a.src = g.wd + (size_t)e * DE * D + (size_t)(kb * 64 + 8 * kg) * D + n0 + 2 * np;
        a.dst = g.td + (size_t)e * D * DE + (size_t)(n0 + 2 * np) * DE + kb * 64 + 8 * kg;
    }
    return a;
}
__device__ __forceinline__ void bg_load(BgConv& g, int lane) {
    const bool live = g.next < BG_ITEMS; const int r = live ? g.next : BG_ITEMS - 1;
    const BgAddr a = bg_addr(g, r, lane);
    if (g.mode != 2) {
#pragma unroll
    for (int j = 0; j < 8; ++j) g.p[j] = *(const __attribute__((address_space(1))) f32x2*)(unsigned long long)(a.src + (size_t)j * a.N); }
    g.cur = live ? g.next : -1; if (live) g.next += g.step;
}
__device__ __forceinline__ void bg_store(BgConv& g, int lane) {
    if (g.cur >= 0 && g.mode == 1) {
#pragma unroll
        for (int j = 0; j < 8; ++j) asm volatile("" :: "v"(g.p[j]));
        g.cur = -1; }
    if (g.cur >= 0) { const BgAddr a = bg_addr(g, g.cur, lane);
        u32x4 o0, o1;
        o0.x = cvt_pk_bf16(g.p[0][0], g.p[1][0]); o0.y = cvt_pk_bf16(g.p[2][0], g.p[3][0]); o0.z = cvt_pk_bf16(g.p[4][0], g.p[5][0]); o0.w = cvt_pk_bf16(g.p[6][0], g.p[7][0]);
        o1.x = cvt_pk_bf16(g.p[0][1], g.p[1][1]); o1.y = cvt_pk_bf16(g.p[2][1], g.p[3][1]); o1.z = cvt_pk_bf16(g.p[4][1], g.p[5][1]); o1.w = cvt_pk_bf16(g.p[6][1], g.p[7][1]);
        *(u32x4*)(a.dst) = o0; *(u32x4*)(a.dst + a.K) = o1; g.cur = -1; }
}
#define BG_PARAM , BgConv& bgc
#define BG_ARG , bgc
#else
#define BG_PARAM
#define BG_ARG
#endif

template <int MODE>
__device__ __forceinline__ void attn_pass(MK_LAS unsigned char* lds, const bf16_t* __restrict__ base  , int qcol, int kcol, int vcol, int qb,
                                          const MK_LAS float* btab, f32x16 (&O)[4], float& lsum BG_PARAM) {
    constexpr int DQK = MODE ? 128 : 64, ND0 = DQK / 16, KSTR = DQK * 2 + 16, VSTR = 320, KBYTES = 64 * KSTR, VBYTES = 64 * VSTR, BUF = KBYTES + VBYTES;
    constexpr int NKP = MODE ? 2 : 1;
    const int tid = ltid(), lane = tid & 63, wid = __builtin_amdgcn_readfirstlane(tid >> 6), r32 = lane & 31, hi = lane >> 5;
    const int q0 = qb * 256, qw0 = q0 + wid * 32, q = qw0 + r32;
    const int nt = 4 * qb + 4;
    bf16x8 qf[ND0];
#pragma unroll
    for (int d0 = 0; d0 < ND0; ++d0) qf[d0] = *(const bf16x8*)(base + (size_t)q * INC + qcol + d0 * 16 + hi * 8);
#pragma unroll
    for (int db = 0; db < 4; ++db)
#pragma unroll
        for (int r = 0; r < 16; ++r) O[db][r] = 0.f;
    float mref = 0.f; lsum = 0.f;
    float carry = 0.f;
    MK_LAS unsigned* flags = (MK_LAS unsigned*)(lds + LDS_FLAGS);
    const int krow = MODE ? (tid >> 4) : (tid >> 3), kch = MODE ? (tid & 15) : (tid & 7);
    const int vrow = tid >> 4, vch = tid & 15;
    const bf16_t* kg = base + (size_t)krow * INC + kcol + kch * 8;
    const bf16_t* vg = base + (size_t)vrow * INC + vcol + vch * 8;
    const unsigned kl = krow * KSTR + kch * 16, vl = KBYTES + vrow * VSTR + vch * 16;
    u32x4 kreg[NKP], vreg[2];
#define AT_GLOAD(j) do { const size_t _ro = (size_t)(j) * 64 * INC; \
        _Pragma("unroll") for (int _i = 0; _i < NKP; ++_i) kreg[_i] = *(const u32x4*)(kg + _ro + (size_t)_i * 32 * INC); \
        _Pragma("unroll") for (int _i = 0; _i < 2; ++_i) vreg[_i] = *(const u32x4*)(vg + _ro + (size_t)_i * 32 * INC); } while (0)
#define AT_LWRITE(bufo) do { \
        _Pragma("unroll") for (int _i = 0; _i < NKP; ++_i) *(MK_LAS u32x4*)(lds + (bufo) + kl + _i * 32 * KSTR) = kreg[_i]; \
        _Pragma("unroll") for (int _i = 0; _i < 2; ++_i) *(MK_LAS u32x4*)(lds + (bufo) + vl + _i * 32 * VSTR) = vreg[_i]; } while (0)
    const unsigned ka = r32 * KSTR + hi * 16;
    const unsigned va = KBYTES + (4 * hi + ((lane & 15) >> 2)) * VSTR + (((lane >> 4) & 1) * 16 + (lane & 3) * 4) * 2;
    { const int j0 = MODE ? nt - 1 : 0; AT_GLOAD(j0); AT_LWRITE(0); }
    __syncthreads();
#ifdef MK_BGCONV
#pragma unroll
    for (int d0 = 0; d0 < ND0; ++d0) asm volatile("" : "+v"(qf[d0]));
#endif
#ifdef MK_BGCONV
#pragma unroll (MODE ? 1 : 2)
#endif
    for (int it = 0; it < nt; ++it) {
        const int j = MODE ? nt - 1 - it : it;
        const unsigned bo = (unsigned)(it & 1) * BUF;
#if defined(MK_BGCONV) && !defined(MK_BGLATE)
        if (MODE == 0 && !(it & MK_BGMASK)) bg_store(bgc, lane);
#endif
        if (it + 1 < nt) { const int jn = MODE ? j - 1 : j + 1; AT_GLOAD(jn); }
#ifdef MK_BGCONV
#ifdef MK_BGSPREAD
        const bool bgact = (MODE == 0) && !(it & MK_BGMASK);
        BgAddr bga; bga.src = nullptr; bga.N = 0;
#define BG_BEGIN() do { if (bgact) { const bool live = bgc.next < BG_ITEMS; const int r = live ? bgc.next : BG_ITEMS - 1; bga = bg_addr(bgc, r, lane); bgc.cur = live ? bgc.next : -1; if (live) bgc.next += bgc.step; } } while (0)
#ifndef MK_BGLATE
        BG_BEGIN();
#endif
#define BG_LD(jj) do { if (bgact) { asm volatile("" :: "v"(bgc.p[jj]));        \
            bgc.p[jj] = *(const __attribute__((address_space(1))) f32x2*)(unsigned long long)(bga.src + (size_t)(jj) * bga.N); } } while (0)
#ifdef MK_BGLATE
#define BG_FENCE() do { if (bgact) __builtin_amdgcn_sched_barrier(0); } while (0)
#else
#define BG_FENCE() __builtin_amdgcn_sched_barrier(0)
#endif
        BG_FENCE();
#else
        if (MODE == 0 && !(it & MK_BGMASK)) bg_load(bgc, lane);
#define BG_LD(jj) do { } while (0)
#define BG_FENCE() do { } while (0)
#endif
#else
#define BG_LD(jj) do { } while (0)
#define BG_FENCE() do { } while (0)
#endif
        const bool skip = MODE ? (64 * j >= qw0 + 32) : (64 * j > qw0 + 31);
        f32x16 sT[2]; bf16x8 pf[2][2];
        if (!skip) {
            const float cinit = MODE ? 0.f : -mref;
#pragma unroll
            for (int kb = 0; kb < 2; ++kb) {
                bf16x8 kf[ND0];
#pragma unroll
                for (int d0 = 0; d0 < ND0; ++d0) kf[d0] = *(const MK_LAS bf16x8*)(lds + bo + ka + kb * 32 * KSTR + d0 * 32);
#pragma unroll
                for (int r = 0; r < 16; ++r) sT[kb][r] = cinit;
                __builtin_amdgcn_sched_barrier(0);
#pragma unroll
                for (int d0 = 0; d0 < ND0; ++d0) sT[kb] = __builtin_amdgcn_mfma_f32_32x32x16_bf16(kf[d0], qf[d0], sT[kb], 0, 0, 0);
            }
        }
#if defined(MK_BGSPREAD) && defined(MK_BGLATE)
        if (bgact) { bg_store(bgc, lane); } BG_BEGIN();
#endif
        BG_FENCE(); BG_LD(0); BG_LD(1); BG_LD(2); BG_FENCE();
        if (!skip) {
            const int kbase = 64 * j + 4 * hi;
            if (MODE == 0) {
                if (j >= 4 * qb - 2) {
#pragma unroll
                    for (int kb = 0; kb < 2; ++kb)
#pragma unroll
                        for (int r = 0; r < 16; ++r) { int rel = q - (kbase + 32 * kb + (r & 3) + 8 * (r >> 2)); rel = rel < 0 ? 0 : (rel > 128 ? 128 : rel); sT[kb][r] += btab[rel]; }
                }
                if (j >= 4 * qb) {
#pragma unroll
                    for (int kb = 0; kb < 2; ++kb)
#pragma unroll
                        for (int r = 0; r < 16; ++r) { const int key = kbase + 32 * kb + (r & 3) + 8 * (r >> 2); if (key > q) sT[kb][r] = -INFINITY; }
                }
                float ma = fmaxf(fmaxf(sT[0][0], sT[0][1]), sT[1][0]), mb = fmaxf(fmaxf(sT[0][2], sT[0][3]), sT[1][1]);
                ma = fmaxf(fmaxf(ma, sT[1][2]), sT[1][3]);
#pragma unroll
                for (int r = 4; r < 16; r += 4) { ma = fmaxf(fmaxf(ma, sT[0][r]), sT[0][r + 1]); mb = fmaxf(fmaxf(mb, sT[0][r + 2]), sT[0][r + 3]);
                    ma = fmaxf(fmaxf(ma, sT[1][r]), sT[1][r + 1]); mb = fmaxf(fmaxf(mb, sT[1][r + 2]), sT[1][r + 3]); }
                float grow = fmaxf(ma, mb);
                grow = fmaxf(grow, permswap_other(grow));
                if (it == 0 || !__all(grow <= 8.0f)) {
                    const float delta = (it == 0) ? grow : fmaxf(grow, 0.f);
                    const float alpha = __builtin_amdgcn_exp2f(-delta);
                    mref += delta; lsum *= alpha;
#pragma unroll
                    for (int kb = 0; kb < 2; ++kb)
#pragma unroll
                        for (int r = 0; r < 16; ++r) sT[kb][r] -= delta;
#pragma unroll
                    for (int db = 0; db < 4; ++db)
#pragma unroll
                        for (int r = 0; r < 16; ++r) O[db][r] *= alpha;
                }
                f32x2 ps2 = {0.f, 0.f};
#pragma unroll
                for (int kb = 0; kb < 2; ++kb)
#pragma unroll
                    for (int r = 0; r < 16; r += 2) { const float p0 = __builtin_amdgcn_exp2f(sT[kb][r]), p1 = __builtin_amdgcn_exp2f(sT[kb][r + 1]); sT[kb][r] = p0; sT[kb][r + 1] = p1; ps2 += (f32x2){p0, p1}; }
                lsum += ps2[0] + ps2[1];
            } else {
                const bool band = (j >= 4 * qb);
                float suf = carry;
#pragma unroll
                for (int kb = 1; kb >= 0; --kb) {
                    float Lr[16], gs[4], pg[4];
#pragma unroll
                    for (int g4 = 0; g4 < 4; ++g4) {
                        float sgrp = 0.f;
#pragma unroll
                        for (int i = 0; i < 4; ++i) { const int r = g4 * 4 + i; const float z = sT[kb][r];
                            float L = -(fmaxf(z, 0.f) + __builtin_amdgcn_logf(1.0f + __builtin_amdgcn_exp2f(-fabsf(z))));
                            if (band) { const int key = kbase + 32 * kb + i + 8 * g4; if (key >= q) L = 0.f; }
                            Lr[r] = L; sgrp += L; }
                        gs[g4] = sgrp;
                    }
#pragma unroll
                    for (int g4 = 0; g4 < 4; ++g4) pg[g4] = permswap_other(gs[g4]);
#pragma unroll
                    for (int g4 = 3; g4 >= 0; --g4) {
                        float cacc = suf + (hi == 0 ? pg[g4] : 0.f);
#pragma unroll
                        for (int i = 3; i >= 0; --i) { const int r = g4 * 4 + i; cacc += Lr[r]; const float z = sT[kb][r];
                            float a = __builtin_amdgcn_exp2f(z + cacc);
                            if (band) { const int key = kbase + 32 * kb + i + 8 * g4; if (key >= q) a = 0.f; }
                            sT[kb][r] = a; }
                        suf += gs[g4] + pg[g4];
                    }
                }
                carry = suf;
            }
#pragma unroll
            for (int kb = 0; kb < 2; ++kb)
#pragma unroll
                for (int s = 0; s < 2; ++s) { u32x4 w; w.x = cvt_pk_bf16(sT[kb][8 * s + 0], sT[kb][8 * s + 1]); w.y = cvt_pk_bf16(sT[kb][8 * s + 2], sT[kb][8 * s + 3]);
                    w.z = cvt_pk_bf16(sT[kb][8 * s + 4], sT[kb][8 * s + 5]); w.w = cvt_pk_bf16(sT[kb][8 * s + 6], sT[kb][8 * s + 7]); pf[kb][s] = __builtin_bit_cast(bf16x8, w); }
        }
        BG_FENCE(); BG_LD(3); BG_LD(4); BG_LD(5); BG_FENCE();
        if (!skip) {
            {
                bf16x8 af[3];
#define AT_VFRAG(m, dst) do { const MK_LAS unsigned char* _vp = lds + bo + va + (32 * (((m) >> 1) & 1) + 16 * ((m) & 1)) * VSTR + ((m) >> 2) * 64; \
                    const s16x4 _a0 = __builtin_bit_cast(s16x4, __builtin_amdgcn_ds_read_tr16_b64_v4i16((MK_LAS s16x4*)_vp)); \
                    const s16x4 _a1 = __builtin_bit_cast(s16x4, __builtin_amdgcn_ds_read_tr16_b64_v4i16((MK_LAS s16x4*)(_vp + 8 * VSTR))); \
                    dst[0] = _a0[0]; dst[1] = _a0[1]; dst[2] = _a0[2]; dst[3] = _a0[3]; dst[4] = _a1[0]; dst[5] = _a1[1]; dst[6] = _a1[2]; dst[7] = _a1[3]; } while (0)
                AT_VFRAG(0, af[0]); AT_VFRAG(1, af[1]);
                __builtin_amdgcn_sched_barrier(0);
#pragma unroll
                for (int m = 0; m < 16; ++m) {
                    if (m + 2 < 16) AT_VFRAG(m + 2, af[(m + 2) % 3]);
                    __builtin_amdgcn_sched_barrier(0);
                    O[m >> 2] = __builtin_amdgcn_mfma_f32_32x32x16_bf16(af[m % 3], pf[(m >> 1) & 1][m & 1], O[m >> 2], 0, 0, 0);
                    __builtin_amdgcn_sched_barrier(0);
                }
#undef AT_VFRAG
            }
        }
        BG_FENCE(); BG_LD(6); BG_LD(7); BG_FENCE();
#undef BG_LD
#undef BG_FENCE
#ifdef BG_BEGIN
#undef BG_BEGIN
#endif
        if (it + 1 < nt) AT_LWRITE((unsigned)((it + 1) & 1) * BUF);
        if (MODE == 1) { const bool dead = __all(carry < -160.0f); if (lane == 0) flags[(it & 1) * 8 + wid] = dead ? 1u : 0u; }
        __syncthreads();
        if (MODE == 1) {
            const u32x4 f0 = *(const MK_LAS u32x4*)(flags + (it & 1) * 8), f1 = *(const MK_LAS u32x4*)(flags + (it & 1) * 8 + 4);
            if ((f0.x & f0.y & f0.z & f0.w & f1.x & f1.y & f1.z & f1.w) != 0u) break;
        }
    }
#ifdef MK_BGCONV
    if (MODE == 0) bg_store(bgc, lane);
#endif
#undef AT_GLOAD
#undef AT_LWRITE
}

__device__ __forceinline__ void attn_unit_diff(const Frame& F, const bf16_t* __restrict__ proj, bf16_t* __restrict__ mixin, int b, int h, int qb,
                                               const float* __restrict__ relb, const float* __restrict__ lamp, float lam_init, const float* __restrict__ subg BG_PARAM) {
    MK_LAS float* btab = (MK_LAS float*)(F.lds + LDS_BTAB);
    MK_LAS float* misc = (MK_LAS float*)(F.lds + LDS_MISC);
    if (F.tid < 264) { const int m = F.tid / 132, i = F.tid % 132;
        float v = 0.f;
        if (i < 128) v = (relb[(t5_bucket(i) * NH + h) * 2 + m] - relb[(31 * NH + h) * 2 + m]) * LOG2E;
        btab[m * 132 + i] = v; }
    if (F.wave == 7) { float a = lamp[F.lane] * lamp[64 + F.lane], c2 = lamp[128 + F.lane] * lamp[192 + F.lane]; a = wave_sum(a); c2 = wave_sum(c2);
        if (F.lane == 0) misc[4] = expf(a) - expf(c2) + lam_init; }
    __syncthreads();
    const float lam = misc[4];
    const bf16_t* base = proj + (size_t)b * S * INC;
    const int hi = F.lane >> 5, r32 = F.lane & 31;
    f32x16 O[4]; float ls;
    MK_LAS u32x4* stash = (MK_LAS u32x4*)(F.lds + 59392) + F.tid;
    attn_pass<0>(F.lds, base, (2 * h) * 64, 1024 + (2 * h) * 64, 2048 + h * 128, qb, btab, O, ls BG_ARG);
    { const float inv = 1.0f / (ls + permswap_other(ls));
#pragma unroll
        for (int db = 0; db < 4; ++db)
#pragma unroll
            for (int r = 0; r < 16; r += 8) { u32x4 pk;
                pk.x = cvt_pk_bf16(O[db][r] * inv, O[db][r + 1] * inv); pk.y = cvt_pk_bf16(O[db][r + 2] * inv, O[db][r + 3] * inv);
                pk.z = cvt_pk_bf16(O[db][r + 4] * inv, O[db][r + 5] * inv); pk.w = cvt_pk_bf16(O[db][r + 6] * inv, O[db][r + 7] * inv);
                stash[(db * 2 + (r >> 3)) * NTHR] = pk; } }
    attn_pass<0>(F.lds, base, (2 * h + 1) * 64, 1024 + (2 * h + 1) * 64, 2048 + h * 128, qb, btab + 132, O, ls BG_ARG);
    const float inv1 = lam / (ls + permswap_other(ls));
    float ss = 0.f;
#pragma unroll
    for (int db = 0; db < 4; ++db)
#pragma unroll
        for (int r8 = 0; r8 < 16; r8 += 8) { const u32x4 pk = stash[(db * 2 + (r8 >> 3)) * NTHR];
#pragma unroll
            for (int i = 0; i < 4; ++i) { const unsigned w = pk[i]; const int r = r8 + 2 * i;
                const float oa = bf16_lo(w) - O[db][r] * inv1, ob = bf16_hi(w) - O[db][r + 1] * inv1;
                O[db][r] = oa; O[db][r + 1] = ob; ss += oa * oa + ob * ob; } }
    ss += permswap_other(ss);
    const float rn = rsqrtf(ss * (1.0f / 128.0f) + SUBLN_EPS) * (1.0f - lam_init);
    const int q = qb * 256 + F.wave * 32 + r32;
    bf16_t* orow = mixin + (size_t)(b * S + q) * D + h * 128;
#pragma unroll
    for (int db = 0; db < 4; ++db)
#pragma unroll
        for (int g4 = 0; g4 < 4; ++g4) { const int d0 = 32 * db + 8 * g4 + 4 * hi; const f32x4 gv = *(const f32x4*)(subg + d0);
            u32x2 o; o.x = cvt_pk_bf16(O[db][4 * g4] * rn * gv[0], O[db][4 * g4 + 1] * rn * gv[1]); o.y = cvt_pk_bf16(O[db][4 * g4 + 2] * rn * gv[2], O[db][4 * g4 + 3] * rn * gv[3]);
            *(u32x2*)(orow + d0) = o; }
}
__device__ __forceinline__ void attn_unit_sb(const Frame& F, const bf16_t* __restrict__ proj, bf16_t* __restrict__ mixin, int b, int h, int qb) {
    const bf16_t* base = proj + (size_t)b * S * INC;
    const int hi = F.lane >> 5, r32 = F.lane & 31;
    f32x16 O[4]; float ls;
#ifdef MK_BGCONV
    BgConv bgc; bgc.next = BG_ITEMS; bgc.cur = -1; bgc.step = 0; bgc.mode = 0;
#pragma unroll
    for (int j = 0; j < 8; ++j) bgc.p[j] = (f32x2){0.f, 0.f};
#endif
    attn_pass<1>(F.lds, base, 3072 + h * 128, 4096 + h * 128, 5120 + h * 128, qb, nullptr, O, ls BG_ARG);
    const int q = qb * 256 + F.wave * 32 + r32;
    bf16_t* orow = mixin + (size_t)(b * S + q) * D + 1024 + h * 128;
#pragma unroll
    for (int db = 0; db < 4; ++db)
#pragma unroll
        for (int g4 = 0; g4 < 4; ++g4) { const int d0 = 32 * db + 8 * g4 + 4 * hi;
            u32x2 o; o.x = cvt_pk_bf16(O[db][4 * g4], O[db][4 * g4 + 1]); o.y = cvt_pk_bf16(O[db][4 * g4 + 2], O[db][4 * g4 + 3]);
            *(u32x2*)(orow + d0) = o; }
}
__device__ __forceinline__ void phase_attention(const Frame& F, const In& in, const Ws& w, int l, int mask = 3) {
    const float lam_init = 0.8f - 0.6f * expf(-0.3f * (float)l);
#ifdef MK_BGCONV
    BgConv bgc; bgc.wg = in.w_gate + (size_t)l * NE * D * DE; bgc.wu = in.w_up + (size_t)l * NE * D * DE; bgc.wd = in.w_down + (size_t)l * NE * DE * D;
    bgc.tgu = w.wt_gu + (size_t)l * NE * 2048 * D; bgc.td = w.wt_d + (size_t)l * NE * D * DE;
    bgc.next = ((mask & 1) && !(mask & 4)) ? (int)blockIdx.x * NWAVES + F.wave : BG_ITEMS; bgc.step = F.G * NWAVES; bgc.cur = -1; bgc.mode = mask >> 4;
#pragma unroll
    for (int j = 0; j < 8; ++j) bgc.p[j] = (f32x2){0.f, 0.f};
#endif
    for (int it = F.vcu; it < 512; it += F.G) {
        const int sb = it >> 8, i = it & 255, bh = i >> 3, pr = i & 7, b = bh >> 3, h = bh & 7;
        if (!((mask >> sb) & 1)) continue;
        if (!sb) {
            attn_unit_diff(F, w.proj, w.mixin, b, h, 15 - pr, in.relb, in.lam + l * 256, lam_init, in.subg + l * 128 BG_ARG);
            attn_unit_diff(F, w.proj, w.mixin, b, h, pr, in.relb, in.lam + l * 256, lam_init, in.subg + l * 128 BG_ARG);
        } else {
            attn_unit_sb(F, w.proj, w.mixin, b, h, 15 - pr);
            attn_unit_sb(F, w.proj, w.mixin, b, h, pr);
        }
    }
#ifdef MK_BGCONV
    while (bgc.next < BG_ITEMS) { bg_load(bgc, F.lane); bg_store(bgc, F.lane); }
#endif
}

#define ROWF4(base, j) ((f32x4*)((char*)(base) + (((j) < 4) ? of0 : of1) + ((j) & 3) * 1024))
#define ROWH4(base, j) ((u32x2*)((char*)(base) + oh0 + (j) * 512))
__device__ __forceinline__ void phase_router_t(const Frame& F, const In& in, const Ws& w) {
    const int gt = F.vcu * NTHR + F.tid, NGT = F.G * NTHR;
    for (int i = gt; i < DEPTH * 48 * D; i += NGT) { const int l = i / (48 * D), r = i % (48 * D), n = r / D, k = r % D;
        const float v = n < 4 ? in.w_group[((size_t)l * D + k) * 4 + n] : (n < 36 ? in.w_router[((size_t)l * D + k) * 32 + (n - 4)] : 0.f);
        const unsigned hi = cvt_pk_bf16(v, 0.f) & 0xffffu; const float lo = v - __uint_as_float(hi << 16);
        w.wt_rh[i] = (bf16_t)hi; w.wt_rl[i] = (bf16_t)(cvt_pk_bf16(lo, 0.f) & 0xffffu); }
}
__device__ __forceinline__ void phase_ln1_route(const Frame& F, const In& in, const Ws& w, int l) {
    const float* modl = w.mod + (size_t)l * NB * 6 * D;
    const float* lng = in.ln_g + (size_t)(l * 2) * D; const float* lnb = in.ln_b + (size_t)(l * 2) * D;
    const float* xin = l == 0 ? in.x : w.xa;
    const bf16_t* wh = w.wt_rh + (size_t)l * 48 * D; const bf16_t* wlo = w.wt_rl + (size_t)l * 48 * D;
    const float* bg = in.b_group + l * 4; const float* br = in.b_router + l * 32;
    int* cnt = (int*)(w.ctl + CTL_CNT) + l * 32;
    MK_LAS float* lg = (MK_LAS float*)F.lds;
    MK_LAS float* part = (MK_LAS float*)(F.lds + 16384);
    for (int pass = F.vcu; pass < M / 64; pass += F.G) {
        const int t0 = pass * 64;
        {
            const int tw = t0 + F.wave * 8;
            const float* mb = modl + (size_t)(tw / S) * 6 * D;
            const unsigned of0 = (unsigned)F.lane * 16u, of1 = of0 + 4096u, oh0 = (unsigned)F.lane * 8u;
            f32x4 xv[8]; u32x2 mv[8];
#ifdef MK_BF16RES
            u32x2 xh[8];
            const bf16_t* xinh = (const bf16_t*)w.xa;
#define LN1_LOADX(t_) do { if (l == 0) { const float* xr = xin + (size_t)(t_) * D; _Pragma("unroll") for (int j = 0; j < 8; ++j) xv[j] = *ROWF4(xr, j); } \
                           else { const bf16_t* xr = xinh + (size_t)(t_) * D; _Pragma("unroll") for (int j = 0; j < 8; ++j) xh[j] = *ROWH4(xr, j); } } while (0)
#define LN1_X(j) (l == 0 ? xv[j] : (f32x4){bf16_lo(xh[j].x), bf16_hi(xh[j].x), bf16_lo(xh[j].y), bf16_hi(xh[j].y)})
#else
#define LN1_LOADX(t_) do { const float* xr = xin + (size_t)(t_) * D; _Pragma("unroll") for (int j = 0; j < 8; ++j) xv[j] = *ROWF4(xr, j); } while (0)
#define LN1_X(j) xv[j]
#endif
            { const bf16_t* mr = w.mixb + (size_t)tw * D; LN1_LOADX(tw);
#pragma unroll
              for (int j = 0; j < 8; ++j) { mv[j] = *ROWH4(mr, j); } }
#pragma unroll 1
            for (int i = 0; i < 8; ++i) {
                const int t = tw + i;
                f32x4 v[8]; float s = 0.f;
#pragma unroll
                for (int j = 0; j < 8; ++j) { const f32x4 g1 = *ROWF4(mb + 2 * D, j) + 1.0f;
                    f32x4 mx; mx[0] = bf16_lo(mv[j].x); mx[1] = bf16_hi(mv[j].x); mx[2] = bf16_lo(mv[j].y); mx[3] = bf16_hi(mv[j].y);
                    v[j] = LN1_X(j) * ALPHA + g1 * mx; s += (v[j][0] + v[j][1]) + (v[j][2] + v[j][3]); }
                if (i < 7) {
                    const bf16_t* mr = w.mixb + (size_t)(t + 1) * D; LN1_LOADX(t + 1);
#pragma unroll
                    for (int j = 0; j < 8; ++j) { mv[j] = *ROWH4(mr, j); }
                }
                const float mu = wave_sum(s) * (1.0f / D);
                float s2 = 0.f;
#pragma unroll
                for (int j = 0; j < 8; ++j) { v[j] = v[j] - mu; s2 += (v[j][0] * v[j][0] + v[j][1] * v[j][1]) + (v[j][2] * v[j][2] + v[j][3] * v[j][3]); }
                const float rs = rsqrtf(wave_sum(s2) * (1.0f / D) + LN_EPS);
                float* x1r = w.x1 + (size_t)t * D; bf16_t* abr = w.ab + (size_t)t * D; bf16_t* alr = w.ablo + (size_t)t * D;
#pragma unroll
                for (int j = 0; j < 8; ++j) {
                    const f32x4 gg = *ROWF4(lng, j), bb = *ROWF4(lnb, j);
                    const f32x4 xo = v[j] * rs * gg + bb;
#ifdef MK_BF16RES
                    { u32x2 xp; xp.x = cvt_pk_bf16(xo[0], xo[1]); xp.y = cvt_pk_bf16(xo[2], xo[3]); *ROWH4((bf16_t*)w.x1 + (size_t)t * D, j) = xp; }
#else
                    *ROWF4(x1r, j) = xo;
#endif
                    const f32x4 sh = *ROWF4(mb + 3 * D, j), scv = *ROWF4(mb + 4 * D, j);
                    const f32x4 u = xo * (scv + 1.0f) + sh;
                    u32x2 o; o.x = cvt_pk_bf16(u[0], u[1]); o.y = cvt_pk_bf16(u[2], u[3]);
                    *ROWH4(abr, j) = o;
                    u32x2 ol; ol.x = cvt_pk_bf16(u[0] - bf16_lo(o.x), u[1] - bf16_hi(o.x)); ol.y = cvt_pk_bf16(u[2] - bf16_lo(o.y), u[3] - bf16_hi(o.y));
                    *ROWH4(alr, j) = ol; }
            }
        }
#undef LN1_LOADX
#undef LN1_X
        asm volatile("s_waitcnt vmcnt(0)" ::: "memory");
        __syncthreads();
        {
            const int rt = F.wave & 3, kh = F.wave >> 2, fr = F.lane & 15, fq = F.lane >> 4;
            const bf16_t* ah = w.ab + (size_t)(t0 + rt * 16 + fr) * D + kh * 1024 + fq * 8;
            const bf16_t* al = w.ablo + (size_t)(t0 + rt * 16 + fr) * D + kh * 1024 + fq * 8;
            const bf16_t* bh = wh + (size_t)fr * D + kh * 1024 + fq * 8;
            const bf16_t* bl = wlo + (size_t)fr * D + kh * 1024 + fq * 8;
            f32x4 acc[3];
#pragma unroll
            for (int nt = 0; nt < 3; ++nt) acc[nt] = (f32x4){0.f, 0.f, 0.f, 0.f};
#pragma unroll 4
            for (int sidx = 0; sidx < 32; ++sidx) {
                const bf16x8 fah = *(const bf16x8*)(ah + sidx * 32), fal = *(const bf16x8*)(al + sidx * 32);
#pragma unroll
                for (int nt = 0; nt < 3; ++nt) { const bf16x8 fbh = *(const bf16x8*)(bh + (size_t)nt * 16 * D + sidx * 32), fbl = *(const bf16x8*)(bl + (size_t)nt * 16 * D + sidx * 32);
                    acc[nt] = __builtin_amdgcn_mfma_f32_16x16x32_bf16(fah, fbh, acc[nt], 0, 0, 0);
                    acc[nt] = __builtin_amdgcn_mfma_f32_16x16x32_bf16(fah, fbl, acc[nt], 0, 0, 0);
                    acc[nt] = __builtin_amdgcn_mfma_f32_16x16x32_bf16(fal, fbh, acc[nt], 0, 0, 0); }
            }
            if (kh == 1) {
#pragma unroll
                for (int nt = 0; nt < 3; ++nt) *(MK_LAS f32x4*)(part + ((rt * 3 + nt) * 64 + F.lane) * 4) = acc[nt];
            }
            __syncthreads();
            if (kh == 0) {
#pragma unroll
                for (int nt = 0; nt < 3; ++nt) { const f32x4 o = acc[nt] + *(const MK_LAS f32x4*)(part + ((rt * 3 + nt) * 64 + F.lane) * 4);
#pragma unroll
                    for (int r = 0; r < 4; ++r) lg[(rt * 16 + fq * 4 + r) * 49 + nt * 16 + fr] = o[r]; }
            }
            __syncthreads();
        }
        if (F.tid < 64) {
            const int t = t0 + F.tid; const MK_LAS float* lr = lg + F.tid * 49;
            float gl[4]; int gi = 0;
#pragma unroll
            for (int i = 0; i < 4; ++i) gl[i] = lr[i] + bg[i];
            float gm = gl[0];
#pragma unroll
            for (int i = 1; i < 4; ++i) if (gl[i] > gm) { gm = gl[i]; gi = i; }
            float gsum = 0.f;
#pragma unroll
            for (int i = 0; i < 4; ++i) gsum += expf(gl[i] - gm);
            const float gp = 1.0f / gsum;
            float el[8];
#pragma unroll
            for (int j = 0; j < 8; ++j) el[j] = lr[4 + gi * 8 + j] + br[gi * 8 + j];
            int i0 = 0; float v0 = el[0];
#pragma unroll
            for (int j = 1; j < 8; ++j) if (el[j] > v0) { v0 = el[j]; i0 = j; }
            int i1 = 0; float v1 = -INFINITY;
#pragma unroll
            for (int j = 0; j < 8; ++j) if (j != i0 && el[j] > v1) { v1 = el[j]; i1 = j; }
            const float e1 = expf(v1 - v0);
            const float w0 = gp / (1.0f + e1), w1 = gp * e1 / (1.0f + e1);
            const int ea = gi * 8 + i0, eb = gi * 8 + i1;
#ifdef MK_RANKAGG
            MK_LAS int* hist = (MK_LAS int*)(F.lds + 32768);
            if (F.tid < 32) hist[F.tid] = 0;
            asm volatile("s_waitcnt lgkmcnt(0)" ::: "memory"); __builtin_amdgcn_wave_barrier();
            const int la = __atomic_fetch_add(hist + ea, 1, __ATOMIC_RELAXED), lb = __atomic_fetch_add(hist + eb, 1, __ATOMIC_RELAXED);
            asm volatile("s_waitcnt lgkmcnt(0)" ::: "memory"); __builtin_amdgcn_wave_barrier();
            if (F.tid < 32) { const int c = hist[F.tid]; hist[32 + F.tid] = c ? atomicAdd(&cnt[F.tid], c) : 0; }
            asm volatile("s_waitcnt vmcnt(0) lgkmcnt(0)" ::: "memory"); __builtin_amdgcn_wave_barrier();
            const int ra = hist[32 + ea] + la, rb = hist[32 + eb] + lb;
#else
            const int ra = atomicAdd(&cnt[ea], 1), rb = atomicAdd(&cnt[eb], 1);
#endif
            w.tok_of[ea * M + ra] = t; w.tok_of[eb * M + rb] = t;
            *(int4*)(w.tokinfo + 4 * t) = make_int4(ea, ra, eb, rb);
            *(float2*)(w.tokw + 2 * t) = make_float2(w0, w1);
        }
        __syncthreads();
    }
}

__device__ __forceinline__ void moe_tables(const Frame& F, const Ws& w, int l) {
    MK_LAS int* pexp = (MK_LAS int*)(F.lds + LDS_PEXP);
    MK_LAS int* pbase = (MK_LAS int*)(F.lds + LDS_PBASE);
    MK_LAS int* cl = (MK_LAS int*)(F.lds + LDS_CNT);
    const int* cnt = (const int*)(w.ctl + CTL_CNT) + l * 32;
    __syncthreads();
    if (F.tid < 32) cl[F.tid] = cnt[F.tid];
    __syncthreads();
    if (F.tid == 0) { int p = 0; for (int e = 0; e < NE; ++e) { pbase[e] = p; const int np = (cl[e] + 255) >> 8; for (int i = 0; i < np; ++i) pexp[p + i] = e; p += np; } pbase[NE] = p; }
    __syncthreads();
}
template <class Sched>
__device__ __forceinline__ void moe_gather_table(const Frame& F, const Ws& w, const Sched& Sc) {
    MK_LAS int* tokl = (MK_LAS int*)(F.lds + LDS_TOKL);
    const MK_LAS int* pbase = (const MK_LAS int*)(F.lds + LDS_PBASE);
    const MK_LAS int* cl = (const MK_LAS int*)(F.lds + LDS_CNT);
    for (int i = 0; i < MAXU; ++i) { Unit u; if (!Sc.next(i, u)) break;
        if (F.tid < 256) { const int e = u.e; int rank = (u.pm - pbase[e]) * 256 + F.tid; const int ce = cl[e]; rank = rank < ce ? rank : ce - 1;
            tokl[i * 256 + F.tid] = w.tok_of[e * M + rank]; } }
    __syncthreads();
}

__device__ __forceinline__ void phase_ln2(const Frame& F, const In& in, const Ws& w, int l, float* __restrict__ xout, const float* __restrict__ nmod) {
    const float* modl = w.mod + (size_t)l * NB * 6 * D;
    const float* lng = in.ln_g + (size_t)(l * 2 + 1) * D; const float* lnb = in.ln_b + (size_t)(l * 2 + 1) * D;
    const MK_LAS int* pbase = (const MK_LAS int*)(F.lds + LDS_PBASE);
    const int gw = F.vcu * NWAVES + F.wave, NGW = F.G * NWAVES;
    const unsigned of0 = (unsigned)F.lane * 16u, of1 = of0 + 4096u, oh0 = (unsigned)F.lane * 8u;
    for (int tb = gw * 8; tb < M; tb += NGW * 8) {
        const int bidx = tb / S;
        const float* mb = modl + (size_t)bidx * 6 * D;
#ifdef MK_BF16RES
        u32x2 xv[8], ya[8], yb[8]; float2 tw, tw_n;
#define LN2_LOADX(_xr, j) xv[j] = *ROWH4((const bf16_t*)w.x1 + (size_t)(_xr) * D, j)
#define LN2_X(j) ((f32x4){bf16_lo(xv[j].x), bf16_hi(xv[j].x), bf16_lo(xv[j].y), bf16_hi(xv[j].y)})
#else
        f32x4 xv[8]; u32x2 ya[8], yb[8]; float2 tw, tw_n;
#define LN2_LOADX(_xr, j) xv[j] = *ROWF4(w.x1 + (size_t)(_xr) * D, j)
#define LN2_X(j) xv[j]
#endif
#define LN2_FETCH(t) do { const int4 _ti = *(const int4*)(w.tokinfo + 4 * (t)); tw_n = *(const float2*)(w.tokw + 2 * (t)); \
            const int _r0 = __builtin_amdgcn_readfirstlane(pbase[_ti.x] * 256 + _ti.y), _r1 = __builtin_amdgcn_readfirstlane(pbase[_ti.z] * 256 + _ti.w); \
            const bf16_t* _y0 = w.Yb + (size_t)_r0 * D; const bf16_t* _y1 = w.Yb + (size_t)_r1 * D; \
            _Pragma("unroll") for (int j = 0; j < 8; ++j) { LN2_LOADX(t, j); ya[j] = *ROWH4(_y0, j); yb[j] = *ROWH4(_y1, j); } } while (0)
        LN2_FETCH(tb); tw = tw_n;
#pragma unroll 1
        for (int i = 0; i < 8; ++i) {
            const int t = tb + i;
            f32x4 v[8]; float s = 0.f;
#pragma unroll
            for (int j = 0; j < 8; ++j) {
                const u32x2 a = ya[j], c2 = yb[j];
                f32x4 y; y[0] = tw.x * bf16_lo(a.x) + tw.y * bf16_lo(c2.x); y[1] = tw.x * bf16_hi(a.x) + tw.y * bf16_hi(c2.x);
                y[2] = tw.x * bf16_lo(a.y) + tw.y * bf16_lo(c2.y); y[3] = tw.x * bf16_hi(a.y) + tw.y * bf16_hi(c2.y);
                const f32x4 g2 = *ROWF4(mb + 5 * D, j) + 1.0f;
                v[j] = LN2_X(j) * ALPHA + g2 * y;
                s += (v[j][0] + v[j][1]) + (v[j][2] + v[j][3]); }
            if (i < 7) { LN2_FETCH(t + 1); }
            const float mu = wave_sum(s) * (1.0f / D);
            float s2 = 0.f;
#pragma unroll
            for (int j = 0; j < 8; ++j) { v[j] = v[j] - mu; s2 += (v[j][0] * v[j][0] + v[j][1] * v[j][1]) + (v[j][2] * v[j][2] + v[j][3] * v[j][3]); }
            const float rs = rsqrtf(wave_sum(s2) * (1.0f / D) + LN_EPS);
            float* xor_ = xout + (size_t)t * D; bf16_t* abr = w.ab + (size_t)t * D;
#pragma unroll
            for (int j = 0; j < 8; ++j) {
                const f32x4 gg = *ROWF4(lng, j), bb = *ROWF4(lnb, j);
                const f32x4 xo = v[j] * rs * gg + bb;
#ifdef MK_BF16RES
                if (nmod) { u32x2 xp; xp.x = cvt_pk_bf16(xo[0], xo[1]); xp.y = cvt_pk_bf16(xo[2], xo[3]); *ROWH4((bf16_t*)xout + (size_t)t * D, j) = xp; }
                else *ROWF4(xor_, j) = xo;
#else
                *ROWF4(xor_, j) = xo;
#endif
                if (nmod) { const float* nb = nmod + (size_t)bidx * 6 * D; const f32x4 sh = *ROWF4(nb, j), scv = *ROWF4(nb + D, j);
                    const f32x4 u = xo * (scv + 1.0f) + sh; u32x2 o; o.x = cvt_pk_bf16(u[0], u[1]); o.y = cvt_pk_bf16(u[2], u[3]); *ROWH4(abr, j) = o; }
            }
            tw = tw_n;
        }
#undef LN2_FETCH
#undef LN2_LOADX
#undef LN2_X
    }
}
struct Args { In in; Ws w; float* out; int l, cv_lo, cv_hi, pad; };

__device__ __forceinline__ Frame make_frame(unsigned char* lds_generic) {
    Frame F; F.lds = (MK_LAS unsigned char*)lds_generic;
    F.tid = ltid(); F.lane = F.tid & 63; F.wave = __builtin_amdgcn_readfirstlane(F.tid >> 6);
    F.G = gridDim.x; { const int bx = blockIdx.x; F.vcu = (F.G % 8 == 0) ? (bx % 8) * (F.G / 8) + bx / 8 : bx; }
    return F;
}

template <int PH>
__device__ __forceinline__ void run_phase(const Frame& F, const Args& a, int l) {
    const In& in = a.in; const Ws& w = a.w;
    if constexpr (PH == 0) { phase_convert(F, in, w, a.cv_lo, a.cv_hi); phase_mod(F, in, w); phase_router_t(F, in, w); }
    if constexpr (PH == 1) { phase_modulate(F, in.x, w.mod, w.ab); }
    if constexpr (PH == 2) { SchedDense Sd; Sd.init(w.ab, w.wt_in + (size_t)l * INC * D, M, INC, D, F.G, (int)blockIdx.x); EpiProj E{w.proj}; gemm_phase(F.lds, D, Sd, E); }
    if constexpr (PH == 3) { phase_attention(F, in, w, l); }
    if constexpr (PH == 31) { phase_attention(F, in, w, l, 1); }
    if constexpr (PH == 32) { phase_attention(F, in, w, l, 2); }
    if constexpr (PH == 34) { phase_attention(F, in, w, l, 3 | 16); }
    if constexpr (PH == 35) { phase_attention(F, in, w, l, 3 | 32); }
    if constexpr (PH == 33) { phase_attention(F, in, w, l, 7); }
    if constexpr (PH == 4) { SchedDense Sd; Sd.init(w.mixin, w.wt_o + (size_t)l * D * D, M, D, D, F.G, (int)blockIdx.x);
        EpiDown E{w.mixb}; gemm_phase(F.lds, D, Sd, E); }
    if constexpr (PH == 5) { phase_ln1_route(F, in, w, l); }
    if constexpr (PH == 6) { moe_tables(F, w, l);
        SchedMoe<true> Sm; Sm.A = w.ab; Sm.Bt = w.wt_gu + (size_t)l * NE * 2048 * D; Sm.estride = (size_t)2048 * D; Sm.K = D;
        Sm.nunits = ((const MK_LAS int*)(F.lds + LDS_PBASE))[NE] * 8; Sm.G = F.G; Sm.c = (int)blockIdx.x;
        Sm.pexp = (const MK_LAS int*)(F.lds + LDS_PEXP); Sm.tokl = (const MK_LAS int*)(F.lds + LDS_TOKL);
        moe_gather_table(F, w, Sm);
#ifdef MK_F32B_UP
        BSrcUp Bu{in.w_gate + (size_t)l * NE * D * DE, in.w_up + (size_t)l * NE * D * DE, (size_t)D * DE, DE};
        EpiGU E{w.Hb}; gemm_phase_fb(F.lds, D, Sm, Bu, E); }
#else
        EpiGU E{w.Hb}; gemm_phase(F.lds, D, Sm, E); }
#endif
    if constexpr (PH >= 60 && PH <= 69) { moe_tables(F, w, l);
        SchedMoe<true> Sm; Sm.A = w.ab; Sm.Bt = w.wt_gu + (size_t)l * NE * 2048 * D; Sm.estride = (size_t)2048 * D; Sm.K = D;
        Sm.nunits = ((const MK_LAS int*)(F.lds + LDS_PBASE))[NE] * 8; Sm.G = F.G; Sm.c = (int)blockIdx.x;
        Sm.pexp = (const MK_LAS int*)(F.lds + LDS_PEXP); Sm.tokl = (const MK_LAS int*)(F.lds + LDS_TOKL);
        moe_gather_table(F, w, Sm);
        BSrcUp Bu{in.w_gate + (size_t)l * NE * D * DE, in.w_up + (size_t)l * NE * D * DE, (size_t)D * DE, DE};
        EpiGU E{w.wt_gu}; gemm_phase_fb<PH - 60>(F.lds, D, Sm, Bu, E); }
    if constexpr (PH >= 70 && PH <= 79) { moe_tables(F, w, l);
        SchedMoe<false> Sm; Sm.A = w.Hb; Sm.Bt = w.wt_d + (size_t)l * NE * D * DE; Sm.estride = (size_t)D * DE; Sm.K = DE;
        Sm.nunits = ((const MK_LAS int*)(F.lds + LDS_PBASE))[NE] * 8; Sm.G = F.G; Sm.c = (int)blockIdx.x;
        Sm.pexp = (const MK_LAS int*)(F.lds + LDS_PEXP); Sm.tokl = nullptr;
        BSrcDown Bd{in.w_down + (size_t)l * NE * DE * D, (size_t)DE * D, D};
        EpiDown E{w.wt_gu}; gemm_phase_fb<PH - 70>(F.lds, DE, Sm, Bd, E); }
    if constexpr (PH == 7) { moe_tables(F, w, l);
        SchedMoe<false> Sm; Sm.A = w.Hb; Sm.Bt = w.wt_d + (size_t)l * NE * D * DE; Sm.estride = (size_t)D * DE; Sm.K = DE;
        Sm.nunits = ((const MK_LAS int*)(F.lds + LDS_PBASE))[NE] * 8; Sm.G = F.G; Sm.c = (int)blockIdx.x;
        Sm.pexp = (const MK_LAS int*)(F.lds + LDS_PEXP); Sm.tokl = nullptr;
#ifdef MK_F32B_DOWN
        BSrcDown Bd{in.w_down + (size_t)l * NE * DE * D, (size_t)DE * D, D};
        EpiDown E{w.Yb}; gemm_phase_fb(F.lds, DE, Sm, Bd, E); }
#else
        EpiDown E{w.Yb}; gemm_phase(F.lds, DE, Sm, E); }
#endif
    if constexpr (PH == 8) { moe_tables(F, w, l);
        phase_ln2(F, in, w, l, l == DEPTH - 1 ? a.out : w.xa, l == DEPTH - 1 ? nullptr : w.mod + (size_t)(l + 1) * NB * 6 * D); }
}

template <int PH>
__global__ void __launch_bounds__(NTHR, 2) k_phase(Args a) {
    extern __shared__ __attribute__((aligned(16))) unsigned char lds_raw[];
    const Frame F = make_frame(lds_raw);
    run_phase<PH>(F, a, a.l);
}

static inline Ws carve(char* base, size_t& end, int nlw = DEPTH) {
    Ws w; size_t o = 0;
    auto take = [&](size_t bytes) { char* p = base + o; o += (bytes + 255) & ~(size_t)255; return p; };
    w.ctl = (unsigned*)take((size_t)CTL_WORDS * 4);
    w.mod = (float*)take((size_t)DEPTH * NB * 6 * D * 4);
    w.wt_in = (bf16_t*)take((size_t)nlw * INC * D * 2);
    w.wt_o = (bf16_t*)take((size_t)nlw * D * D * 2);
    w.ab = (bf16_t*)take((size_t)M * D * 2);
    w.proj = (bf16_t*)take((size_t)M * INC * 2);
    w.mixin = (bf16_t*)take((size_t)M * D * 2);
    w.mixb = (bf16_t*)take((size_t)M * D * 2);
    w.ablo = (bf16_t*)take((size_t)M * D * 2);
    w.x1 = (float*)take((size_t)M * D * 4);
    w.xa = (float*)take((size_t)M * D * 4);
    w.Hb = (bf16_t*)take((size_t)PROWS * DE * 2);
    w.Yb = (bf16_t*)take((size_t)PROWS * D * 2);
    w.tok_of = (int*)take((size_t)NE * M * 4);
    w.tokinfo = (int*)take((size_t)M * 16);
    w.tokw = (float*)take((size_t)M * 8);
    w.wt_rh = (bf16_t*)take((size_t)DEPTH * 48 * D * 2);
    w.wt_rl = (bf16_t*)take((size_t)DEPTH * 48 * D * 2);
    w.wt_gu = (bf16_t*)take((size_t)nlw * NE * 2048 * D * 2);
    w.wt_d = (bf16_t*)take((size_t)nlw * NE * D * DE * 2);
    end = o; return w;
}
static inline In make_in(void* const* d_in) {
    In in; const float* const* p = (const float* const*)d_in;
    in.x = p[0]; in.c = p[1]; in.w_ada = p[2]; in.b_ada = p[3]; in.w_in = p[4]; in.lam = p[5]; in.subg = p[6]; in.relb = p[7]; in.w_o = p[8]; in.ln_g = p[9]; in.ln_b = p[10];
    in.w_group = p[11]; in.b_group = p[12]; in.w_router = p[13]; in.b_router = p[14]; in.w_gate = p[15]; in.w_up = p[16]; in.w_down = p[17];
    return in;
}
template <int PH>
static inline void launch_phase(const Args& a, int grid, hipStream_t st) {
    static bool attr = false;
    if (!attr) { attr = true; (void)hipFuncSetAttribute((const void*)k_phase<PH>, hipFuncAttributeMaxDynamicSharedMemorySize, LDS_BYTES); }
    hipLaunchKernelGGL(k_phase<PH>, dim3(grid), dim3(NTHR), LDS_BYTES, st, a);
}
}
namespace mk {
typedef const __attribute__((address_space(4))) Args* KArgsPtr;
__device__ __forceinline__ void load_args(Args& a) {
    KArgsPtr p = (KArgsPtr)__builtin_amdgcn_kernarg_segment_ptr();
    asm volatile("" : "+s"(p));
    __builtin_memcpy(&a, p, sizeof(Args));
}
#ifndef MK_REPEAT_PH
#define MK_REPEAT_PH -1
#endif
#define MK_PHASE1(PH, l) do { Args _a; load_args(_a); const Frame _F = make_frame(lds_raw); run_phase<PH>(_F, _a, (l)); } while (0)
#ifndef MK_REPEAT_AS
#define MK_REPEAT_AS MK_REPEAT_PH
#endif
#ifndef MK_REPEAT_N
#define MK_REPEAT_N 1
#endif
#define MK_PHASE(PH, l) do { MK_PHASE1(PH, l); if ((PH) == MK_REPEAT_PH && (l) == 0) { MK_BARRIER(); MK_PHASE1(MK_REPEAT_AS, l); if (MK_REPEAT_N > 1) { MK_BARRIER(); MK_PHASE1(MK_REPEAT_AS, l); } } } while (0)
#define MK_BARRIER() do { Args _a; load_args(_a); XcdBarrier _b; _b.bar = _a.w.ctl; _b.x = xb_xcc_id(); _b.st = (volatile LAS unsigned*)(F.lds + LDS_MISC); xcd_barrier(_b); } while (0)
__global__ void __launch_bounds__(NTHR, 2) k_mega(Args a) {
    extern __shared__ __attribute__((aligned(16))) unsigned char lds_raw[];
    const Frame F = make_frame(lds_raw);
    if (F.tid < 16) ((MK_LAS unsigned*)(F.lds + LDS_MISC))[F.tid] = 0u;
    __syncthreads();
    (void)xcd_barrier_post(a.w.ctl, (volatile LAS unsigned*)(F.lds + LDS_MISC));
    MK_PHASE(0, 0); MK_BARRIER();
    MK_PHASE(1, 0); MK_BARRIER();
#define MK_LAYER(l, last) do { \
        MK_PHASE(2, l); MK_BARRIER(); MK_PHASE(3, l); MK_BARRIER(); MK_PHASE(4, l); MK_BARRIER(); MK_PHASE(5, l); MK_BARRIER(); \
        MK_PHASE(6, l); MK_BARRIER(); MK_PHASE(7, l); MK_BARRIER(); MK_PHASE(8, l); if (!(last)) MK_BARRIER(); } while (0)
    MK_LAYER(0, false);
    MK_LAYER(1, true);
}
}

extern "C" void kernel_launch(void* const* d_in, const int* in_sizes, int n_in, void* d_out, int out_size, void* d_ws, size_t ws_size, hipStream_t stream) {
    static int grid = 0;
    if (grid == 0) {
        int dev = 0, cus = 0, per_cu = 0;
        (void)hipGetDevice(&dev); (void)hipDeviceGetAttribute(&cus, hipDeviceAttributeMultiprocessorCount, dev);
        if (hipFuncSetAttribute((const void*)mk::k_mega, hipFuncAttributeMaxDynamicSharedMemorySize, mk::LDS_BYTES) != hipSuccess) { fprintf(stderr, "kernel_launch: hipFuncSetAttribute failed\n"); grid = -1; return; }
        if (hipOccupancyMaxActiveBlocksPerMultiprocessor(&per_cu, (const void*)mk::k_mega, mk::NTHR, mk::LDS_BYTES) != hipSuccess || per_cu < 1)
            fprintf(stderr, "kernel_launch: occupancy query reports %d workgroups per CU\n", per_cu);
        (void)hipGetLastError();
        grid = cus > 0 ? cus : 256;
    }
    if (grid < 0) return;
    size_t end = 0;
    mk::Ws w = mk::carve((char*)d_ws, end, mk::DEPTH);
    if (end > ws_size) { fprintf(stderr, "kernel_launch: workspace too small: need %zu, have %zu\n", end, ws_size); return; }
    (void)hipMemsetAsync(w.ctl, 0, (size_t)mk::CTL_WORDS * 4, stream);
    mk::Args a; memset(&a, 0, sizeof(a));
    a.in = mk::make_in(d_in); a.w = w; a.out = (float*)d_out; a.l = 0; a.cv_lo = 0; a.cv_hi = mk::DEPTH * mk::CI_LAYER;
#ifdef MK_MULTI
    mk::launch_phase<0>(a, grid, stream); mk::launch_phase<1>(a, grid, stream);
    for (int l = 0; l < mk::DEPTH; ++l) { a.l = l;
        mk::launch_phase<2>(a, grid, stream); mk::launch_phase<3>(a, grid, stream); mk::launch_phase<4>(a, grid, stream); mk::launch_phase<5>(a, grid, stream);
        mk::launch_phase<6>(a, grid, stream); mk::launch_phase<7>(a, grid, stream); mk::launch_phase<8>(a, grid, stream); }
#else
    hipLaunchKernelGGL(mk::k_mega, dim3(grid), dim3(mk::NTHR), mk::LDS_BYTES, stream, a);
#endif
}
```

```cpp
#include <hip/hip_runtime.h>
#include <hip/hip_bf16.h>
#include <cstdio>
#include <cstdint>
#include <cmath>
#include <cstring>
#define MK_BGCONV 2
#define MK_BGMASK 1
#define MK_F32B_DOWN 1
#define MK_BF16RES 1
#define MK_BGSPREAD 1
#define MK_RANKAGG 1
#define MK_LNPAR 1
#define XB_TMO      128
#define XB_XCNT(j)  (256  + 64 * (j))
#define XB_XSUB(j)  (1280 + 64 * (j))
#define XB_XGEN(j)  (2304 + 64 * (j))
#define XB_TOP      3328
#define XB_TOPGEN   3392
#define XCD_BAR_WORDS 3456
#define XB_SPIN_CAP (1u << 22)
#define LAS __attribute__((address_space(3)))

__device__ __forceinline__ unsigned xb_ld(unsigned* p)              { return __hip_atomic_load(p, __ATOMIC_RELAXED, __HIP_MEMORY_SCOPE_AGENT); }
__device__ __forceinline__ unsigned xb_add(unsigned* p, unsigned v) { return __hip_atomic_fetch_add(p, v, __ATOMIC_RELAXED, __HIP_MEMORY_SCOPE_AGENT); }
__device__ __forceinline__ unsigned xb_xcc_id() { return (unsigned)__builtin_amdgcn_s_getreg((3 << 11) | 20) & 0xFu; }
#define XB_SPIN(cond, bar) do { unsigned _sp = 0; while (cond) { __builtin_amdgcn_s_sleep(1); \
    if ((++_sp & 255u) == 0u) { if (xb_ld(&(bar)[XB_TMO])) break; if (_sp > XB_SPIN_CAP) { atomicAdd(&(bar)[XB_TMO], 1u); break; } } } } while (0)

struct XcdBarrier {
    unsigned* bar; unsigned x;
    volatile LAS unsigned* st;
};

__device__ __forceinline__ XcdBarrier xcd_barrier_post(unsigned* bar, volatile LAS unsigned* st) {
    XcdBarrier b; b.bar = bar; b.x = xb_xcc_id(); b.st = st;
    if (threadIdx.x == 0) (void)xb_add(&bar[XB_XCNT(b.x)], 1u);
    return b;
}
__device__ __forceinline__ void xcd_barrier_complete(unsigned* bar, unsigned x, unsigned& nloc, unsigned& nx) {
    const unsigned G = gridDim.x * gridDim.y * gridDim.z;
    unsigned sum, cnt, mine, sp = 0u;
    for (;;) {
        sum = 0u; cnt = 0u; mine = 0u;
#pragma unroll
        for (unsigned j = 0; j < 16; ++j) { const unsigned c = xb_ld(&bar[XB_XCNT(j)]); sum += c; cnt += (c > 0u) ? 1u : 0u; mine = (j == x) ? c : mine; }
        if (sum == G) break;
        __builtin_amdgcn_s_sleep(1);
        if ((++sp & 255u) == 0u) { if (xb_ld(&bar[XB_TMO])) break; if (sp > XB_SPIN_CAP) { atomicAdd(&bar[XB_TMO], 1u); break; } }
    }
    nloc = mine > 0u ? mine : 1u; nx = cnt > 0u ? cnt : 1u;
}

__device__ __forceinline__ void xcd_barrier(const XcdBarrier& b) {
    asm volatile("s_waitcnt vmcnt(0)" ::: "memory");
    __syncthreads();
    if (threadIdx.x == 0) {
        unsigned* bar = b.bar;
        __builtin_amdgcn_s_waitcnt(0);
        unsigned nloc = b.st[0], nx = b.st[1];
        if (nloc == 0u) { xcd_barrier_complete(bar, b.x, nloc, nx); b.st[0] = nloc; b.st[1] = nx; }
        const unsigned old = xb_add(&bar[XB_XSUB(b.x)], 1u);
        const unsigned gen = old / nloc;
        if (old + 1u == (gen + 1u) * nloc) {
            __builtin_amdgcn_fence(__ATOMIC_RELEASE, "agent");
            asm volatile("s_waitcnt vmcnt(0)" ::: "memory");
            const unsigned og = xb_add(&bar[XB_TOP], 1u);
            const unsigned tg = og / nx;
            if (og + 1u == (tg + 1u) * nx) xb_add(&bar[XB_TOPGEN], 1u);
            else XB_SPIN(xb_ld(&bar[XB_TOPGEN]) == tg, bar);
            __builtin_amdgcn_fence(__ATOMIC_ACQUIRE, "agent");
            xb_add(&bar[XB_XGEN(b.x)], 1u);
            asm volatile("s_waitcnt vmcnt(0)" ::: "memory");
        } else {
            XB_SPIN(xb_ld(&bar[XB_XGEN(b.x)]) == gen, bar);
            __builtin_amdgcn_fence(__ATOMIC_ACQUIRE, "agent");
            asm volatile("s_waitcnt vmcnt(0)" ::: "memory");
        }
    }
    __syncthreads();
}

namespace mk {
#define MK_LAS __attribute__((address_space(3)))
typedef unsigned short bf16_t;
typedef short bf16x8 __attribute__((ext_vector_type(8)));
typedef short s16x4 __attribute__((ext_vector_type(4)));
typedef float f32x2 __attribute__((ext_vector_type(2)));
typedef float f32x4 __attribute__((ext_vector_type(4)));
typedef float f32x16 __attribute__((ext_vector_type(16)));
typedef unsigned u32x2 __attribute__((ext_vector_type(2)));
typedef unsigned u32x4 __attribute__((ext_vector_type(4)));

constexpr int D = 2048, NB = 4, S = 4096, M = NB * S, INC = 6144, NE = 32, DE = 1024, NH = 8, DEPTH = 2;
constexpr int NWAVES = 8, NTHR = 512;
constexpr float LOG2E = 1.4426950408889634f;
constexpr float LN_EPS = 1e-5f, SUBLN_EPS = 1e-5f;
constexpr float ALPHA = 1.4142135623730951f;
constexpr int PMAXP = 161;
constexpr int PROWS = PMAXP * 256;
constexpr int MAXU = 8;

__device__ __forceinline__ void st16(void* p, u32x4 v) {
#ifdef MK_WT
    asm volatile("global_store_dwordx4 %0, %1, off sc1\n\ts_nop 1" :: "v"(p), "v"(v) : "memory");
#else
    *(u32x4*)p = v;
#endif
}
__device__ __forceinline__ unsigned cvt_pk_bf16(float lo, float hi) { unsigned r; asm volatile("v_cvt_pk_bf16_f32 %0, %1, %2" : "=v"(r) : "v"(lo), "v"(hi)); return r; }
typedef __bf16 bf16v2 __attribute__((ext_vector_type(2)));
__device__ __forceinline__ unsigned cvt_pk_bf16_c(float lo, float hi) { const f32x2 v = {lo, hi}; return __builtin_bit_cast(unsigned, __builtin_convertvector(v, bf16v2)); }
__device__ __forceinline__ float bf16_lo(unsigned w) { return __uint_as_float(w << 16); }
__device__ __forceinline__ float bf16_hi(unsigned w) { return __uint_as_float(w & 0xffff0000u); }
__device__ __forceinline__ float wave_sum(float v) {
#pragma unroll
    for (int o = 1; o < 64; o <<= 1) v += __shfl_xor(v, o);
    return v;
}
__device__ __forceinline__ int ltid() { int t = threadIdx.x; asm volatile("" : "+v"(t)); return t; }
__device__ __forceinline__ int crow(int r, int hi) { return (r & 3) + 8 * (r >> 2) + 4 * hi; }

constexpr int BM = 256, BK = 64, HALF = 128, HTB = HALF * BK * 2, STAGE_BYTES = 8 * HTB, NXCD = 8, WGM = 8;
__host__ __device__ __forceinline__ int lds_byte(int r, int c) { const int st = (r >> 4) * 2 + (c >> 5), rr = r & 15, cc = c & 31, ob = rr * 64 + cc * 2; return st * 1024 + (ob ^ (((ob >> 9) & 1) << 5)); }
__host__ __device__ __forceinline__ void stage_rc(int b, int& R, int& C) { const int st = b / 1024, sb = b % 1024, swz = sb ^ (((sb >> 9) & 1) << 5); R = (st >> 1) * 16 + swz / 64; C = (st & 1) * 32 + (swz % 64) / 2; }
__host__ __device__ __forceinline__ int perm32(int rho) { const int n = rho >> 4, i = rho & 15; return 8 * (i >> 2) + 4 * n + (i & 3); }

struct Unit { int pm, pn, e; };

struct SchedDense {
    static constexpr bool GATHER = false;
    const bf16_t* A; const bf16_t* Bt; int K;
    int nM, nN, nwg, G, c;
    __device__ void init(const bf16_t* A_, const bf16_t* Bt_, int Mr, int N, int K_, int G_, int c_) { A = A_; Bt = Bt_; K = K_; nM = Mr / BM; nN = N / BM; nwg = nM * nN; G = G_; c = c_; }
    __device__ __forceinline__ bool next(int i, Unit& u) const {
        const long L = (long)i * G + c; if (L >= nwg) return false;
        int wgid = (int)L; { const int q = nwg / NXCD, r = nwg % NXCD, xcd = wgid % NXCD, off = wgid / NXCD; wgid = (xcd < r ? xcd * (q + 1) : r * (q + 1) + (xcd - r) * q) + off; }
        const int nig = WGM * nN, gid = wgid / nig, fm = gid * WGM, gsz = (nM - fm) < WGM ? (nM - fm) : WGM;
        u.pm = fm + ((wgid % nig) % gsz); u.pn = (wgid % nig) / gsz; u.e = 0; return true;
    }
    __device__ __forceinline__ const char* a_base(const Unit& u) const { return (const char*)A + (size_t)u.pm * BM * K * 2; }
    __device__ __forceinline__ const char* b_base(const Unit& u) const { return (const char*)Bt + (size_t)u.pn * BM * K * 2; }
    __device__ __forceinline__ void a_voff(int, const Unit&, const int (&R)[2], const int (&C)[2], unsigned (&v0)[2], unsigned (&v1)[2]) const {
#pragma unroll
        for (int j = 0; j < 2; ++j) { v0[j] = (unsigned)(R[j] * K + C[j]) * 2u; v1[j] = v0[j] + (unsigned)(HALF * K * 2); }
    }
};
template <bool GATHER_>
struct SchedMoe {
    static constexpr bool GATHER = GATHER_;
    const bf16_t* A; const bf16_t* Bt; size_t estride; int K;
    int nunits, G, c;
    const MK_LAS int* pexp;
    const MK_LAS int* tokl;
    __device__ __forceinline__ bool next(int i, Unit& u) const {
        const int L = i * G + c; if (L >= nunits || i >= MAXU) return false;
        int wgid = L; { const int q = nunits / NXCD, r = nunits % NXCD, xcd = wgid % NXCD, off = wgid / NXCD; wgid = (xcd < r ? xcd * (q + 1) : r * (q + 1) + (xcd - r) * q) + off; }
        u.pm = wgid >> 3; u.pn = wgid & 7; u.e = pexp[u.pm]; return true;
    }
    __device__ __forceinline__ const char* a_base(const Unit& u) const { return GATHER ? (const char*)A : (const char*)A + (size_t)u.pm * BM * K * 2; }
    __device__ __forceinline__ const char* b_base(const Unit& u) const { return (const char*)Bt + ((size_t)u.e * estride + (size_t)u.pn * BM * K) * 2; }
    __device__ __forceinline__ unsigned a_off1(int i, int half, int R, int C) const {
        if (GATHER) return (unsigned)(tokl[i * 256 + half * HALF + R] * K + C) * 2u;
        return (unsigned)((R + half * HALF) * K + C) * 2u;
    }
    __device__ __forceinline__ void a_voff(int i, const Unit&, const int (&R)[2], const int (&C)[2], unsigned (&v0)[2], unsigned (&v1)[2]) const {
#pragma unroll
        for (int j = 0; j < 2; ++j) {
            if (GATHER) { const int t0 = tokl[i * 256 + R[j]], t1 = tokl[i * 256 + HALF + R[j]];
                v0[j] = (unsigned)(t0 * K + C[j]) * 2u; v1[j] = (unsigned)(t1 * K + C[j]) * 2u; }
            else { v0[j] = (unsigned)(R[j] * K + C[j]) * 2u; v1[j] = v0[j] + (unsigned)(HALF * K * 2); }
        }
    }
};

struct EpiProj {
    static constexpr bool PERM = true;
    bf16_t* O;
    __device__ __forceinline__ void operator()(const f32x4 (&acc)[2][2][4][2], const Unit& u, int wr, int wc, int fr, int fq) const {
        const int row0 = u.pm * BM + wr * 64 + fr, col0 = u.pn * BM + wc * 32 + 8 * fq;
        const float s = (u.pn < 4) ? 0.125f * LOG2E : ((u.pn >= 12 && u.pn < 16) ? 0.08838834764831845f * LOG2E : 1.0f);
#pragma unroll
        for (int ai = 0; ai < 2; ++ai)
#pragma unroll
            for (int m = 0; m < 4; ++m) { bf16_t* rowp = O + (size_t)(row0 + ai * HALF + m * 16) * INC + col0;
#pragma unroll
                for (int bj = 0; bj < 2; ++bj) { const f32x4 v0 = acc[ai][bj][m][0] * s, v1 = acc[ai][bj][m][1] * s;
                    u32x4 w; w.x = cvt_pk_bf16(v0[0], v0[1]); w.y = cvt_pk_bf16(v0[2], v0[3]); w.z = cvt_pk_bf16(v1[0], v1[1]); w.w = cvt_pk_bf16(v1[2], v1[3]);
                    st16(rowp + bj * HALF, w); } }
    }
};
struct EpiWo {
    static constexpr bool PERM = false;
    const float* x; const float* gate; float* H;
    __device__ __forceinline__ void operator()(const f32x4 (&acc)[2][2][4][2], const Unit& u, int wr, int wc, int fr, int fq) const {
        const int row0 = u.pm * BM + wr * 64 + fr, col0 = u.pn * BM + wc * 32 + 4 * fq;
        const float* gp = gate + (size_t)(u.pm >> 4) * 6 * D + col0;
        f32x4 gv[2][2];
#pragma unroll
        for (int bj = 0; bj < 2; ++bj)
#pragma unroll
            for (int n = 0; n < 2; ++n) gv[bj][n] = *(const f32x4*)(gp + bj * HALF + n * 16) + 1.0f;
#pragma unroll
        for (int ai = 0; ai < 2; ++ai)
#pragma unroll
            for (int m = 0; m < 4; ++m) { const size_t off = (size_t)(row0 + ai * HALF + m * 16) * D + col0;
#pragma unroll
                for (int bj = 0; bj < 2; ++bj)
#pragma unroll
                    for (int n = 0; n < 2; ++n) { const f32x4 xv = *(const f32x4*)(x + off + bj * HALF + n * 16);
                        *(f32x4*)(H + off + bj * HALF + n * 16) = xv * ALPHA + gv[bj][n] * acc[ai][bj][m][n]; } }
    }
};
struct EpiGU {
    static constexpr bool PERM = true;
    bf16_t* Hb;
    __device__ __forceinline__ void operator()(const f32x4 (&acc)[2][2][4][2], const Unit& u, int wr, int wc, int fr, int fq) const {
        const int row0 = u.pm * BM + wr * 64 + fr, col0 = u.pn * HALF + wc * 32 + 8 * fq;
#pragma unroll
        for (int ai = 0; ai < 2; ++ai)
#pragma unroll
            for (int m = 0; m < 4; ++m) { bf16_t* rowp = Hb + (size_t)(row0 + ai * HALF + m * 16) * DE + col0;
                float h[8];
#pragma unroll
                for (int n = 0; n < 2; ++n)
#pragma unroll
                    for (int j = 0; j < 4; ++j) { const float g = acc[ai][0][m][n][j], up = acc[ai][1][m][n][j];
                        h[n * 4 + j] = g * __builtin_amdgcn_rcpf(1.0f + __builtin_amdgcn_exp2f(-g * LOG2E)) * up; }
                u32x4 w; w.x = cvt_pk_bf16(h[0], h[1]); w.y = cvt_pk_bf16(h[2], h[3]); w.z = cvt_pk_bf16(h[4], h[5]); w.w = cvt_pk_bf16(h[6], h[7]);
                st16(rowp, w); }
    }
};
struct EpiDown {
    static constexpr bool PERM = true;
    bf16_t* Y;
    __device__ __forceinline__ void operator()(const f32x4 (&acc)[2][2][4][2], const Unit& u, int wr, int wc, int fr, int fq) const {
        const int row0 = u.pm * BM + wr * 64 + fr, col0 = u.pn * BM + wc * 32 + 8 * fq;
#pragma unroll
        for (int ai = 0; ai < 2; ++ai)
#pragma unroll
            for (int m = 0; m < 4; ++m) { bf16_t* rowp = Y + (size_t)(row0 + ai * HALF + m * 16) * D + col0;
#pragma unroll
                for (int bj = 0; bj < 2; ++bj) { const f32x4 v0 = acc[ai][bj][m][0], v1 = acc[ai][bj][m][1];
                    u32x4 w; w.x = cvt_pk_bf16(v0[0], v0[1]); w.y = cvt_pk_bf16(v0[2], v0[3]); w.z = cvt_pk_bf16(v1[0], v1[1]); w.w = cvt_pk_bf16(v1[2], v1[3]);
                    st16(rowp + bj * HALF, w); } }
    }
};

template <class Epi, class Sched>
__device__ __forceinline__ void gemm_phase(MK_LAS unsigned char* lds, const int K, const Sched& S, const Epi& E) {
    const int tid = ltid(), wid = __builtin_amdgcn_readfirstlane(tid >> 6), lane = tid & 63, wr = wid >> 2, wc = wid & 3, fr = lane & 15, fq = lane >> 4;
    const int nt = K / BK;
    int Rr[2], Cc[2]; unsigned voffB[2];
#pragma unroll
    for (int i = 0; i < 2; ++i) { int R, C; stage_rc(tid * 16 + i * 8192, R, C); const int Rb = Epi::PERM ? ((R & ~31) + perm32(R & 31)) : R;
        Rr[i] = R; Cc[i] = C; voffB[i] = (unsigned)(Rb * K + C) * 2u; }
    const size_t kstep = (size_t)(BK * 2);
    const size_t hstep = (size_t)HALF * K * 2;
    const unsigned ldsw = (unsigned)wid * 1024u;
    const int aoff = lds_byte(wr * 64 + fr, fq * 8), boff = lds_byte(wc * 32 + fr, fq * 8);
#define PG8_SA(b, h) (((b) * 2 + (h)) * HTB)
#define PG8_SB(b, h) ((4 + (b) * 2 + (h)) * HTB)
#define PG8_STAGE(bufoff, gbase, voff) do { _Pragma("unroll") for (int _i = 0; _i < 2; ++_i) \
        __builtin_amdgcn_global_load_lds((const unsigned*)((const char*)(gbase) + (voff)[_i]), (MK_LAS unsigned*)(lds + (bufoff) + ldsw + _i * 8192), 16, 0, 0); } while (0)
#define PG8_LDA(dst, b, h) do { _Pragma("unroll") for (int m = 0; m < 4; ++m) _Pragma("unroll") for (int k = 0; k < 2; ++k) dst[m][k] = *(const MK_LAS bf16x8*)(lds + PG8_SA(b, h) + aoff + m * 2048 + k * 1024); } while (0)
#define PG8_LDB(dst, b, h) do { _Pragma("unroll") for (int n = 0; n < 2; ++n) _Pragma("unroll") for (int k = 0; k < 2; ++k) dst[n][k] = *(const MK_LAS bf16x8*)(lds + PG8_SB(b, h) + boff + n * 2048 + k * 1024); } while (0)
#define PG8_MMA(ai, bj, At, Bt) do { __builtin_amdgcn_s_setprio(1); _Pragma("unroll") for (int m = 0; m < 4; ++m) _Pragma("unroll") for (int n = 0; n < 2; ++n) _Pragma("unroll") for (int k = 0; k < 2; ++k) \
        acc[ai][bj][m][n] = __builtin_amdgcn_mfma_f32_16x16x32_bf16(Bt[n][k], At[m][k], acc[ai][bj][m][n], 0, 0, 0); __builtin_amdgcn_s_setprio(0); } while (0)
#define PG8_WAIT_V(n) asm volatile("s_waitcnt vmcnt(" #n ")" ::: "memory")
#define PG8_WAIT_L(n) asm volatile("s_waitcnt lgkmcnt(" #n ")" ::: "memory")
#define PG8_BAR __builtin_amdgcn_s_barrier()
#define PG8_SCHED __builtin_amdgcn_sched_barrier(0)
    Unit cur, nxt; int ui = 0;
    if (!S.next(0, cur)) return;
    unsigned cv0[2], cv1[2], nv0[2], nv1[2];
    S.a_voff(0, cur, Rr, Cc, cv0, cv1);
    f32x4 acc[2][2][4][2];
#pragma unroll
    for (int a = 0; a < 2; ++a)
#pragma unroll
        for (int b = 0; b < 2; ++b)
#pragma unroll
            for (int m = 0; m < 4; ++m)
#pragma unroll
                for (int n = 0; n < 2; ++n) acc[a][b][m][n] = (f32x4){0.f, 0.f, 0.f, 0.f};
    bf16x8 At[4][2], B0[2][2], B1[2][2];
    const char* cA = S.a_base(cur); const char* cB = S.b_base(cur);
    PG8_STAGE(PG8_SB(0, 0), cB, voffB); PG8_STAGE(PG8_SB(0, 1), cB + hstep, voffB); PG8_STAGE(PG8_SA(0, 0), cA, cv0); PG8_STAGE(PG8_SA(0, 1), cA, cv1);
    if (wr == 1) PG8_BAR;
    PG8_WAIT_V(2); PG8_BAR;
    PG8_STAGE(PG8_SB(1, 0), cB + kstep, voffB); PG8_STAGE(PG8_SA(1, 0), cA + kstep, cv0); PG8_STAGE(PG8_SB(1, 1), cB + hstep + kstep, voffB);
    PG8_WAIT_V(6); PG8_BAR;
    for (;;) {
        const bool has_next = S.next(ui + 1, nxt);
        const char* nA = cA; const char* nB = cB;
#pragma unroll
        for (int j = 0; j < 2; ++j) { nv0[j] = cv0[j]; nv1[j] = cv1[j]; }
        if (has_next) { nA = S.a_base(nxt); nB = S.b_base(nxt); S.a_voff(ui + 1, nxt, Rr, Cc, nv0, nv1); }
        for (int t = 0; t < nt; t += 2) {
            const bool last = (t == nt - 2);
            const char* a1 = cA + (size_t)(t + 1) * kstep;
            const char* a2 = last ? nA : cA + (size_t)(t + 2) * kstep; const char* b2 = last ? nB : cB + (size_t)(t + 2) * kstep;
            const char* a3 = a2 + kstep; const char* b3 = b2 + kstep;
            unsigned x0[2], x1[2];
#pragma unroll
            for (int j = 0; j < 2; ++j) { x0[j] = last ? nv0[j] : cv0[j]; x1[j] = last ? nv1[j] : cv1[j]; }
            PG8_LDB(B0, 0, 0); PG8_LDB(B1, 0, 1); PG8_SCHED; PG8_LDA(At, 0, 0); PG8_STAGE(PG8_SA(1, 1), a1, cv1);
            PG8_WAIT_V(8); PG8_WAIT_L(0); PG8_BAR; PG8_MMA(0, 0, At, B0); PG8_MMA(0, 1, At, B1); PG8_BAR; PG8_SCHED;
            PG8_LDA(At, 0, 1); PG8_STAGE(PG8_SB(0, 0), b2, voffB); PG8_STAGE(PG8_SB(0, 1), b2 + hstep, voffB); PG8_STAGE(PG8_SA(0, 0), a2, x0);
            PG8_WAIT_V(8); PG8_WAIT_L(0); PG8_BAR; PG8_MMA(1, 0, At, B0); PG8_MMA(1, 1, At, B1); PG8_BAR; PG8_SCHED;
            PG8_LDB(B0, 1, 0); PG8_LDB(B1, 1, 1); PG8_SCHED; PG8_LDA(At, 1, 0); PG8_STAGE(PG8_SA(0, 1), a2, x1);
            PG8_WAIT_V(8); PG8_WAIT_L(0); PG8_BAR; PG8_MMA(0, 0, At, B0); PG8_MMA(0, 1, At, B1); PG8_BAR; PG8_SCHED;
            PG8_LDA(At, 1, 1); PG8_STAGE(PG8_SB(1, 0), b3, voffB); PG8_STAGE(PG8_SB(1, 1), b3 + hstep, voffB); PG8_STAGE(PG8_SA(1, 0), a3, x0);
            PG8_WAIT_V(8); PG8_WAIT_L(0); PG8_BAR; PG8_MMA(1, 0, At, B0); PG8_MMA(1, 1, At, B1); PG8_BAR; PG8_SCHED;
        }
        if (wr == 0) PG8_BAR;
        E(acc, cur, wr, wc, fr, fq);
        if (!has_next) break;
#pragma unroll
        for (int a = 0; a < 2; ++a)
#pragma unroll
            for (int b = 0; b < 2; ++b)
#pragma unroll
                for (int m = 0; m < 4; ++m)
#pragma unroll
                    for (int n = 0; n < 2; ++n) acc[a][b][m][n] = (f32x4){0.f, 0.f, 0.f, 0.f};
        cur = nxt; cA = nA; cB = nB; ++ui;
#pragma unroll
        for (int j = 0; j < 2; ++j) { cv0[j] = nv0[j]; cv1[j] = nv1[j]; }
        if (wr == 1) PG8_BAR;
    }
    PG8_WAIT_V(0);
    PG8_BAR;
#undef PG8_SA
#undef PG8_SB
#undef PG8_STAGE
#undef PG8_LDA
#undef PG8_LDB
#undef PG8_MMA
#undef PG8_WAIT_V
#undef PG8_WAIT_L
#undef PG8_BAR
#undef PG8_SCHED
}
__device__ __forceinline__ const char* uniform_ptr(const char* p) { const unsigned long long v = (unsigned long long)p; const unsigned lo = __builtin_amdgcn_readfirstlane((unsigned)v), hi = __builtin_amdgcn_readfirstlane((unsigned)(v >> 32)); return (const char*)(((unsigned long long)hi << 32) | lo); }
__host__ __device__ __forceinline__ int invperm32(int c) { return ((c >> 2) & 1) * 16 + (c >> 3) * 4 + (c & 3); }
struct BPatch {
    unsigned voff;
    unsigned ldsoff;
};
struct BSrcDown {
    const float* W; size_t estride; int ldb;
    __device__ __forceinline__ void patch(int tid, bool perm, BPatch& P) const {
        const int lane = tid & 63, w = tid >> 6, kr0 = 8 * w, n0 = 4 * lane;
        P.voff = (unsigned)(kr0 * ldb + n0) * 4u;
        { const int n = n0, h = n >> 7, R = n & 127, slot = perm ? ((R & ~31) + invperm32(R & 31)) : R; P.ldsoff = (unsigned)(h * HTB + lds_byte(slot, kr0)); }
    }
    __device__ __forceinline__ const char* base(const Unit& u, int  ) const { const int e = __builtin_amdgcn_readfirstlane(u.e), pn = __builtin_amdgcn_readfirstlane(u.pn); return (const char*)(W + (size_t)e * estride + (size_t)pn * BM); }
    __device__ __forceinline__ size_t rowbytes() const { return (size_t)ldb * 4; }
};

struct BSrcUp {
    const float* Wg; const float* Wu; size_t estride; int ldb;
    __device__ __forceinline__ void patch(int tid, bool perm, BPatch& P) const {
        const int lane = tid & 63, w = tid >> 6, s_ = w & 1, kr0 = 16 * (w >> 1) + 8 * (lane >> 5), c0 = 4 * (lane & 31);
        P.voff = (unsigned)(kr0 * ldb + c0) * 4u;
        { const int R = c0, slot = perm ? ((R & ~31) + invperm32(R & 31)) : R; P.ldsoff = (unsigned)(s_ * HTB + lds_byte(slot, kr0)); }
    }
    __device__ __forceinline__ const char* base(const Unit& u, int wave) const { const int e = __builtin_amdgcn_readfirstlane(u.e), pn = __builtin_amdgcn_readfirstlane(u.pn), sel = __builtin_amdgcn_readfirstlane(wave & 1);
        const unsigned long long m = 0ull - (unsigned long long)(unsigned)sel;
        const float* src = (const float*)(((unsigned long long)Wg & ~m) | ((unsigned long long)Wu & m)); return (const char*)(src + (size_t)e * estride + (size_t)pn * HALF); }
    __device__ __forceinline__ size_t rowbytes() const { return (size_t)ldb * 4; }
};

template <int VAR = 0, class Epi, class Sched, class BSrc>
__device__ __forceinline__ void gemm_phase_fb(MK_LAS unsigned char* lds, const int K, const Sched& S, const BSrc& Bs_, const Epi& E) {
    const int tid = ltid(), wid = __builtin_amdgcn_readfirstlane(tid >> 6), lane = tid & 63, wr = wid >> 2, wc = wid & 3, fr = lane & 15, fq = lane >> 4;
    const int nt = K / BK;
    BPatch P; Bs_.patch(tid, Epi::PERM, P);
    const size_t kstep = (size_t)(BK * 2);
    const size_t rowb = Bs_.rowbytes(), ktb = rowb * BK;
    const unsigned ldsw = (unsigned)wid * 1024u;
    const int aoff = lds_byte(wr * 64 + fr, fq * 8), boff = lds_byte(wc * 32 + fr, fq * 8);
#define PG8_SA(b, h) (((b) * 2 + (h)) * HTB)
#define PG8_SB(b, h) ((4 + (b) * 2 + (h)) * HTB)
#define PG8_STAGE(bufoff, gbase, voff) do { _Pragma("unroll") for (int _i = 0; _i < 2; ++_i) \
        __builtin_amdgcn_global_load_lds((const unsigned*)((const char*)(gbase) + (voff)[_i]), (MK_LAS unsigned*)(lds + (bufoff) + ldsw + _i * 8192), 16, 0, 0); } while (0)
#define PG8_LDA(dst, b, h) do { _Pragma("unroll") for (int m = 0; m < 4; ++m) _Pragma("unroll") for (int k = 0; k < 2; ++k) dst[m][k] = *(const MK_LAS bf16x8*)(lds + PG8_SA(b, h) + aoff + m * 2048 + k * 1024); } while (0)
#define PG8_LDB(dst, b, h) do { _Pragma("unroll") for (int n = 0; n < 2; ++n) _Pragma("unroll") for (int k = 0; k < 2; ++k) dst[n][k] = *(const MK_LAS bf16x8*)(lds + PG8_SB(b, h) + boff + n * 2048 + k * 1024); } while (0)
#define PG8_MMA(ai, bj, At, Bt) do { __builtin_amdgcn_s_setprio(1); _Pragma("unroll") for (int m = 0; m < 4; ++m) _Pragma("unroll") for (int n = 0; n < 2; ++n) _Pragma("unroll") for (int k = 0; k < 2; ++k) \
        acc[ai][bj][m][n] = __builtin_amdgcn_mfma_f32_16x16x32_bf16(Bt[n][k], At[m][k], acc[ai][bj][m][n], 0, 0, 0); __builtin_amdgcn_s_setprio(0); } while (0)
#define PG8_WAIT_V(n) asm volatile("s_waitcnt vmcnt(" #n ")" ::: "memory")
#define PG8_WAIT_L(n) asm volatile("s_waitcnt lgkmcnt(" #n ")" ::: "memory")
#define PG8_BAR __builtin_amdgcn_s_barrier()
#define PG8_SCHED __builtin_amdgcn_sched_barrier(0)
    f32x4 br[8];
#define BF_LOAD(ptr) do { const char* _p = uniform_ptr(ptr); \
        _Pragma("unroll") for (int _j = 0; _j < 8; ++_j) asm volatile("global_load_dwordx4 %0, %1, %2" : "=v"(br[_j]) : "v"(P.voff), "s"(_p + (size_t)_j * rowb) : "memory"); } while (0)
#define BF_CONSUME(NLEFT, b) do { asm volatile("s_waitcnt vmcnt(" #NLEFT ")" : "+v"(br[0]), "+v"(br[1]), "+v"(br[2]), "+v"(br[3]), "+v"(br[4]), "+v"(br[5]), "+v"(br[6]), "+v"(br[7]) :: "memory"); \
        _Pragma("unroll") for (int _i = 0; _i < 4; ++_i) { u32x4 _w; _w.x = cvt_pk_bf16(br[0][_i], br[1][_i]); _w.y = cvt_pk_bf16(br[2][_i], br[3][_i]); _w.z = cvt_pk_bf16(br[4][_i], br[5][_i]); _w.w = cvt_pk_bf16(br[6][_i], br[7][_i]); \
            *(MK_LAS u32x4*)(lds + PG8_SB(b, 0) + P.ldsoff + _i * 64) = _w; } } while (0)
#define BF_FILL(g, b, nptr) do { \
        if ((g) < 20) { if (VAR != 2 && VAR != 3) { const int _c = (g) / 5, _w = (g) % 5; \
            if (_w < 4) fw[_w] = cvt_pk_bf16_c(br[2 * _w][_c], br[2 * _w + 1][_c]); \
            else *(MK_LAS u32x4*)(lds + PG8_SB(b, 0) + P.ldsoff + _c * 64) = (u32x4){fw[0], fw[1], fw[2], fw[3]}; } } \
        else if ((g) < 28 && VAR != 3) { const int _j = (g) - 20; asm volatile("global_load_dwordx4 %0, %1, %2" : "=v"(br[_j]) : "v"(P.voff), "s"(nptr + (size_t)_j * rowb) : "memory"); } } while (0)
#define BF_MMA_FILL(b, nextp) do { const char* _np = uniform_ptr(nextp); unsigned fw[4]; BPatch P; Bs_.patch(ltid(), Epi::PERM, P); \
        asm volatile("s_waitcnt vmcnt(4)" : "+v"(br[0]), "+v"(br[1]), "+v"(br[2]), "+v"(br[3]), "+v"(br[4]), "+v"(br[5]), "+v"(br[6]), "+v"(br[7]) :: "memory"); \
        __builtin_amdgcn_s_setprio(1); \
        _Pragma("unroll") for (int _g = 0; _g < 32; ++_g) { const int _bj = _g >> 4, _m = (_g >> 2) & 3, _n = (_g >> 1) & 1, _k = _g & 1; \
            if (_bj == 0) acc[1][0][_m][_n] = __builtin_amdgcn_mfma_f32_16x16x32_bf16(B0[_n][_k], At[_m][_k], acc[1][0][_m][_n], 0, 0, 0); \
            else acc[1][1][_m][_n] = __builtin_amdgcn_mfma_f32_16x16x32_bf16(B1[_n][_k], At[_m][_k], acc[1][1][_m][_n], 0, 0, 0); \
            BF_FILL(_g, b, _np); \
            __builtin_amdgcn_sched_barrier(0); } \
        __builtin_amdgcn_s_setprio(0); } while (0)
    Unit cur, nxt; int ui = 0;
    if (!S.next(0, cur)) return;
#define AV(dst, unit, half) do { _Pragma("unroll") for (int _j = 0; _j < 2; ++_j) { int _R, _C; stage_rc(ltid() * 16 + _j * 8192, _R, _C); dst[_j] = S.a_off1((unit), (half), _R, _C); } } while (0)
    unsigned cv0[2], cv1[2], nv0[2], nv1[2];
    AV(cv0, 0, 0); AV(cv1, 0, 1);
    f32x4 acc[2][2][4][2];
#pragma unroll
    for (int a = 0; a < 2; ++a)
#pragma unroll
        for (int b = 0; b < 2; ++b)
#pragma unroll
            for (int m = 0; m < 4; ++m)
#pragma unroll
                for (int n = 0; n < 2; ++n) acc[a][b][m][n] = (f32x4){0.f, 0.f, 0.f, 0.f};
    bf16x8 At[4][2], B0[2][2], B1[2][2];
    const char* cA = S.a_base(cur); const char* cB = Bs_.base(cur, wid);
    BF_LOAD(cB); PG8_STAGE(PG8_SA(0, 0), cA, cv0); PG8_STAGE(PG8_SA(0, 1), cA, cv1);
    BF_CONSUME(4, 0);
    BF_LOAD(cB + ktb); PG8_STAGE(PG8_SA(1, 0), cA + kstep, cv0);
    BF_CONSUME(2, 1);
    BF_LOAD(cB + 2 * ktb);
    PG8_WAIT_V(8); PG8_WAIT_L(0);
    if (wr == 1) PG8_BAR;
    PG8_BAR; PG8_BAR;
    for (;;) {
        const bool has_next = S.next(ui + 1, nxt);
        const char* nA = cA; const char* nB = cB;
        if (has_next) { nA = S.a_base(nxt); nB = Bs_.base(nxt, wid); }
        const int un = has_next ? ui + 1 : ui;
        if constexpr (Sched::GATHER) { AV(nv0, un, 0); AV(nv1, un, 1); }
        for (int t = 0; t < nt; t += 2) {
            const bool last = (t == nt - 2);
            const char* a1 = cA + (size_t)(t + 1) * kstep;
            const char* a2 = last ? nA : cA + (size_t)(t + 2) * kstep;
            const char* a3 = a2 + kstep;
            const int km = (VAR == 1) ? 1 : -1;
            const char* b3 = (t + 3 < nt) ? cB + (size_t)((t + 3) & km) * ktb : nB + (size_t)(t + 3 - nt) * ktb;
            const char* b4 = (t + 4 < nt) ? cB + (size_t)((t + 4) & km) * ktb : nB + (size_t)(t + 4 - nt) * ktb;
#define AOFF_H0(_i) (Sched::GATHER ? (last ? nv0[_i] : cv0[_i]) : cv0[_i])
#define AOFF_H1(_i) (Sched::GATHER ? (last ? nv1[_i] : cv1[_i]) : cv0[_i] + (unsigned)(HALF * K * 2))
#define AOFF_C1(_i) (Sched::GATHER ? cv1[_i] : cv0[_i] + (unsigned)(HALF * K * 2))
#define PG8_STAGEF(bufoff, gbase, OFF) do { _Pragma("unroll") for (int _i = 0; _i < 2; ++_i) \
        __builtin_amdgcn_global_load_lds((const unsigned*)((const char*)(gbase) + OFF(_i)), (MK_LAS unsigned*)(lds + (bufoff) + ldsw + _i * 8192), 16, 0, 0); } while (0)
            PG8_LDB(B0, 0, 0); PG8_LDB(B1, 0, 1); PG8_SCHED; PG8_LDA(At, 0, 0); PG8_STAGEF(PG8_SA(1, 1), a1, AOFF_C1);
            PG8_WAIT_V(12); PG8_WAIT_L(0); PG8_BAR; PG8_MMA(0, 0, At, B0); PG8_MMA(0, 1, At, B1); PG8_BAR; PG8_SCHED;
            PG8_LDA(At, 0, 1); PG8_STAGEF(PG8_SA(0, 0), a2, AOFF_H0);
            PG8_WAIT_L(0); PG8_BAR; BF_MMA_FILL(0, b3); PG8_BAR; PG8_SCHED;
            PG8_LDB(B0, 1, 0); PG8_LDB(B1, 1, 1); PG8_SCHED; PG8_LDA(At, 1, 0); PG8_STAGEF(PG8_SA(0, 1), a2, AOFF_H1);
            PG8_WAIT_V(12); PG8_WAIT_L(0); PG8_BAR; PG8_MMA(0, 0, At, B0); PG8_MMA(0, 1, At, B1); PG8_BAR; PG8_SCHED;
            PG8_LDA(At, 1, 1); PG8_STAGEF(PG8_SA(1, 0), a3, AOFF_H0);
            PG8_WAIT_L(0); PG8_BAR; BF_MMA_FILL(1, b4); PG8_BAR; PG8_SCHED;
        }
        if (wr == 0) PG8_BAR;
        E(acc, cur, wr, wc, fr, fq);
        if (!has_next) break;
#pragma unroll
        for (int a = 0; a < 2; ++a)
#pragma unroll
            for (int b = 0; b < 2; ++b)
#pragma unroll
                for (int m = 0; m < 4; ++m)
#pragma unroll
                    for (int n = 0; n < 2; ++n) acc[a][b][m][n] = (f32x4){0.f, 0.f, 0.f, 0.f};
        cur = nxt; cA = nA; cB = nB; ++ui;
        if constexpr (Sched::GATHER) {
#pragma unroll
            for (int j = 0; j < 2; ++j) { cv0[j] = nv0[j]; cv1[j] = nv1[j]; } }
        if (wr == 1) PG8_BAR;
    }
    asm volatile("s_waitcnt vmcnt(0)" : "+v"(br[0]), "+v"(br[1]), "+v"(br[2]), "+v"(br[3]), "+v"(br[4]), "+v"(br[5]), "+v"(br[6]), "+v"(br[7]) :: "memory");
    PG8_BAR;
#undef BF_LOAD
#undef AOFF_H0
#undef AOFF_H1
#undef AOFF_C1
#undef PG8_STAGEF
#undef BF_FILL
#undef BF_MMA_FILL
#undef AV
#undef BF_CONSUME
#undef PG8_SA
#undef PG8_SB
#undef PG8_STAGE
#undef PG8_LDA
#undef PG8_LDB
#undef PG8_MMA
#undef PG8_WAIT_V
#undef PG8_WAIT_L
#undef PG8_BAR
#undef PG8_SCHED
}
struct In { const float *x, *c, *w_ada, *b_ada, *w_in, *lam, *subg, *relb, *w_o, *ln_g, *ln_b, *w_group, *b_group, *w_router, *b_router, *w_gate, *w_up, *w_down; };
struct Ws {
    unsigned* ctl;
    float* mod;
    bf16_t* wt_in;
    bf16_t* wt_o;
    bf16_t* wt_gu;
    bf16_t* wt_d;
    bf16_t* ab;
    bf16_t* proj;
    bf16_t* mixin;
    bf16_t* mixb;
    float* x1;
    float* xa;
    bf16_t* Hb;
    bf16_t* Yb;
    int* tok_of;
    int* tokinfo;
    float* tokw;
    bf16_t* wt_rh;
    bf16_t* wt_rl;
    bf16_t* ablo;
};
constexpr int CTL_CNT = 4096;
constexpr int CTL_WORDS = 8192;

constexpr int LDS_AUX = 131072;
constexpr int LDS_PEXP = LDS_AUX;
constexpr int LDS_PBASE = LDS_AUX + 768;
constexpr int LDS_CNT = LDS_AUX + 1024;
constexpr int LDS_XOFF = LDS_AUX + 1280;
constexpr int LDS_TOKL = LDS_AUX + 2048;
constexpr int LDS_BTAB = LDS_AUX + 2048 + 8192;
constexpr int LDS_MISC = LDS_BTAB + 1088;
constexpr int LDS_BYTES = 147456;
constexpr int LDS_FLAGS = LDS_MISC + 64;
static_assert(LDS_FLAGS + 64 <= LDS_BYTES, "LDS map");

struct Frame { MK_LAS unsigned char* lds; int tid, lane, wave, G, vcu; };

__device__ __forceinline__ void conv_item(const float* __restrict__ W, int K, int N, bf16_t* __restrict__ WT, int k0, int n0, int drow0, MK_LAS float* scr, int lane) {
    const int n4 = (lane & 15) * 4, kq = lane >> 4;
    f32x4 v[16];
#pragma unroll
    for (int i = 0; i < 16; ++i) v[i] = *(const f32x4*)(W + (size_t)(k0 + kq + 4 * i) * N + n0 + n4);
#pragma unroll
    for (int i = 0; i < 16; ++i) { MK_LAS float* p = scr + (kq + 4 * i) * 65 + n4; p[0] = v[i][0]; p[1] = v[i][1]; p[2] = v[i][2]; p[3] = v[i][3]; }
    asm volatile("s_waitcnt lgkmcnt(0)" ::: "memory");
    const int c = lane & 7;
#pragma unroll
    for (int j = 0; j < 8; ++j) { const int n = (lane >> 3) + 8 * j; const MK_LAS float* s = scr + (8 * c) * 65 + n;
        u32x4 o; o.x = cvt_pk_bf16(s[0 * 65], s[1 * 65]); o.y = cvt_pk_bf16(s[2 * 65], s[3 * 65]); o.z = cvt_pk_bf16(s[4 * 65], s[5 * 65]); o.w = cvt_pk_bf16(s[6 * 65], s[7 * 65]);
        st16(WT + (size_t)(drow0 + n) * K + k0 + 8 * c, o); }
    asm volatile("s_waitcnt lgkmcnt(0)" ::: "memory");
}
#if (defined(MK_F32B_DOWN) && defined(MK_F32B_UP)) || defined(MK_BGCONV)
constexpr int CI_E = 0;
#elif defined(MK_F32B_DOWN)
constexpr int CI_E = 1024;
#else
constexpr int CI_E = 1536;
#endif
constexpr int CI_IN = 3072, CI_O = 1024, CI_LAYER = CI_IN + CI_O + NE * CI_E;
__device__ __forceinline__ void conv_dispatch(const In& in, const Ws& w, int l, int r, MK_LAS float* scr, int lane) {
    if (r < CI_IN) { const int kb = r / 96, nb = r % 96; conv_item(in.w_in + (size_t)l * D * INC, D, INC, w.wt_in + (size_t)l * INC * D, kb * 64, nb * 64, nb * 64, scr, lane); return; }
    r -= CI_IN;
    if (r < CI_O) { const int kb = r / 32, nb = r % 32; conv_item(in.w_o + (size_t)l * D * D, D, D, w.wt_o + (size_t)l * D * D, kb * 64, nb * 64, nb * 64, scr, lane); return; }
    r -= CI_O;
    if (CI_E == 0) return;
    const int e = r / (CI_E ? CI_E : 1); r -= e * CI_E;
    const size_t le = (size_t)l * NE + e;
    if (r < 512) { const int kb = r / 16, nb = r % 16, n0 = nb * 64; conv_item(in.w_gate + le * D * DE, D, DE, w.wt_gu + le * 2048 * D, kb * 64, n0, ((n0 >> 7) << 8) + (n0 & 127), scr, lane); return; }
    r -= 512;
    if (r < 512) { const int kb = r / 16, nb = r % 16, n0 = nb * 64; conv_item(in.w_up + le * D * DE, D, DE, w.wt_gu + le * 2048 * D, kb * 64, n0, ((n0 >> 7) << 8) + 128 + (n0 & 127), scr, lane); return; }
    r -= 512;
#ifndef MK_F32B_DOWN
    { const int kb = r / 32, nb = r % 32; conv_item(in.w_down + le * DE * D, DE, D, w.wt_d + le * D * DE, kb * 64, nb * 64, nb * 64, scr, lane); }
#endif
}
__device__ __forceinline__ void phase_convert(const Frame& F, const In& in, const Ws& w, int it_lo, int it_hi) {
    MK_LAS float* scr = (MK_LAS float*)(F.lds + F.wave * 16640);
    const int gw = F.vcu * NWAVES + F.wave, NGW = F.G * NWAVES;
    for (int it = gw + it_lo; it < it_hi; it += NGW) conv_dispatch(in, w, it / CI_LAYER, it % CI_LAYER, scr, F.lane);
}

__device__ __forceinline__ void phase_mod(const Frame& F, const In& in, const Ws& w) {
    MK_LAS float* sc = (MK_LAS float*)(F.lds + 133120 - 133120);
    MK_LAS float* red = (MK_LAS float*)(F.lds + 32768);
    __syncthreads();
    for (int i = F.tid; i < NB * D; i += NTHR) { const float cv = in.c[i]; sc[i] = cv / (1.0f + __expf(-cv)); }
    __syncthreads();
    for (int item = F.vcu; item < 256; item += F.G) {
        const int l = item >> 7, n0 = (item & 127) * 96;
        const int cq = F.tid % 24, ks = F.tid / 24;
        if (ks < 16) {
            const float* wp = in.w_ada + (size_t)l * D * 6 * D + (size_t)(ks * 128) * 6 * D + n0 + cq * 4;
            f32x4 a0 = {0.f, 0.f, 0.f, 0.f}, a1 = a0, a2 = a0, a3 = a0;
#pragma unroll 8
            for (int k = 0; k < 128; ++k) { const f32x4 wv = *(const f32x4*)(wp + (size_t)k * 6 * D); const int kk = ks * 128 + k;
                a0 += wv * sc[kk]; a1 += wv * sc[D + kk]; a2 += wv * sc[2 * D + kk]; a3 += wv * sc[3 * D + kk]; }
            MK_LAS f32x4* rp = (MK_LAS f32x4*)red + (ks * 24 + cq) * 4;
            rp[0] = a0; rp[1] = a1; rp[2] = a2; rp[3] = a3;
        }
        __syncthreads();
        if (F.tid < 384) {
            const int q = F.tid / 16, bb = (F.tid >> 2) & 3, comp = F.tid & 3;
            float s = 0.f;
#pragma unroll
            for (int k2 = 0; k2 < 16; ++k2) s += red[((k2 * 24 + q) * 4 + bb) * 4 + comp];
            const int n = n0 + q * 4 + comp;
            w.mod[((size_t)l * NB + bb) * 6 * D + n] = s + in.b_ada[l * 6 * D + n];
        }
        __syncthreads();
    }
}

__device__ __forceinline__ void phase_modulate(const Frame& F, const float* __restrict__ x, const float* __restrict__ modl, bf16_t* __restrict__ ub) {
    const int gw = F.vcu * NWAVES + F.wave, NGW = F.G * NWAVES;
    for (int t = gw; t < M; t += NGW) {
        const float* mb = modl + (size_t)(t / S) * 6 * D;
        const float* xr = x + (size_t)t * D;
        bf16_t* ur = ub + (size_t)t * D;
#pragma unroll
        for (int j = 0; j < 8; ++j) { const int col = j * 256 + F.lane * 4;
            const f32x4 xv = *(const f32x4*)(xr + col), sh = *(const f32x4*)(mb + col), scv = *(const f32x4*)(mb + D + col);
            const f32x4 u = xv * (scv + 1.0f) + sh;
            u32x2 o; o.x = cvt_pk_bf16(u[0], u[1]); o.y = cvt_pk_bf16(u[2], u[3]);
            *(u32x2*)(ur + col) = o; }
    }
}

__device__ __forceinline__ int t5_bucket(int n) {
    if (n < 16) return n;
    const float v = logf((float)n / 16.0f) / 2.0794415416798357f * 16.0f;
    const int large = 16 + (int)v;
    return large < 31 ? large : 31;
}
__device__ __forceinline__ float permswap_other(float v) {
    auto rr = __builtin_amdgcn_permlane32_swap(__float_as_uint(v), __float_as_uint(v), false, false);
    return (__lane_id() & 32) ? __uint_as_float(rr[0]) : __uint_as_float(rr[1]);
}

#ifdef MK_BGCONV
constexpr int BG_ITEMS = (MK_BGCONV == 2 ? 2 : 3) * 65536;
#ifndef MK_BGMASK
#define MK_BGMASK 0
#endif
struct BgConv { const float* wg; const float* wu; const float* wd; bf16_t* tgu; bf16_t* td; int next, step, cur, mode; f32x2 p[8]; };
struct BgAddr { const float* src; bf16_t* dst; int N, K; };
__device__ __forceinline__ BgAddr bg_addr(const BgConv& g, int r, int lane) {
    r = __builtin_amdgcn_readfirstlane(r);
    const int mat = r >> 16, e = (r >> 11) & 31, kg = lane & 7, np = lane >> 3;
    BgAddr a;
    if (mat < 2) { const int kb = (r >> 6) & 31, n0 = (r & 63) * 16;
        const unsigned long long m = 0ull - (unsigned long long)(unsigned)mat;
        const float* W = (const float*)(((unsigned long long)g.wg & ~m) | ((unsigned long long)g.wu & m));
        a.N = DE; a.K = D;
        a.src = W + (size_t)e * D * DE + (size_t)(kb * 64 + 8 * kg) * DE + n0 + 2 * np;
        a.dst = g.tgu + (size_t)e * 2048 * D + (size_t)(((n0 >> 7) << 8) + (n0 & 127) + mat * 128 + 2 * np) * D + kb * 64 + 8 * kg;
    } else { const int kb = (r >> 7) & 15, n0 = (r & 127) * 16;
        a.N = D; a.K = DE;
        a.src = g.wd + (size_t)e * DE * D + (size_t)(kb * 64 + 8 * kg) * D + n0 + 2 * np;
        a.dst = g.td + (size_t)e * D * DE + (size_t)(n0 + 2 * np) * DE + kb * 64 + 8 * kg;
    }
    return a;
}
__device__ __forceinline__ void bg_load(BgConv& g, int lane) {
    const bool live = g.next < BG_ITEMS; const int r = live ? g.next : BG_ITEMS - 1;
    const BgAddr a = bg_addr(g, r, lane);
    if (g.mode != 2) {
#pragma unroll
    for (int j = 0; j < 8; ++j) g.p[j] = *(const __attribute__((address_space(1))) f32x2*)(unsigned long long)(a.src + (size_t)j * a.N); }
    g.cur = live ? g.next : -1; if (live) g.next += g.step;
}
__device__ __forceinline__ void bg_store(BgConv& g, int lane) {
    if (g.cur >= 0 && g.mode == 1) {
#pragma unroll
        for (int j = 0; j < 8; ++j) asm volatile("" :: "v"(g.p[j]));
        g.cur = -1; }
    if (g.cur >= 0) { const BgAddr a = bg_addr(g, g.cur, lane);
        u32x4 o0, o1;
        o0.x = cvt_pk_bf16(g.p[0][0], g.p[1][0]); o0.y = cvt_pk_bf16(g.p[2][0], g.p[3][0]); o0.z = cvt_pk_bf16(g.p[4][0], g.p[5][0]); o0.w = cvt_pk_bf16(g.p[6][0], g.p[7][0]);
        o1.x = cvt_pk_bf16(g.p[0][1], g.p[1][1]); o1.y = cvt_pk_bf16(g.p[2][1], g.p[3][1]); o1.z = cvt_pk_bf16(g.p[4][1], g.p[5][1]); o1.w = cvt_pk_bf16(g.p[6][1], g.p[7][1]);
        st16(a.dst, o0); st16(a.dst + a.K, o1); g.cur = -1; }
}
#define BG_PARAM , BgConv& bgc
#define BG_ARG , bgc
#else
#define BG_PARAM
#define BG_ARG
#endif

template <int MODE>
__device__ __forceinline__ void attn_pass(MK_LAS unsigned char* lds, const bf16_t* __restrict__ base  , int qcol, int kcol, int vcol, int qb,
                                          const MK_LAS float* btab, f32x16 (&O)[4], float& lsum BG_PARAM) {
    constexpr int DQK = MODE ? 128 : 64, ND0 = DQK / 16, KSTR = DQK * 2 + 16, VSTR = 320, KBYTES = 64 * KSTR, VBYTES = 64 * VSTR, BUF = KBYTES + VBYTES;
    constexpr int NKP = MODE ? 2 : 1;
    const int tid = ltid(), lane = tid & 63, wid = __builtin_amdgcn_readfirstlane(tid >> 6), r32 = lane & 31, hi = lane >> 5;
    const int q0 = qb * 256, qw0 = q0 + wid * 32, q = qw0 + r32;
    const int nt = 4 * qb + 4;
    bf16x8 qf[ND0];
#pragma unroll
    for (int d0 = 0; d0 < ND0; ++d0) qf[d0] = *(const bf16x8*)(base + (size_t)q * INC + qcol + d0 * 16 + hi * 8);
#pragma unroll
    for (int db = 0; db < 4; ++db)
#pragma unroll
        for (int r = 0; r < 16; ++r) O[db][r] = 0.f;
    float mref = 0.f; lsum = 0.f;
    float carry = 0.f;
    MK_LAS unsigned* flags = (MK_LAS unsigned*)(lds + LDS_FLAGS);
    const int krow = MODE ? (tid >> 4) : (tid >> 3), kch = MODE ? (tid & 15) : (tid & 7);
    const int vrow = tid >> 4, vch = tid & 15;
    const bf16_t* kg = base + (size_t)krow * INC + kcol + kch * 8;
    const bf16_t* vg = base + (size_t)vrow * INC + vcol + vch * 8;
    const unsigned kl = krow * KSTR + kch * 16, vl = KBYTES + vrow * VSTR + vch * 16;
    u32x4 kreg[NKP], vreg[2];
#define AT_GLOAD(j) do { const size_t _ro = (size_t)(j) * 64 * INC; \
        _Pragma("unroll") for (int _i = 0; _i < NKP; ++_i) kreg[_i] = *(const u32x4*)(kg + _ro + (size_t)_i * 32 * INC); \
        _Pragma("unroll") for (int _i = 0; _i < 2; ++_i) vreg[_i] = *(const u32x4*)(vg + _ro + (size_t)_i * 32 * INC); } while (0)
#define AT_LWRITE(bufo) do { \
        _Pragma("unroll") for (int _i = 0; _i < NKP; ++_i) *(MK_LAS u32x4*)(lds + (bufo) + kl + _i * 32 * KSTR) = kreg[_i]; \
        _Pragma("unroll") for (int _i = 0; _i < 2; ++_i) *(MK_LAS u32x4*)(lds + (bufo) + vl + _i * 32 * VSTR) = vreg[_i]; } while (0)
    const unsigned ka = r32 * KSTR + hi * 16;
    const unsigned va = KBYTES + (4 * hi + ((lane & 15) >> 2)) * VSTR + (((lane >> 4) & 1) * 16 + (lane & 3) * 4) * 2;
    { const int j0 = MODE ? nt - 1 : 0; AT_GLOAD(j0); AT_LWRITE(0); }
    __syncthreads();
#ifdef MK_BGCONV
#pragma unroll
    for (int d0 = 0; d0 < ND0; ++d0) asm volatile("" : "+v"(qf[d0]));
#endif
#ifdef MK_BGCONV
#pragma unroll (MODE ? 1 : 2)
#endif
    for (int it = 0; it < nt; ++it) {
        const int j = MODE ? nt - 1 - it : it;
        const unsigned bo = (unsigned)(it & 1) * BUF;
#if defined(MK_BGCONV) && !defined(MK_BGLATE)
        if (MODE == 0 && !(it & MK_BGMASK)) bg_store(bgc, lane);
#endif
        if (it + 1 < nt) { const int jn = MODE ? j - 1 : j + 1; AT_GLOAD(jn); }
#ifdef MK_BGCONV
#ifdef MK_BGSPREAD
        const bool bgact = (MODE == 0) && !(it & MK_BGMASK);
        BgAddr bga; bga.src = nullptr; bga.N = 0;
#define BG_BEGIN() do { if (bgact) { const bool live = bgc.next < BG_ITEMS; const int r = live ? bgc.next : BG_ITEMS - 1; bga = bg_addr(bgc, r, lane); bgc.cur = live ? bgc.next : -1; if (live) bgc.next += bgc.step; } } while (0)
#ifndef MK_BGLATE
        BG_BEGIN();
#endif
#define BG_LD(jj) do { if (bgact) { asm volatile("" :: "v"(bgc.p[jj]));        \
            bgc.p[jj] = *(const __attribute__((address_space(1))) f32x2*)(unsigned long long)(bga.src + (size_t)(jj) * bga.N); } } while (0)
#ifdef MK_BGLATE
#define BG_FENCE() do { if (bgact) __builtin_amdgcn_sched_barrier(0); } while (0)
#else
#define BG_FENCE() __builtin_amdgcn_sched_barrier(0)
#endif
        BG_FENCE();
#else
        if (MODE == 0 && !(it & MK_BGMASK)) bg_load(bgc, lane);
#define BG_LD(jj) do { } while (0)
#define BG_FENCE() do { } while (0)
#endif
#else
#define BG_LD(jj) do { } while (0)
#define BG_FENCE() do { } while (0)
#endif
        const bool skip = MODE ? (64 * j >= qw0 + 32) : (64 * j > qw0 + 31);
        f32x16 sT[2]; bf16x8 pf[2][2];
        if (!skip) {
            const float cinit = MODE ? 0.f : -mref;
#pragma unroll
            for (int kb = 0; kb < 2; ++kb) {
                bf16x8 kf[ND0];
#pragma unroll
                for (int d0 = 0; d0 < ND0; ++d0) kf[d0] = *(const MK_LAS bf16x8*)(lds + bo + ka + kb * 32 * KSTR + d0 * 32);
#pragma unroll
                for (int r = 0; r < 16; ++r) sT[kb][r] = cinit;
                __builtin_amdgcn_sched_barrier(0);
#pragma unroll
                for (int d0 = 0; d0 < ND0; ++d0) sT[kb] = __builtin_amdgcn_mfma_f32_32x32x16_bf16(kf[d0], qf[d0], sT[kb], 0, 0, 0);
            }
        }
#if defined(MK_BGSPREAD) && defined(MK_BGLATE)
        if (bgact) { bg_store(bgc, lane); } BG_BEGIN();
#endif
        BG_FENCE(); BG_LD(0); BG_LD(1); BG_LD(2); BG_FENCE();
        if (!skip) {
            const int kbase = 64 * j + 4 * hi;
            if (MODE == 0) {
                if (j >= 4 * qb - 2) {
#pragma unroll
                    for (int kb = 0; kb < 2; ++kb)
#pragma unroll
                        for (int r = 0; r < 16; ++r) { int rel = q - (kbase + 32 * kb + (r & 3) + 8 * (r >> 2)); rel = rel < 0 ? 0 : (rel > 128 ? 128 : rel); sT[kb][r] += btab[rel]; }
                }
                if (j >= 4 * qb) {
#pragma unroll
                    for (int kb = 0; kb < 2; ++kb)
#pragma unroll
                        for (int r = 0; r < 16; ++r) { const int key = kbase + 32 * kb + (r & 3) + 8 * (r >> 2); if (key > q) sT[kb][r] = -INFINITY; }
                }
                float ma = fmaxf(fmaxf(sT[0][0], sT[0][1]), sT[1][0]), mb = fmaxf(fmaxf(sT[0][2], sT[0][3]), sT[1][1]);
                ma = fmaxf(fmaxf(ma, sT[1][2]), sT[1][3]);
#pragma unroll
                for (int r = 4; r < 16; r += 4) { ma = fmaxf(fmaxf(ma, sT[0][r]), sT[0][r + 1]); mb = fmaxf(fmaxf(mb, sT[0][r + 2]), sT[0][r + 3]);
                    ma = fmaxf(fmaxf(ma, sT[1][r]), sT[1][r + 1]); mb = fmaxf(fmaxf(mb, sT[1][r + 2]), sT[1][r + 3]); }
                float grow = fmaxf(ma, mb);
                grow = fmaxf(grow, permswap_other(grow));
                if (it == 0 || !__all(grow <= 8.0f)) {
                    const float delta = (it == 0) ? grow : fmaxf(grow, 0.f);
                    const float alpha = __builtin_amdgcn_exp2f(-delta);
                    mref += delta; lsum *= alpha;
#pragma unroll
                    for (int kb = 0; kb < 2; ++kb)
#pragma unroll
                        for (int r = 0; r < 16; ++r) sT[kb][r] -= delta;
#pragma unroll
                    for (int db = 0; db < 4; ++db)
#pragma unroll
                        for (int r = 0; r < 16; ++r) O[db][r] *= alpha;
                }
                f32x2 ps2 = {0.f, 0.f};
#pragma unroll
                for (int kb = 0; kb < 2; ++kb)
#pragma unroll
                    for (int r = 0; r < 16; r += 2) { const float p0 = __builtin_amdgcn_exp2f(sT[kb][r]), p1 = __builtin_amdgcn_exp2f(sT[kb][r + 1]); sT[kb][r] = p0; sT[kb][r + 1] = p1; ps2 += (f32x2){p0, p1}; }
                lsum += ps2[0] + ps2[1];
            } else {
                const bool band = (j >= 4 * qb);
                float suf = carry;
#pragma unroll
                for (int kb = 1; kb >= 0; --kb) {
                    float Lr[16], gs[4], pg[4];
#pragma unroll
                    for (int g4 = 0; g4 < 4; ++g4) {
                        float sgrp = 0.f;
#pragma unroll
                        for (int i = 0; i < 4; ++i) { const int r = g4 * 4 + i; const float z = sT[kb][r];
                            float L = -(fmaxf(z, 0.f) + __builtin_amdgcn_logf(1.0f + __builtin_amdgcn_exp2f(-fabsf(z))));
                            if (band) { const int key = kbase + 32 * kb + i + 8 * g4; if (key >= q) L = 0.f; }
                            Lr[r] = L; sgrp += L; }
                        gs[g4] = sgrp;
                    }
#pragma unroll
                    for (int g4 = 0; g4 < 4; ++g4) pg[g4] = permswap_other(gs[g4]);
#pragma unroll
                    for (int g4 = 3; g4 >= 0; --g4) {
                        float cacc = suf + (hi == 0 ? pg[g4] : 0.f);
#pragma unroll
                        for (int i = 3; i >= 0; --i) { const int r = g4 * 4 + i; cacc += Lr[r]; const float z = sT[kb][r];
                            float a = __builtin_amdgcn_exp2f(z + cacc);
                            if (band) { const int key = kbase + 32 * kb + i + 8 * g4; if (key >= q) a = 0.f; }
                            sT[kb][r] = a; }
                        suf += gs[g4] + pg[g4];
                    }
                }
                carry = suf;
            }
#pragma unroll
            for (int kb = 0; kb < 2; ++kb)
#pragma unroll
                for (int s = 0; s < 2; ++s) { u32x4 w; w.x = cvt_pk_bf16(sT[kb][8 * s + 0], sT[kb][8 * s + 1]); w.y = cvt_pk_bf16(sT[kb][8 * s + 2], sT[kb][8 * s + 3]);
                    w.z = cvt_pk_bf16(sT[kb][8 * s + 4], sT[kb][8 * s + 5]); w.w = cvt_pk_bf16(sT[kb][8 * s + 6], sT[kb][8 * s + 7]); pf[kb][s] = __builtin_bit_cast(bf16x8, w); }
        }
        BG_FENCE(); BG_LD(3); BG_LD(4); BG_LD(5); BG_FENCE();
        if (!skip) {
            {
                bf16x8 af[3];
#define AT_VFRAG(m, dst) do { const MK_LAS unsigned char* _vp = lds + bo + va + (32 * (((m) >> 1) & 1) + 16 * ((m) & 1)) * VSTR + ((m) >> 2) * 64; \
                    const s16x4 _a0 = __builtin_bit_cast(s16x4, __builtin_amdgcn_ds_read_tr16_b64_v4i16((MK_LAS s16x4*)_vp)); \
                    const s16x4 _a1 = __builtin_bit_cast(s16x4, __builtin_amdgcn_ds_read_tr16_b64_v4i16((MK_LAS s16x4*)(_vp + 8 * VSTR))); \
                    dst[0] = _a0[0]; dst[1] = _a0[1]; dst[2] = _a0[2]; dst[3] = _a0[3]; dst[4] = _a1[0]; dst[5] = _a1[1]; dst[6] = _a1[2]; dst[7] = _a1[3]; } while (0)
                AT_VFRAG(0, af[0]); AT_VFRAG(1, af[1]);
                __builtin_amdgcn_sched_barrier(0);
#pragma unroll
                for (int m = 0; m < 16; ++m) {
                    if (m + 2 < 16) AT_VFRAG(m + 2, af[(m + 2) % 3]);
                    __builtin_amdgcn_sched_barrier(0);
                    O[m >> 2] = __builtin_amdgcn_mfma_f32_32x32x16_bf16(af[m % 3], pf[(m >> 1) & 1][m & 1], O[m >> 2], 0, 0, 0);
                    __builtin_amdgcn_sched_barrier(0);
                }
#undef AT_VFRAG
            }
        }
        BG_FENCE(); BG_LD(6); BG_LD(7); BG_FENCE();
#undef BG_LD
#undef BG_FENCE
#ifdef BG_BEGIN
#undef BG_BEGIN
#endif
        if (it + 1 < nt) AT_LWRITE((unsigned)((it + 1) & 1) * BUF);
        if (MODE == 1) { const bool dead = __all(carry < -160.0f); if (lane == 0) flags[(it & 1) * 8 + wid] = dead ? 1u : 0u; }
        __syncthreads();
        if (MODE == 1) {
            const u32x4 f0 = *(const MK_LAS u32x4*)(flags + (it & 1) * 8), f1 = *(const MK_LAS u32x4*)(flags + (it & 1) * 8 + 4);
            if ((f0.x & f0.y & f0.z & f0.w & f1.x & f1.y & f1.z & f1.w) != 0u) break;
        }
    }
#ifdef MK_BGCONV
    if (MODE == 0) bg_store(bgc, lane);
#endif
#undef AT_GLOAD
#undef AT_LWRITE
}

__device__ __forceinline__ void attn_unit_diff(const Frame& F, const bf16_t* __restrict__ proj, bf16_t* __restrict__ mixin, int b, int h, int qb,
                                               const float* __restrict__ relb, const float* __restrict__ lamp, float lam_init, const float* __restrict__ subg BG_PARAM) {
    MK_LAS float* btab = (MK_LAS float*)(F.lds + LDS_BTAB);
    MK_LAS float* misc = (MK_LAS float*)(F.lds + LDS_MISC);
    if (F.tid < 264) { const int m = F.tid / 132, i = F.tid % 132;
        float v = 0.f;
        if (i < 128) v = (relb[(t5_bucket(i) * NH + h) * 2 + m] - relb[(31 * NH + h) * 2 + m]) * LOG2E;
        btab[m * 132 + i] = v; }
    if (F.wave == 7) { float a = lamp[F.lane] * lamp[64 + F.lane], c2 = lamp[128 + F.lane] * lamp[192 + F.lane]; a = wave_sum(a); c2 = wave_sum(c2);
        if (F.lane == 0) misc[4] = expf(a) - expf(c2) + lam_init; }
    __syncthreads();
    const float lam = misc[4];
    const bf16_t* base = proj + (size_t)b * S * INC;
    const int hi = F.lane >> 5, r32 = F.lane & 31;
    f32x16 O[4]; float ls;
    MK_LAS u32x4* stash = (MK_LAS u32x4*)(F.lds + 59392) + F.tid;
    attn_pass<0>(F.lds, base, (2 * h) * 64, 1024 + (2 * h) * 64, 2048 + h * 128, qb, btab, O, ls BG_ARG);
    { const float inv = 1.0f / (ls + permswap_other(ls));
#pragma unroll
        for (int db = 0; db < 4; ++db)
#pragma unroll
            for (int r = 0; r < 16; r += 8) { u32x4 pk;
                pk.x = cvt_pk_bf16(O[db][r] * inv, O[db][r + 1] * inv); pk.y = cvt_pk_bf16(O[db][r + 2] * inv, O[db][r + 3] * inv);
                pk.z = cvt_pk_bf16(O[db][r + 4] * inv, O[db][r + 5] * inv); pk.w = cvt_pk_bf16(O[db][r + 6] * inv, O[db][r + 7] * inv);
                stash[(db * 2 + (r >> 3)) * NTHR] = pk; } }
    attn_pass<0>(F.lds, base, (2 * h + 1) * 64, 1024 + (2 * h + 1) * 64, 2048 + h * 128, qb, btab + 132, O, ls BG_ARG);
    const float inv1 = lam / (ls + permswap_other(ls));
    float ss = 0.f;
#pragma unroll
    for (int db = 0; db < 4; ++db)
#pragma unroll
        for (int r8 = 0; r8 < 16; r8 += 8) { const u32x4 pk = stash[(db * 2 + (r8 >> 3)) * NTHR];
#pragma unroll
            for (int i = 0; i < 4; ++i) { const unsigned w = pk[i]; const int r = r8 + 2 * i;
                const float oa = bf16_lo(w) - O[db][r] * inv1, ob = bf16_hi(w) - O[db][r + 1] * inv1;
                O[db][r] = oa; O[db][r + 1] = ob; ss += oa * oa + ob * ob; } }
    ss += permswap_other(ss);
    const float rn = rsqrtf(ss * (1.0f / 128.0f) + SUBLN_EPS) * (1.0f - lam_init);
    const int q = qb * 256 + F.wave * 32 + r32;
    bf16_t* orow = mixin + (size_t)(b * S + q) * D + h * 128;
#pragma unroll
    for (int db = 0; db < 4; ++db)
#pragma unroll
        for (int g4 = 0; g4 < 4; ++g4) { const int d0 = 32 * db + 8 * g4 + 4 * hi; const f32x4 gv = *(const f32x4*)(subg + d0);
            u32x2 o; o.x = cvt_pk_bf16(O[db][4 * g4] * rn * gv[0], O[db][4 * g4 + 1] * rn * gv[1]); o.y = cvt_pk_bf16(O[db][4 * g4 + 2] * rn * gv[2], O[db][4 * g4 + 3] * rn * gv[3]);
            *(u32x2*)(orow + d0) = o; }
}
__device__ __forceinline__ void attn_unit_sb(const Frame& F, const bf16_t* __restrict__ proj, bf16_t* __restrict__ mixin, int b, int h, int qb) {
    const bf16_t* base = proj + (size_t)b * S * INC;
    const int hi = F.lane >> 5, r32 = F.lane & 31;
    f32x16 O[4]; float ls;
#ifdef MK_BGCONV
    BgConv bgc; bgc.next = BG_ITEMS; bgc.cur = -1; bgc.step = 0; bgc.mode = 0;
#pragma unroll
    for (int j = 0; j < 8; ++j) bgc.p[j] = (f32x2){0.f, 0.f};
#endif
    attn_pass<1>(F.lds, base, 3072 + h * 128, 4096 + h * 128, 5120 + h * 128, qb, nullptr, O, ls BG_ARG);
    const int q = qb * 256 + F.wave * 32 + r32;
    bf16_t* orow = mixin + (size_t)(b * S + q) * D + 1024 + h * 128;
#pragma unroll
    for (int db = 0; db < 4; ++db)
#pragma unroll
        for (int g4 = 0; g4 < 4; ++g4) { const int d0 = 32 * db + 8 * g4 + 4 * hi;
            u32x2 o; o.x = cvt_pk_bf16(O[db][4 * g4], O[db][4 * g4 + 1]); o.y = cvt_pk_bf16(O[db][4 * g4 + 2], O[db][4 * g4 + 3]);
            *(u32x2*)(orow + d0) = o; }
}
__device__ __forceinline__ void phase_attention(const Frame& F, const In& in, const Ws& w, int l, int mask = 3) {
    const float lam_init = 0.8f - 0.6f * expf(-0.3f * (float)l);
#ifdef MK_BGCONV
    BgConv bgc; bgc.wg = in.w_gate + (size_t)l * NE * D * DE; bgc.wu = in.w_up + (size_t)l * NE * D * DE; bgc.wd = in.w_down + (size_t)l * NE * DE * D;
    bgc.tgu = w.wt_gu + (size_t)l * NE * 2048 * D; bgc.td = w.wt_d + (size_t)l * NE * D * DE;
    bgc.next = ((mask & 1) && !(mask & 4)) ? (int)blockIdx.x * NWAVES + F.wave : BG_ITEMS; bgc.step = F.G * NWAVES; bgc.cur = -1; bgc.mode = mask >> 4;
#pragma unroll
    for (int j = 0; j < 8; ++j) bgc.p[j] = (f32x2){0.f, 0.f};
#endif
    for (int it = F.vcu; it < 512; it += F.G) {
        const int sb = it >> 8, i = it & 255, bh = i >> 3, pr = i & 7, b = bh >> 3, h = bh & 7;
        if (!((mask >> sb) & 1)) continue;
        if (!sb) {
            attn_unit_diff(F, w.proj, w.mixin, b, h, 15 - pr, in.relb, in.lam + l * 256, lam_init, in.subg + l * 128 BG_ARG);
            attn_unit_diff(F, w.proj, w.mixin, b, h, pr, in.relb, in.lam + l * 256, lam_init, in.subg + l * 128 BG_ARG);
        } else {
            attn_unit_sb(F, w.proj, w.mixin, b, h, 15 - pr);
            attn_unit_sb(F, w.proj, w.mixin, b, h, pr);
        }
    }
#ifdef MK_BGCONV
    while (bgc.next < BG_ITEMS) { bg_load(bgc, F.lane); bg_store(bgc, F.lane); }
#endif
}

#define ROWF4(base, j) ((f32x4*)((char*)(base) + (((j) < 4) ? of0 : of1) + ((j) & 3) * 1024))
#define ROWH4(base, j) ((u32x2*)((char*)(base) + oh0 + (j) * 512))
__device__ __forceinline__ void phase_router_t(const Frame& F, const In& in, const Ws& w) {
    const int gt = F.vcu * NTHR + F.tid, NGT = F.G * NTHR;
    for (int i = gt; i < DEPTH * 48 * D; i += NGT) { const int l = i / (48 * D), r = i % (48 * D), n = r / D, k = r % D;
        const float v = n < 4 ? in.w_group[((size_t)l * D + k) * 4 + n] : (n < 36 ? in.w_router[((size_t)l * D + k) * 32 + (n - 4)] : 0.f);
        const unsigned hi = cvt_pk_bf16(v, 0.f) & 0xffffu; const float lo = v - __uint_as_float(hi << 16);
        w.wt_rh[i] = (bf16_t)hi; w.wt_rl[i] = (bf16_t)(cvt_pk_bf16(lo, 0.f) & 0xffffu); }
}
__device__ __forceinline__ void phase_ln1_route(const Frame& F, const In& in, const Ws& w, int l) {
    const float* modl = w.mod + (size_t)l * NB * 6 * D;
    const float* lng = in.ln_g + (size_t)(l * 2) * D; const float* lnb = in.ln_b + (size_t)(l * 2) * D;
    const float* xin = l == 0 ? in.x : w.xa;
    const bf16_t* wh = w.wt_rh + (size_t)l * 48 * D; const bf16_t* wlo = w.wt_rl + (size_t)l * 48 * D;
    const float* bg = in.b_group + l * 4; const float* br = in.b_router + l * 32;
#ifdef MK_XCNT
    int* cnt = (int*)(w.ctl + CTL_CNT) + l * 256;
#else
    int* cnt = (int*)(w.ctl + CTL_CNT) + l * 32;
#endif
    MK_LAS float* lg = (MK_LAS float*)F.lds;
    MK_LAS float* part = (MK_LAS float*)(F.lds + 16384);
    for (int pass = F.vcu; pass < M / 64; pass += F.G) {
        const int t0 = pass * 64;
#ifdef MK_LNPAR
        { const float* mbp = modl + (size_t)(t0 / S) * 6 * D; MK_LAS f32x4* pl = (MK_LAS f32x4*)(F.lds + 40960);
          __syncthreads();
          pl[F.tid] = *(const f32x4*)(mbp + 2 * D + F.tid * 4); pl[512 + F.tid] = *(const f32x4*)(lng + F.tid * 4); pl[1024 + F.tid] = *(const f32x4*)(lnb + F.tid * 4);
          pl[1536 + F.tid] = *(const f32x4*)(mbp + 3 * D + F.tid * 4); pl[2048 + F.tid] = *(const f32x4*)(mbp + 4 * D + F.tid * 4);
          __syncthreads(); }
#define PARL(k, j) (*(const MK_LAS f32x4*)(F.lds + 40960 + (k) * 8192 + F.lane * 16 + (j) * 1024))
#endif
        {
            const int tw = t0 + F.wave * 8;
            const float* mb = modl + (size_t)(tw / S) * 6 * D;
            const unsigned of0 = (unsigned)F.lane * 16u, of1 = of0 + 4096u, oh0 = (unsigned)F.lane * 8u;
            f32x4 xv[8]; u32x2 mv[8];
#ifdef MK_BF16RES
            u32x2 xh[8];
            const bf16_t* xinh = (const bf16_t*)w.xa;
#define LN1_LOADX(t_) do { if (l == 0) { const float* xr = xin + (size_t)(t_) * D; _Pragma("unroll") for (int j = 0; j < 8; ++j) xv[j] = *ROWF4(xr, j); } \
                           else { const bf16_t* xr = xinh + (size_t)(t_) * D; _Pragma("unroll") for (int j = 0; j < 8; ++j) xh[j] = *ROWH4(xr, j); } } while (0)
#define LN1_X(j) (l == 0 ? xv[j] : (f32x4){bf16_lo(xh[j].x), bf16_hi(xh[j].x), bf16_lo(xh[j].y), bf16_hi(xh[j].y)})
#else
#define LN1_LOADX(t_) do { const float* xr = xin + (size_t)(t_) * D; _Pragma("unroll") for (int j = 0; j < 8; ++j) xv[j] = *ROWF4(xr, j); } while (0)
#define LN1_X(j) xv[j]
#endif
            { const bf16_t* mr = w.mixb + (size_t)tw * D; LN1_LOADX(tw);
#pragma unroll
              for (int j = 0; j < 8; ++j) { mv[j] = *ROWH4(mr, j); } }
#pragma unroll 1
            for (int i = 0; i < 8; ++i) {
                const int t = tw + i;
                f32x4 v[8]; float s = 0.f;
#pragma unroll
#ifdef MK_LNPAR
                for (int j = 0; j < 8; ++j) { const f32x4 g1 = PARL(0, j) + 1.0f;
#else
                for (int j = 0; j < 8; ++j) { const f32x4 g1 = *ROWF4(mb + 2 * D, j) + 1.0f;
#endif
                    f32x4 mx; mx[0] = bf16_lo(mv[j].x); mx[1] = bf16_hi(mv[j].x); mx[2] = bf16_lo(mv[j].y); mx[3] = bf16_hi(mv[j].y);
                    v[j] = LN1_X(j) * ALPHA + g1 * mx; s += (v[j][0] + v[j][1]) + (v[j][2] + v[j][3]); }
                if (i < 7) {
                    const bf16_t* mr = w.mixb + (size_t)(t + 1) * D; LN1_LOADX(t + 1);
#pragma unroll
                    for (int j = 0; j < 8; ++j) { mv[j] = *ROWH4(mr, j); }
                }
                const float mu = wave_sum(s) * (1.0f / D);
                float s2 = 0.f;
#pragma unroll
                for (int j = 0; j < 8; ++j) { v[j] = v[j] - mu; s2 += (v[j][0] * v[j][0] + v[j][1] * v[j][1]) + (v[j][2] * v[j][2] + v[j][3] * v[j][3]); }
                const float rs = rsqrtf(wave_sum(s2) * (1.0f / D) + LN_EPS);
                float* x1r = w.x1 + (size_t)t * D; bf16_t* abr = w.ab + (size_t)t * D; bf16_t* alr = w.ablo + (size_t)t * D;
#pragma unroll
                for (int j = 0; j < 8; ++j) {
#ifdef MK_LNPAR
                    const f32x4 gg = PARL(1, j), bb = PARL(2, j);
#else
                    const f32x4 gg = *ROWF4(lng, j), bb = *ROWF4(lnb, j);
#endif
                    const f32x4 xo = v[j] * rs * gg + bb;
#ifdef MK_BF16RES
                    { u32x2 xp; xp.x = cvt_pk_bf16(xo[0], xo[1]); xp.y = cvt_pk_bf16(xo[2], xo[3]); *ROWH4((bf16_t*)w.x1 + (size_t)t * D, j) = xp; }
#else
                    *ROWF4(x1r, j) = xo;
#endif
#ifdef MK_LNPAR
                    const f32x4 sh = PARL(3, j), scv = PARL(4, j);
#else
                    const f32x4 sh = *ROWF4(mb + 3 * D, j), scv = *ROWF4(mb + 4 * D, j);
#endif
                    const f32x4 u = xo * (scv + 1.0f) + sh;
                    u32x2 o; o.x = cvt_pk_bf16(u[0], u[1]); o.y = cvt_pk_bf16(u[2], u[3]);
                    *ROWH4(abr, j) = o;
                    u32x2 ol; ol.x = cvt_pk_bf16(u[0] - bf16_lo(o.x), u[1] - bf16_hi(o.x)); ol.y = cvt_pk_bf16(u[2] - bf16_lo(o.y), u[3] - bf16_hi(o.y));
                    *ROWH4(alr, j) = ol; }
            }
        }
#undef LN1_LOADX
#undef LN1_X
        asm volatile("s_waitcnt vmcnt(0)" ::: "memory");
        __syncthreads();
        {
            const int rt = F.wave & 3, kh = F.wave >> 2, fr = F.lane & 15, fq = F.lane >> 4;
            const bf16_t* ah = w.ab + (size_t)(t0 + rt * 16 + fr) * D + kh * 1024 + fq * 8;
            const bf16_t* al = w.ablo + (size_t)(t0 + rt * 16 + fr) * D + kh * 1024 + fq * 8;
            const bf16_t* bh = wh + (size_t)fr * D + kh * 1024 + fq * 8;
            const bf16_t* bl = wlo + (size_t)fr * D + kh * 1024 + fq * 8;
            f32x4 acc[3];
#pragma unroll
            for (int nt = 0; nt < 3; ++nt) acc[nt] = (f32x4){0.f, 0.f, 0.f, 0.f};
#pragma unroll 4
            for (int sidx = 0; sidx < 32; ++sidx) {
                const bf16x8 fah = *(const bf16x8*)(ah + sidx * 32), fal = *(const bf16x8*)(al + sidx * 32);
#pragma unroll
                for (int nt = 0; nt < 3; ++nt) { const bf16x8 fbh = *(const bf16x8*)(bh + (size_t)nt * 16 * D + sidx * 32), fbl = *(const bf16x8*)(bl + (size_t)nt * 16 * D + sidx * 32);
                    acc[nt] = __builtin_amdgcn_mfma_f32_16x16x32_bf16(fah, fbh, acc[nt], 0, 0, 0);
                    acc[nt] = __builtin_amdgcn_mfma_f32_16x16x32_bf16(fah, fbl, acc[nt], 0, 0, 0);
                    acc[nt] = __builtin_amdgcn_mfma_f32_16x16x32_bf16(fal, fbh, acc[nt], 0, 0, 0); }
            }
            if (kh == 1) {
#pragma unroll
                for (int nt = 0; nt < 3; ++nt) *(MK_LAS f32x4*)(part + ((rt * 3 + nt) * 64 + F.lane) * 4) = acc[nt];
            }
            __syncthreads();
            if (kh == 0) {
#pragma unroll
                for (int nt = 0; nt < 3; ++nt) { const f32x4 o = acc[nt] + *(const MK_LAS f32x4*)(part + ((rt * 3 + nt) * 64 + F.lane) * 4);
#pragma unroll
                    for (int r = 0; r < 4; ++r) lg[(rt * 16 + fq * 4 + r) * 49 + nt * 16 + fr] = o[r]; }
            }
            __syncthreads();
        }
        if (F.tid < 64) {
            const int t = t0 + F.tid; const MK_LAS float* lr = lg + F.tid * 49;
            float gl[4]; int gi = 0;
#pragma unroll
            for (int i = 0; i < 4; ++i) gl[i] = lr[i] + bg[i];
            float gm = gl[0];
#pragma unroll
            for (int i = 1; i < 4; ++i) if (gl[i] > gm) { gm = gl[i]; gi = i; }
            float gsum = 0.f;
#pragma unroll
            for (int i = 0; i < 4; ++i) gsum += expf(gl[i] - gm);
            const float gp = 1.0f / gsum;
            float el[8];
#pragma unroll
            for (int j = 0; j < 8; ++j) el[j] = lr[4 + gi * 8 + j] + br[gi * 8 + j];
            int i0 = 0; float v0 = el[0];
#pragma unroll
            for (int j = 1; j < 8; ++j) if (el[j] > v0) { v0 = el[j]; i0 = j; }
            int i1 = 0; float v1 = -INFINITY;
#pragma unroll
            for (int j = 0; j < 8; ++j) if (j != i0 && el[j] > v1) { v1 = el[j]; i1 = j; }
            const float e1 = expf(v1 - v0);
            const float w0 = gp / (1.0f + e1), w1 = gp * e1 / (1.0f + e1);
            const int ea = gi * 8 + i0, eb = gi * 8 + i1;
#ifdef MK_RANKAGG
            MK_LAS int* hist = (MK_LAS int*)(F.lds + 32768);
            if (F.tid < 32) hist[F.tid] = 0;
            asm volatile("s_waitcnt lgkmcnt(0)" ::: "memory"); __builtin_amdgcn_wave_barrier();
            const int la = __atomic_fetch_add(hist + ea, 1, __ATOMIC_RELAXED), lb = __atomic_fetch_add(hist + eb, 1, __ATOMIC_RELAXED);
            asm volatile("s_waitcnt lgkmcnt(0)" ::: "memory"); __builtin_amdgcn_wave_barrier();
#ifdef MK_XCNT
            if (F.tid < 32) { const int c = hist[F.tid]; hist[32 + F.tid] = c ? atomicAdd(&cnt[(t0 >> 11) * 32 + F.tid], c) : 0; }
#else
            if (F.tid < 32) { const int c = hist[F.tid]; hist[32 + F.tid] = c ? atomicAdd(&cnt[F.tid], c) : 0; }
#endif
            asm volatile("s_waitcnt vmcnt(0) lgkmcnt(0)" ::: "memory"); __builtin_amdgcn_wave_barrier();
            const int ra = hist[32 + ea] + la, rb = hist[32 + eb] + lb;
#else
            const int ra = atomicAdd(&cnt[ea], 1), rb = atomicAdd(&cnt[eb], 1);
#endif
#ifdef MK_XCNT
            w.tok_of[(ea * 8 + (t >> 11)) * 2048 + ra] = t; w.tok_of[(eb * 8 + (t >> 11)) * 2048 + rb] = t;
#else
            w.tok_of[ea * M + ra] = t; w.tok_of[eb * M + rb] = t;
#endif
            *(int4*)(w.tokinfo + 4 * t) = make_int4(ea, ra, eb, rb);
            *(float2*)(w.tokw + 2 * t) = make_float2(w0, w1);
        }
        __syncthreads();
    }
}

__device__ __forceinline__ void moe_tables(const Frame& F, const Ws& w, int l) {
    MK_LAS int* pexp = (MK_LAS int*)(F.lds + LDS_PEXP);
    MK_LAS int* pbase = (MK_LAS int*)(F.lds + LDS_PBASE);
    MK_LAS int* cl = (MK_LAS int*)(F.lds + LDS_CNT);
#ifdef MK_XCNT
    const int* cnt = (const int*)(w.ctl + CTL_CNT) + l * 256;
    MK_LAS unsigned short* xoff = (MK_LAS unsigned short*)(F.lds + LDS_XOFF);
    __syncthreads();
    if (F.tid < 32) { int cx[8];
#pragma unroll
        for (int x = 0; x < 8; ++x) cx[x] = cnt[x * 32 + F.tid];
        int p = 0;
#pragma unroll
        for (int x = 0; x < 8; ++x) { xoff[F.tid * 8 + x] = (unsigned short)p; p += cx[x]; }
        cl[F.tid] = p; }
#else
    const int* cnt = (const int*)(w.ctl + CTL_CNT) + l * 32;
    __syncthreads();
    if (F.tid < 32) cl[F.tid] = cnt[F.tid];
#endif
    __syncthreads();
    if (F.tid == 0) { int p = 0; for (int e = 0; e < NE; ++e) { pbase[e] = p; const int np = (cl[e] + 255) >> 8; for (int i = 0; i < np; ++i) pexp[p + i] = e; p += np; } pbase[NE] = p; }
    __syncthreads();
}
template <class Sched>
__device__ __forceinline__ void moe_gather_table(const Frame& F, const Ws& w, const Sched& Sc) {
    MK_LAS int* tokl = (MK_LAS int*)(F.lds + LDS_TOKL);
    const MK_LAS int* pbase = (const MK_LAS int*)(F.lds + LDS_PBASE);
    const MK_LAS int* cl = (const MK_LAS int*)(F.lds + LDS_CNT);
    for (int i = 0; i < MAXU; ++i) { Unit u; if (!Sc.next(i, u)) break;
        if (F.tid < 256) { const int e = u.e; int rank = (u.pm - pbase[e]) * 256 + F.tid; const int ce = cl[e]; rank = rank < ce ? rank : ce - 1;
#ifdef MK_XCNT
            const MK_LAS unsigned short* xo = (const MK_LAS unsigned short*)(F.lds + LDS_XOFF) + e * 8;
            int x = 0;
#pragma unroll
            for (int k = 1; k < 8; ++k) x += (rank >= (int)xo[k]) ? 1 : 0;
            tokl[i * 256 + F.tid] = w.tok_of[(e * 8 + x) * 2048 + rank - (int)xo[x]]; } }
#else
            tokl[i * 256 + F.tid] = w.tok_of[e * M + rank]; } }
#endif
    __syncthreads();
}

__device__ __forceinline__ void phase_ln2(const Frame& F, const In& in, const Ws& w, int l, float* __restrict__ xout, const float* __restrict__ nmod) {
    const float* modl = w.mod + (size_t)l * NB * 6 * D;
    const float* lng = in.ln_g + (size_t)(l * 2 + 1) * D; const float* lnb = in.ln_b + (size_t)(l * 2 + 1) * D;
    const MK_LAS int* pbase = (const MK_LAS int*)(F.lds + LDS_PBASE);
    const int gw = F.vcu * NWAVES + F.wave, NGW = F.G * NWAVES;
    const unsigned of0 = (unsigned)F.lane * 16u, of1 = of0 + 4096u, oh0 = (unsigned)F.lane * 8u;
    for (int tb = gw * 8; tb < M; tb += NGW * 8) {
        const int bidx = tb / S;
        const float* mb = modl + (size_t)bidx * 6 * D;
#ifdef MK_LNPAR
        { MK_LAS f32x4* pl = (MK_LAS f32x4*)(F.lds + 40960);
          __syncthreads();
          pl[F.tid] = *(const f32x4*)(mb + 5 * D + F.tid * 4); pl[512 + F.tid] = *(const f32x4*)(lng + F.tid * 4); pl[1024 + F.tid] = *(const f32x4*)(lnb + F.tid * 4);
          if (nmod) { const float* nbp = nmod + (size_t)bidx * 6 * D; pl[1536 + F.tid] = *(const f32x4*)(nbp + F.tid * 4); pl[2048 + F.tid] = *(const f32x4*)(nbp + D + F.tid * 4); }
          __syncthreads(); }
#ifndef PARL
#define PARL(k, j) (*(const MK_LAS f32x4*)(F.lds + 40960 + (k) * 8192 + F.lane * 16 + (j) * 1024))
#endif
#endif
#ifdef MK_BF16RES
        u32x2 xv[8], ya[8], yb[8]; float2 tw, tw_n;
#define LN2_LOADX(_xr, j) xv[j] = *ROWH4((const bf16_t*)w.x1 + (size_t)(_xr) * D, j)
#define LN2_X(j) ((f32x4){bf16_lo(xv[j].x), bf16_hi(xv[j].x), bf16_lo(xv[j].y), bf16_hi(xv[j].y)})
#else
        f32x4 xv[8]; u32x2 ya[8], yb[8]; float2 tw, tw_n;
#define LN2_LOADX(_xr, j) xv[j] = *ROWF4(w.x1 + (size_t)(_xr) * D, j)
#define LN2_X(j) xv[j]
#endif
#ifdef MK_XCNT
#define LN2_XOFF(e_, t_) ((int)((const MK_LAS unsigned short*)(F.lds + LDS_XOFF))[(e_) * 8 + ((t_) >> 11)])
#else
#define LN2_XOFF(e_, t_) 0
#endif
#define LN2_FETCH(t) do { const int4 _ti = *(const int4*)(w.tokinfo + 4 * (t)); tw_n = *(const float2*)(w.tokw + 2 * (t)); \
            const int _r0 = __builtin_amdgcn_readfirstlane(pbase[_ti.x] * 256 + _ti.y + LN2_XOFF(_ti.x, t)), _r1 = __builtin_amdgcn_readfirstlane(pbase[_ti.z] * 256 + _ti.w + LN2_XOFF(_ti.z, t)); \
            const bf16_t* _y0 = w.Yb + (size_t)_r0 * D; const bf16_t* _y1 = w.Yb + (size_t)_r1 * D; \
            _Pragma("unroll") for (int j = 0; j < 8; ++j) { LN2_LOADX(t, j); ya[j] = *ROWH4(_y0, j); yb[j] = *ROWH4(_y1, j); } } while (0)
        LN2_FETCH(tb); tw = tw_n;
#pragma unroll 1
        for (int i = 0; i < 8; ++i) {
            const int t = tb + i;
            f32x4 v[8]; float s = 0.f;
#pragma unroll
            for (int j = 0; j < 8; ++j) {
                const u32x2 a = ya[j], c2 = yb[j];
                f32x4 y; y[0] = tw.x * bf16_lo(a.x) + tw.y * bf16_lo(c2.x); y[1] = tw.x * bf16_hi(a.x) + tw.y * bf16_hi(c2.x);
                y[2] = tw.x * bf16_lo(a.y) + tw.y * bf16_lo(c2.y); y[3] = tw.x * bf16_hi(a.y) + tw.y * bf16_hi(c2.y);
#ifdef MK_LNPAR
                const f32x4 g2 = PARL(0, j) + 1.0f;
#else
                const f32x4 g2 = *ROWF4(mb + 5 * D, j) + 1.0f;
#endif
                v[j] = LN2_X(j) * ALPHA + g2 * y;
                s += (v[j][0] + v[j][1]) + (v[j][2] + v[j][3]); }
            if (i < 7) { LN2_FETCH(t + 1); }
            const float mu = wave_sum(s) * (1.0f / D);
            float s2 = 0.f;
#pragma unroll
            for (int j = 0; j < 8; ++j) { v[j] = v[j] - mu; s2 += (v[j][0] * v[j][0] + v[j][1] * v[j][1]) + (v[j][2] * v[j][2] + v[j][3] * v[j][3]); }
            const float rs = rsqrtf(wave_sum(s2) * (1.0f / D) + LN_EPS);
            float* xor_ = xout + (size_t)t * D; bf16_t* abr = w.ab + (size_t)t * D;
#pragma unroll
            for (int j = 0; j < 8; ++j) {
#ifdef MK_LNPAR
                const f32x4 gg = PARL(1, j), bb = PARL(2, j);
#else
                const f32x4 gg = *ROWF4(lng, j), bb = *ROWF4(lnb, j);
#endif
                const f32x4 xo = v[j] * rs * gg + bb;
#ifdef MK_BF16RES
                if (nmod) { u32x2 xp; xp.x = cvt_pk_bf16(xo[0], xo[1]); xp.y = cvt_pk_bf16(xo[2], xo[3]); *ROWH4((bf16_t*)xout + (size_t)t * D, j) = xp; }
                else *ROWF4(xor_, j) = xo;
#else
                *ROWF4(xor_, j) = xo;
#endif
#ifdef MK_LNPAR
                if (nmod) { const f32x4 sh = PARL(3, j), scv = PARL(4, j);
#else
                if (nmod) { const float* nb = nmod + (size_t)bidx * 6 * D; const f32x4 sh = *ROWF4(nb, j), scv = *ROWF4(nb + D, j);
#endif
                    const f32x4 u = xo * (scv + 1.0f) + sh; u32x2 o; o.x = cvt_pk_bf16(u[0], u[1]); o.y = cvt_pk_bf16(u[2], u[3]); *ROWH4(abr, j) = o; }
            }
            tw = tw_n;
        }
#undef LN2_FETCH
#undef LN2_XOFF
#undef LN2_LOADX
#undef LN2_X
    }
}
struct Args { In in; Ws w; float* out; int l, cv_lo, cv_hi, pad; };

__device__ __forceinline__ Frame make_frame(unsigned char* lds_generic) {
    Frame F; F.lds = (MK_LAS unsigned char*)lds_generic;
    F.tid = ltid(); F.lane = F.tid & 63; F.wave = __builtin_amdgcn_readfirstlane(F.tid >> 6);
    F.G = gridDim.x; { const int bx = blockIdx.x; F.vcu = (F.G % 8 == 0) ? (bx % 8) * (F.G / 8) + bx / 8 : bx; }
    return F;
}

template <int PH>
__device__ __forceinline__ void run_phase(const Frame& F, const Args& a, int l) {
    const In& in = a.in; const Ws& w = a.w;
    if constexpr (PH == 0) { phase_convert(F, in, w, a.cv_lo, a.cv_hi); phase_mod(F, in, w); phase_router_t(F, in, w); }
    if constexpr (PH == 1) { phase_modulate(F, in.x, w.mod, w.ab); }
    if constexpr (PH == 2) { SchedDense Sd; Sd.init(w.ab, w.wt_in + (size_t)l * INC * D, M, INC, D, F.G, (int)blockIdx.x); EpiProj E{w.proj}; gemm_phase(F.lds, D, Sd, E); }
    if constexpr (PH == 3) { phase_attention(F, in, w, l); }
    if constexpr (PH == 31) { phase_attention(F, in, w, l, 1); }
    if constexpr (PH == 32) { phase_attention(F, in, w, l, 2); }
    if constexpr (PH == 34) { phase_attention(F, in, w, l, 3 | 16); }
    if constexpr (PH == 35) { phase_attention(F, in, w, l, 3 | 32); }
    if constexpr (PH == 33) { phase_attention(F, in, w, l, 7); }
    if constexpr (PH == 4) { SchedDense Sd; Sd.init(w.mixin, w.wt_o + (size_t)l * D * D, M, D, D, F.G, (int)blockIdx.x);
        EpiDown E{w.mixb}; gemm_phase(F.lds, D, Sd, E); }
    if constexpr (PH == 5) { phase_ln1_route(F, in, w, l); }
    if constexpr (PH == 6) { moe_tables(F, w, l);
        SchedMoe<true> Sm; Sm.A = w.ab; Sm.Bt = w.wt_gu + (size_t)l * NE * 2048 * D; Sm.estride = (size_t)2048 * D; Sm.K = D;
        Sm.nunits = ((const MK_LAS int*)(F.lds + LDS_PBASE))[NE] * 8; Sm.G = F.G; Sm.c = (int)blockIdx.x;
        Sm.pexp = (const MK_LAS int*)(F.lds + LDS_PEXP); Sm.tokl = (const MK_LAS int*)(F.lds + LDS_TOKL);
        moe_gather_table(F, w, Sm);
#ifdef MK_F32B_UP
        BSrcUp Bu{in.w_gate + (size_t)l * NE * D * DE, in.w_up + (size_t)l * NE * D * DE, (size_t)D * DE, DE};
        EpiGU E{w.Hb}; gemm_phase_fb(F.lds, D, Sm, Bu, E); }
#else
        EpiGU E{w.Hb}; gemm_phase(F.lds, D, Sm, E); }
#endif
    if constexpr (PH >= 60 && PH <= 69) { moe_tables(F, w, l);
        SchedMoe<true> Sm; Sm.A = w.ab; Sm.Bt = w.wt_gu + (size_t)l * NE * 2048 * D; Sm.estride = (size_t)2048 * D; Sm.K = D;
        Sm.nunits = ((const MK_LAS int*)(F.lds + LDS_PBASE))[NE] * 8; Sm.G = F.G; Sm.c = (int)blockIdx.x;
        Sm.pexp = (const MK_LAS int*)(F.lds + LDS_PEXP); Sm.tokl = (const MK_LAS int*)(F.lds + LDS_TOKL);
        moe_gather_table(F, w, Sm);
        BSrcUp Bu{in.w_gate + (size_t)l * NE * D * DE, in.w_up + (size_t)l * NE * D * DE, (size_t)D * DE, DE};
        EpiGU E{w.wt_gu}; gemm_phase_fb<PH - 60>(F.lds, D, Sm, Bu, E); }
    if constexpr (PH >= 70 && PH <= 79) { moe_tables(F, w, l);
        SchedMoe<false> Sm; Sm.A = w.Hb; Sm.Bt = w.wt_d + (size_t)l * NE * D * DE; Sm.estride = (size_t)D * DE; Sm.K = DE;
        Sm.nunits = ((const MK_LAS int*)(F.lds + LDS_PBASE))[NE] * 8; Sm.G = F.G; Sm.c = (int)blockIdx.x;
        Sm.pexp = (const MK_LAS int*)(F.lds + LDS_PEXP); Sm.tokl = nullptr;
        BSrcDown Bd{in.w_down + (size_t)l * NE * DE * D, (size_t)DE * D, D};
        EpiDown E{w.wt_gu}; gemm_phase_fb<PH - 70>(F.lds, DE, Sm, Bd, E); }
    if constexpr (PH == 7) { moe_tables(F, w, l);
        SchedMoe<false> Sm; Sm.A = w.Hb; Sm.Bt = w.wt_d + (size_t)l * NE * D * DE; Sm.estride = (size_t)D * DE; Sm.K = DE;
        Sm.nunits = ((const MK_LAS int*)(F.lds + LDS_PBASE))[NE] * 8; Sm.G = F.G; Sm.c = (int)blockIdx.x;
        Sm.pexp = (const MK_LAS int*)(F.lds + LDS_PEXP); Sm.tokl = nullptr;
#ifdef MK_F32B_DOWN
        BSrcDown Bd{in.w_down + (size_t)l * NE * DE * D, (size_t)DE * D, D};
        EpiDown E{w.Yb}; gemm_phase_fb(F.lds, DE, Sm, Bd, E); }
#else
        EpiDown E{w.Yb}; gemm_phase(F.lds, DE, Sm, E); }
#endif
    if constexpr (PH == 8) { moe_tables(F, w, l);
        phase_ln2(F, in, w, l, l == DEPTH - 1 ? a.out : w.xa, l == DEPTH - 1 ? nullptr : w.mod + (size_t)(l + 1) * NB * 6 * D); }
}

template <int PH>
__global__ void __launch_bounds__(NTHR, 2) k_phase(Args a) {
    extern __shared__ __attribute__((aligned(16))) unsigned char lds_raw[];
    const Frame F = make_frame(lds_raw);
    run_phase<PH>(F, a, a.l);
}

static inline Ws carve(char* base, size_t& end, int nlw = DEPTH) {
    Ws w; size_t o = 0;
    auto take = [&](size_t bytes) { char* p = base + o; o += (bytes + 255) & ~(size_t)255; return p; };
    w.ctl = (unsigned*)take((size_t)CTL_WORDS * 4);
    w.mod = (float*)take((size_t)DEPTH * NB * 6 * D * 4);
    w.wt_in = (bf16_t*)take((size_t)nlw * INC * D * 2);
    w.wt_o = (bf16_t*)take((size_t)nlw * D * D * 2);
    w.ab = (bf16_t*)take((size_t)M * D * 2);
    w.proj = (bf16_t*)take((size_t)M * INC * 2);
    w.mixin = (bf16_t*)take((size_t)M * D * 2);
    w.mixb = (bf16_t*)take((size_t)M * D * 2);
    w.ablo = (bf16_t*)take((size_t)M * D * 2);
    w.x1 = (float*)take((size_t)M * D * 4);
    w.xa = (float*)take((size_t)M * D * 4);
    w.Hb = (bf16_t*)take((size_t)PROWS * DE * 2);
    w.Yb = (bf16_t*)take((size_t)PROWS * D * 2);
    w.tok_of = (int*)take((size_t)NE * M * 4);
    w.tokinfo = (int*)take((size_t)M * 16);
    w.tokw = (float*)take((size_t)M * 8);
    w.wt_rh = (bf16_t*)take((size_t)DEPTH * 48 * D * 2);
    w.wt_rl = (bf16_t*)take((size_t)DEPTH * 48 * D * 2);
    w.wt_gu = (bf16_t*)take((size_t)nlw * NE * 2048 * D * 2);
    w.wt_d = (bf16_t*)take((size_t)nlw * NE * D * DE * 2);
    end = o; return w;
}
static inline In make_in(void* const* d_in) {
    In in; const float* const* p = (const float* const*)d_in;
    in.x = p[0]; in.c = p[1]; in.w_ada = p[2]; in.b_ada = p[3]; in.w_in = p[4]; in.lam = p[5]; in.subg = p[6]; in.relb = p[7]; in.w_o = p[8]; in.ln_g = p[9]; in.ln_b = p[10];
    in.w_group = p[11]; in.b_group = p[12]; in.w_router = p[13]; in.b_router = p[14]; in.w_gate = p[15]; in.w_up = p[16]; in.w_down = p[17];
    return in;
}
template <int PH>
static inline void launch_phase(const Args& a, int grid, hipStream_t st) {
    static bool attr = false;
    if (!attr) { attr = true; (void)hipFuncSetAttribute((const void*)k_phase<PH>, hipFuncAttributeMaxDynamicSharedMemorySize, LDS_BYTES); }
    hipLaunchKernelGGL(k_phase<PH>, dim3(grid), dim3(NTHR), LDS_BYTES, st, a);
}
}
namespace mk {
typedef const __attribute__((address_space(4))) Args* KArgsPtr;
__device__ __forceinline__ void load_args(Args& a) {
    KArgsPtr p = (KArgsPtr)__builtin_amdgcn_kernarg_segment_ptr();
    asm volatile("" : "+s"(p));
    __builtin_memcpy(&a, p, sizeof(Args));
}
#ifndef MK_REPEAT_PH
#define MK_REPEAT_PH -1
#endif
#define MK_PHASE1(PH, l) do { Args _a; load_args(_a); const Frame _F = make_frame(lds_raw); run_phase<PH>(_F, _a, (l)); } while (0)
#ifndef MK_REPEAT_AS
#define MK_REPEAT_AS MK_REPEAT_PH
#endif
#ifndef MK_REPEAT_N
#define MK_REPEAT_N 1
#endif
#define MK_PHASE(PH, l) do { MK_PHASE1(PH, l); if ((PH) == MK_REPEAT_PH && (l) == 0) { MK_BARRIER(); MK_PHASE1(MK_REPEAT_AS, l); if (MK_REPEAT_N > 1) { MK_BARRIER(); MK_PHASE1(MK_REPEAT_AS, l); } } } while (0)
#define MK_BARRIER() do { Args _a; load_args(_a); XcdBarrier _b; _b.bar = _a.w.ctl; _b.x = xb_xcc_id(); _b.st = (volatile LAS unsigned*)(F.lds + LDS_MISC); xcd_barrier(_b); } while (0)
__global__ void __launch_bounds__(NTHR, 2) k_mega(Args a) {
    extern __shared__ __attribute__((aligned(16))) unsigned char lds_raw[];
    const Frame F = make_frame(lds_raw);
    if (F.tid < 16) ((MK_LAS unsigned*)(F.lds + LDS_MISC))[F.tid] = 0u;
    __syncthreads();
    (void)xcd_barrier_post(a.w.ctl, (volatile LAS unsigned*)(F.lds + LDS_MISC));
    MK_PHASE(0, 0); MK_BARRIER();
    MK_PHASE(1, 0); MK_BARRIER();
#define MK_LAYER(l, last) do { \
        MK_PHASE(2, l); MK_BARRIER(); MK_PHASE(3, l); MK_BARRIER(); MK_PHASE(4, l); MK_BARRIER(); MK_PHASE(5, l); MK_BARRIER(); \
        MK_PHASE(6, l); MK_BARRIER(); MK_PHASE(7, l); MK_BARRIER(); MK_PHASE(8, l); if (!(last)) MK_BARRIER(); } while (0)
    MK_LAYER(0, false);
    MK_LAYER(1, true);
}
}

extern "C" void kernel_launch(void* const* d_in, const int* in_sizes, int n_in, void* d_out, int out_size, void* d_ws, size_t ws_size, hipStream_t stream) {
    static int grid = 0;
    if (grid == 0) {
        int dev = 0, cus = 0, per_cu = 0;
        (void)hipGetDevice(&dev); (void)hipDeviceGetAttribute(&cus, hipDeviceAttributeMultiprocessorCount, dev);
        if (hipFuncSetAttribute((const void*)mk::k_mega, hipFuncAttributeMaxDynamicSharedMemorySize, mk::LDS_BYTES) != hipSuccess) { fprintf(stderr, "kernel_launch: hipFuncSetAttribute failed\n"); grid = -1; return; }
        if (hipOccupancyMaxActiveBlocksPerMultiprocessor(&per_cu, (const void*)mk::k_mega, mk::NTHR, mk::LDS_BYTES) != hipSuccess || per_cu < 1)
            fprintf(stderr, "kernel_launch: occupancy query reports %d workgroups per CU\n", per_cu);
        (void)hipGetLastError();
        grid = cus > 0 ? cus : 256;
    }
    if (grid < 0) return;
    size_t end = 0;
    mk::Ws w = mk::carve((char*)d_ws, end, mk::DEPTH);
    if (end > ws_size) { fprintf(stderr, "kernel_launch: workspace too small: need %zu, have %zu\n", end, ws_size); return; }
    (void)hipMemsetAsync(w.ctl, 0, (size_t)mk::CTL_WORDS * 4, stream);
    mk::Args a; memset(&a, 0, sizeof(a));
    a.in = mk::make_in(d_in); a.w = w; a.out = (float*)d_out; a.l = 0; a.cv_lo = 0; a.cv_hi = mk::DEPTH * mk::CI_LAYER;
#ifdef MK_MULTI
    mk::launch_phase<0>(a, grid, stream); mk::launch_phase<1>(a, grid, stream);
    for (int l = 0; l < mk::DEPTH; ++l) { a.l = l;
        mk::launch_phase<2>(a, grid, stream); mk::launch_phase<3>(a, grid, stream); mk::launch_phase<4>(a, grid, stream); mk::launch_phase<5>(a, grid, stream);
        mk::launch_phase<6>(a, grid, stream); mk::launch_phase<7>(a, grid, stream); mk::launch_phase<8>(a, grid, stream); }
#else
    hipLaunchKernelGGL(mk::k_mega, dim3(grid), dim3(mk::NTHR), mk::LDS_BYTES, stream, a);
#endif
}
```

```cpp
#include <hip/hip_runtime.h>
#include <hip/hip_bf16.h>
#include <cstdio>
#include <cstdint>
#include <cmath>
#include <cstring>
#define MK_BGCONV 2
#define MK_BGMASK 1
#define MK_F32B_DOWN 1
#define MK_BF16RES 1
#define MK_BGSPREAD 1
#define MK_RANKAGG 1
#define MK_LNPAR 1
#define MK_ROUTK 1
#define XB_TMO      128
#define XB_XCNT(j)  (256  + 64 * (j))
#define XB_XSUB(j)  (1280 + 64 * (j))
#define XB_XGEN(j)  (2304 + 64 * (j))
#define XB_TOP      3328
#define XB_TOPGEN   3392
#define XCD_BAR_WORDS 3456
#define XB_SPIN_CAP (1u << 22)
#define LAS __attribute__((address_space(3)))

__device__ __forceinline__ unsigned xb_ld(unsigned* p)              { return __hip_atomic_load(p, __ATOMIC_RELAXED, __HIP_MEMORY_SCOPE_AGENT); }
__device__ __forceinline__ unsigned xb_add(unsigned* p, unsigned v) { return __hip_atomic_fetch_add(p, v, __ATOMIC_RELAXED, __HIP_MEMORY_SCOPE_AGENT); }
__device__ __forceinline__ unsigned xb_xcc_id() { return (unsigned)__builtin_amdgcn_s_getreg((3 << 11) | 20) & 0xFu; }
#define XB_SPIN(cond, bar) do { unsigned _sp = 0; while (cond) { __builtin_amdgcn_s_sleep(1); \
    if ((++_sp & 255u) == 0u) { if (xb_ld(&(bar)[XB_TMO])) break; if (_sp > XB_SPIN_CAP) { atomicAdd(&(bar)[XB_TMO], 1u); break; } } } } while (0)

struct XcdBarrier {
    unsigned* bar; unsigned x;
    volatile LAS unsigned* st;
};

__device__ __forceinline__ XcdBarrier xcd_barrier_post(unsigned* bar, volatile LAS unsigned* st) {
    XcdBarrier b; b.bar = bar; b.x = xb_xcc_id(); b.st = st;
    if (threadIdx.x == 0) (void)xb_add(&bar[XB_XCNT(b.x)], 1u);
    return b;
}
__device__ __forceinline__ void xcd_barrier_complete(unsigned* bar, unsigned x, unsigned& nloc, unsigned& nx) {
    const unsigned G = gridDim.x * gridDim.y * gridDim.z;
    unsigned sum, cnt, mine, sp = 0u;
    for (;;) {
        sum = 0u; cnt = 0u; mine = 0u;
#pragma unroll
        for (unsigned j = 0; j < 16; ++j) { const unsigned c = xb_ld(&bar[XB_XCNT(j)]); sum += c; cnt += (c > 0u) ? 1u : 0u; mine = (j == x) ? c : mine; }
        if (sum == G) break;
        __builtin_amdgcn_s_sleep(1);
        if ((++sp & 255u) == 0u) { if (xb_ld(&bar[XB_TMO])) break; if (sp > XB_SPIN_CAP) { atomicAdd(&bar[XB_TMO], 1u); break; } }
    }
    nloc = mine > 0u ? mine : 1u; nx = cnt > 0u ? cnt : 1u;
}

__device__ __forceinline__ void xcd_barrier(const XcdBarrier& b) {
    asm volatile("s_waitcnt vmcnt(0)" ::: "memory");
    __syncthreads();
    if (threadIdx.x == 0) {
        unsigned* bar = b.bar;
        __builtin_amdgcn_s_waitcnt(0);
        unsigned nloc = b.st[0], nx = b.st[1];
        if (nloc == 0u) { xcd_barrier_complete(bar, b.x, nloc, nx); b.st[0] = nloc; b.st[1] = nx; }
        const unsigned old = xb_add(&bar[XB_XSUB(b.x)], 1u);
        const unsigned gen = old / nloc;
        if (old + 1u == (gen + 1u) * nloc) {
            __builtin_amdgcn_fence(__ATOMIC_RELEASE, "agent");
            asm volatile("s_waitcnt vmcnt(0)" ::: "memory");
            const unsigned og = xb_add(&bar[XB_TOP], 1u);
            const unsigned tg = og / nx;
            if (og + 1u == (tg + 1u) * nx) xb_add(&bar[XB_TOPGEN], 1u);
            else XB_SPIN(xb_ld(&bar[XB_TOPGEN]) == tg, bar);
            __builtin_amdgcn_fence(__ATOMIC_ACQUIRE, "agent");
            xb_add(&bar[XB_XGEN(b.x)], 1u);
            asm volatile("s_waitcnt vmcnt(0)" ::: "memory");
        } else {
            XB_SPIN(xb_ld(&bar[XB_XGEN(b.x)]) == gen, bar);
            __builtin_amdgcn_fence(__ATOMIC_ACQUIRE, "agent");
            asm volatile("s_waitcnt vmcnt(0)" ::: "memory");
        }
    }
    __syncthreads();
}

namespace mk {
#define MK_LAS __attribute__((address_space(3)))
typedef unsigned short bf16_t;
typedef short bf16x8 __attribute__((ext_vector_type(8)));
typedef short s16x4 __attribute__((ext_vector_type(4)));
typedef float f32x2 __attribute__((ext_vector_type(2)));
typedef float f32x4 __attribute__((ext_vector_type(4)));
typedef float f32x16 __attribute__((ext_vector_type(16)));
typedef unsigned u32x2 __attribute__((ext_vector_type(2)));
typedef unsigned u32x4 __attribute__((ext_vector_type(4)));

constexpr int D = 2048, NB = 4, S = 4096, M = NB * S, INC = 6144, NE = 32, DE = 1024, NH = 8, DEPTH = 2;
constexpr int NWAVES = 8, NTHR = 512;
constexpr float LOG2E = 1.4426950408889634f;
constexpr float LN_EPS = 1e-5f, SUBLN_EPS = 1e-5f;
constexpr float ALPHA = 1.4142135623730951f;
constexpr int PMAXP = 161;
constexpr int PROWS = PMAXP * 256;
constexpr int MAXU = 8;

__device__ __forceinline__ void st16(void* p, u32x4 v) {
#ifdef MK_WT
    asm volatile("global_store_dwordx4 %0, %1, off sc1\n\ts_nop 1" :: "v"(p), "v"(v) : "memory");
#else
    *(u32x4*)p = v;
#endif
}
__device__ __forceinline__ unsigned cvt_pk_bf16(float lo, float hi) { unsigned r; asm volatile("v_cvt_pk_bf16_f32 %0, %1, %2" : "=v"(r) : "v"(lo), "v"(hi)); return r; }
typedef __bf16 bf16v2 __attribute__((ext_vector_type(2)));
__device__ __forceinline__ unsigned cvt_pk_bf16_c(float lo, float hi) { const f32x2 v = {lo, hi}; return __builtin_bit_cast(unsigned, __builtin_convertvector(v, bf16v2)); }
__device__ __forceinline__ float bf16_lo(unsigned w) { return __uint_as_float(w << 16); }
__device__ __forceinline__ float bf16_hi(unsigned w) { return __uint_as_float(w & 0xffff0000u); }
__device__ __forceinline__ float wave_sum(float v) {
#pragma unroll
    for (int o = 1; o < 64; o <<= 1) v += __shfl_xor(v, o);
    return v;
}
__device__ __forceinline__ int ltid() { int t = threadIdx.x; asm volatile("" : "+v"(t)); return t; }
__device__ __forceinline__ int crow(int r, int hi) { return (r & 3) + 8 * (r >> 2) + 4 * hi; }

constexpr int BM = 256, BK = 64, HALF = 128, HTB = HALF * BK * 2, STAGE_BYTES = 8 * HTB, NXCD = 8, WGM = 8;
__host__ __device__ __forceinline__ int lds_byte(int r, int c) { const int st = (r >> 4) * 2 + (c >> 5), rr = r & 15, cc = c & 31, ob = rr * 64 + cc * 2; return st * 1024 + (ob ^ (((ob >> 9) & 1) << 5)); }
__host__ __device__ __forceinline__ void stage_rc(int b, int& R, int& C) { const int st = b / 1024, sb = b % 1024, swz = sb ^ (((sb >> 9) & 1) << 5); R = (st >> 1) * 16 + swz / 64; C = (st & 1) * 32 + (swz % 64) / 2; }
__host__ __device__ __forceinline__ int perm32(int rho) { const int n = rho >> 4, i = rho & 15; return 8 * (i >> 2) + 4 * n + (i & 3); }

struct Unit { int pm, pn, e; };

struct SchedDense {
    static constexpr bool GATHER = false;
    const bf16_t* A; const bf16_t* Bt; int K;
    int nM, nN, nwg, G, c;
    __device__ void init(const bf16_t* A_, const bf16_t* Bt_, int Mr, int N, int K_, int G_, int c_) { A = A_; Bt = Bt_; K = K_; nM = Mr / BM; nN = N / BM; nwg = nM * nN; G = G_; c = c_; }
    __device__ __forceinline__ bool next(int i, Unit& u) const {
        const long L = (long)i * G + c; if (L >= nwg) return false;
        int wgid = (int)L; { const int q = nwg / NXCD, r = nwg % NXCD, xcd = wgid % NXCD, off = wgid / NXCD; wgid = (xcd < r ? xcd * (q + 1) : r * (q + 1) + (xcd - r) * q) + off; }
        const int nig = WGM * nN, gid = wgid / nig, fm = gid * WGM, gsz = (nM - fm) < WGM ? (nM - fm) : WGM;
        u.pm = fm + ((wgid % nig) % gsz); u.pn = (wgid % nig) / gsz; u.e = 0; return true;
    }
    __device__ __forceinline__ const char* a_base(const Unit& u) const { return (const char*)A + (size_t)u.pm * BM * K * 2; }
    __device__ __forceinline__ const char* b_base(const Unit& u) const { return (const char*)Bt + (size_t)u.pn * BM * K * 2; }
    __device__ __forceinline__ void a_voff(int, const Unit&, const int (&R)[2], const int (&C)[2], unsigned (&v0)[2], unsigned (&v1)[2]) const {
#pragma unroll
        for (int j = 0; j < 2; ++j) { v0[j] = (unsigned)(R[j] * K + C[j]) * 2u; v1[j] = v0[j] + (unsigned)(HALF * K * 2); }
    }
};
template <bool GATHER_>
struct SchedMoe {
    static constexpr bool GATHER = GATHER_;
    const bf16_t* A; const bf16_t* Bt; size_t estride; int K;
    int nunits, G, c;
    const MK_LAS int* pexp;
    const MK_LAS int* tokl;
    __device__ __forceinline__ bool next(int i, Unit& u) const {
        const int L = i * G + c; if (L >= nunits || i >= MAXU) return false;
        int wgid = L; { const int q = nunits / NXCD, r = nunits % NXCD, xcd = wgid % NXCD, off = wgid / NXCD; wgid = (xcd < r ? xcd * (q + 1) : r * (q + 1) + (xcd - r) * q) + off; }
        u.pm = wgid >> 3; u.pn = wgid & 7; u.e = pexp[u.pm]; return true;
    }
    __device__ __forceinline__ const char* a_base(const Unit& u) const { return GATHER ? (const char*)A : (const char*)A + (size_t)u.pm * BM * K * 2; }
    __device__ __forceinline__ const char* b_base(const Unit& u) const { return (const char*)Bt + ((size_t)u.e * estride + (size_t)u.pn * BM * K) * 2; }
    __device__ __forceinline__ unsigned a_off1(int i, int half, int R, int C) const {
        if (GATHER) return (unsigned)(tokl[i * 256 + half * HALF + R] * K + C) * 2u;
        return (unsigned)((R + half * HALF) * K + C) * 2u;
    }
    __device__ __forceinline__ void a_voff(int i, const Unit&, const int (&R)[2], const int (&C)[2], unsigned (&v0)[2], unsigned (&v1)[2]) const {
#pragma unroll
        for (int j = 0; j < 2; ++j) {
            if (GATHER) { const int t0 = tokl[i * 256 + R[j]], t1 = tokl[i * 256 + HALF + R[j]];
                v0[j] = (unsigned)(t0 * K + C[j]) * 2u; v1[j] = (unsigned)(t1 * K + C[j]) * 2u; }
            else { v0[j] = (unsigned)(R[j] * K + C[j]) * 2u; v1[j] = v0[j] + (unsigned)(HALF * K * 2); }
        }
    }
};

struct EpiProj {
    static constexpr bool PERM = true;
    bf16_t* O;
    __device__ __forceinline__ void operator()(const f32x4 (&acc)[2][2][4][2], const Unit& u, int wr, int wc, int fr, int fq) const {
        const int row0 = u.pm * BM + wr * 64 + fr, col0 = u.pn * BM + wc * 32 + 8 * fq;
        const float s = (u.pn < 4) ? 0.125f * LOG2E : ((u.pn >= 12 && u.pn < 16) ? 0.08838834764831845f * LOG2E : 1.0f);
#pragma unroll
        for (int ai = 0; ai < 2; ++ai)
#pragma unroll
            for (int m = 0; m < 4; ++m) { bf16_t* rowp = O + (size_t)(row0 + ai * HALF + m * 16) * INC + col0;
#pragma unroll
                for (int bj = 0; bj < 2; ++bj) { const f32x4 v0 = acc[ai][bj][m][0] * s, v1 = acc[ai][bj][m][1] * s;
                    u32x4 w; w.x = cvt_pk_bf16(v0[0], v0[1]); w.y = cvt_pk_bf16(v0[2], v0[3]); w.z = cvt_pk_bf16(v1[0], v1[1]); w.w = cvt_pk_bf16(v1[2], v1[3]);
                    st16(rowp + bj * HALF, w); } }
    }
};
struct EpiWo {
    static constexpr bool PERM = false;
    const float* x; const float* gate; float* H;
    __device__ __forceinline__ void operator()(const f32x4 (&acc)[2][2][4][2], const Unit& u, int wr, int wc, int fr, int fq) const {
        const int row0 = u.pm * BM + wr * 64 + fr, col0 = u.pn * BM + wc * 32 + 4 * fq;
        const float* gp = gate + (size_t)(u.pm >> 4) * 6 * D + col0;
        f32x4 gv[2][2];
#pragma unroll
        for (int bj = 0; bj < 2; ++bj)
#pragma unroll
            for (int n = 0; n < 2; ++n) gv[bj][n] = *(const f32x4*)(gp + bj * HALF + n * 16) + 1.0f;
#pragma unroll
        for (int ai = 0; ai < 2; ++ai)
#pragma unroll
            for (int m = 0; m < 4; ++m) { const size_t off = (size_t)(row0 + ai * HALF + m * 16) * D + col0;
#pragma unroll
                for (int bj = 0; bj < 2; ++bj)
#pragma unroll
                    for (int n = 0; n < 2; ++n) { const f32x4 xv = *(const f32x4*)(x + off + bj * HALF + n * 16);
                        *(f32x4*)(H + off + bj * HALF + n * 16) = xv * ALPHA + gv[bj][n] * acc[ai][bj][m][n]; } }
    }
};
struct EpiGU {
    static constexpr bool PERM = true;
    bf16_t* Hb;
    __device__ __forceinline__ void operator()(const f32x4 (&acc)[2][2][4][2], const Unit& u, int wr, int wc, int fr, int fq) const {
        const int row0 = u.pm * BM + wr * 64 + fr, col0 = u.pn * HALF + wc * 32 + 8 * fq;
#pragma unroll
        for (int ai = 0; ai < 2; ++ai)
#pragma unroll
            for (int m = 0; m < 4; ++m) { bf16_t* rowp = Hb + (size_t)(row0 + ai * HALF + m * 16) * DE + col0;
                float h[8];
#pragma unroll
                for (int n = 0; n < 2; ++n)
#pragma unroll
                    for (int j = 0; j < 4; ++j) { const float g = acc[ai][0][m][n][j], up = acc[ai][1][m][n][j];
                        h[n * 4 + j] = g * __builtin_amdgcn_rcpf(1.0f + __builtin_amdgcn_exp2f(-g * LOG2E)) * up; }
                u32x4 w; w.x = cvt_pk_bf16(h[0], h[1]); w.y = cvt_pk_bf16(h[2], h[3]); w.z = cvt_pk_bf16(h[4], h[5]); w.w = cvt_pk_bf16(h[6], h[7]);
                st16(rowp, w); }
    }
};
struct EpiDown {
    static constexpr bool PERM = true;
    bf16_t* Y;
    __device__ __forceinline__ void operator()(const f32x4 (&acc)[2][2][4][2], const Unit& u, int wr, int wc, int fr, int fq) const {
        const int row0 = u.pm * BM + wr * 64 + fr, col0 = u.pn * BM + wc * 32 + 8 * fq;
#pragma unroll
        for (int ai = 0; ai < 2; ++ai)
#pragma unroll
            for (int m = 0; m < 4; ++m) { bf16_t* rowp = Y + (size_t)(row0 + ai * HALF + m * 16) * D + col0;
#pragma unroll
                for (int bj = 0; bj < 2; ++bj) { const f32x4 v0 = acc[ai][bj][m][0], v1 = acc[ai][bj][m][1];
                    u32x4 w; w.x = cvt_pk_bf16(v0[0], v0[1]); w.y = cvt_pk_bf16(v0[2], v0[3]); w.z = cvt_pk_bf16(v1[0], v1[1]); w.w = cvt_pk_bf16(v1[2], v1[3]);
                    st16(rowp + bj * HALF, w); } }
    }
};

template <class Epi, class Sched>
__device__ __forceinline__ void gemm_phase(MK_LAS unsigned char* lds, const int K, const Sched& S, const Epi& E) {
    const int tid = ltid(), wid = __builtin_amdgcn_readfirstlane(tid >> 6), lane = tid & 63, wr = wid >> 2, wc = wid & 3, fr = lane & 15, fq = lane >> 4;
    const int nt = K / BK;
    int Rr[2], Cc[2]; unsigned voffB[2];
#pragma unroll
    for (int i = 0; i < 2; ++i) { int R, C; stage_rc(tid * 16 + i * 8192, R, C); const int Rb = Epi::PERM ? ((R & ~31) + perm32(R & 31)) : R;
        Rr[i] = R; Cc[i] = C; voffB[i] = (unsigned)(Rb * K + C) * 2u; }
    const size_t kstep = (size_t)(BK * 2);
    const size_t hstep = (size_t)HALF * K * 2;
    const unsigned ldsw = (unsigned)wid * 1024u;
    const int aoff = lds_byte(wr * 64 + fr, fq * 8), boff = lds_byte(wc * 32 + fr, fq * 8);
#define PG8_SA(b, h) (((b) * 2 + (h)) * HTB)
#define PG8_SB(b, h) ((4 + (b) * 2 + (h)) * HTB)
#define PG8_STAGE(bufoff, gbase, voff) do { _Pragma("unroll") for (int _i = 0; _i < 2; ++_i) \
        __builtin_amdgcn_global_load_lds((const unsigned*)((const char*)(gbase) + (voff)[_i]), (MK_LAS unsigned*)(lds + (bufoff) + ldsw + _i * 8192), 16, 0, 0); } while (0)
#define PG8_LDA(dst, b, h) do { _Pragma("unroll") for (int m = 0; m < 4; ++m) _Pragma("unroll") for (int k = 0; k < 2; ++k) dst[m][k] = *(const MK_LAS bf16x8*)(lds + PG8_SA(b, h) + aoff + m * 2048 + k * 1024); } while (0)
#define PG8_LDB(dst, b, h) do { _Pragma("unroll") for (int n = 0; n < 2; ++n) _Pragma("unroll") for (int k = 0; k < 2; ++k) dst[n][k] = *(const MK_LAS bf16x8*)(lds + PG8_SB(b, h) + boff + n * 2048 + k * 1024); } while (0)
#define PG8_MMA(ai, bj, At, Bt) do { __builtin_amdgcn_s_setprio(1); _Pragma("unroll") for (int m = 0; m < 4; ++m) _Pragma("unroll") for (int n = 0; n < 2; ++n) _Pragma("unroll") for (int k = 0; k < 2; ++k) \
        acc[ai][bj][m][n] = __builtin_amdgcn_mfma_f32_16x16x32_bf16(Bt[n][k], At[m][k], acc[ai][bj][m][n], 0, 0, 0); __builtin_amdgcn_s_setprio(0); } while (0)
#define PG8_WAIT_V(n) asm volatile("s_waitcnt vmcnt(" #n ")" ::: "memory")
#define PG8_WAIT_L(n) asm volatile("s_waitcnt lgkmcnt(" #n ")" ::: "memory")
#define PG8_BAR __builtin_amdgcn_s_barrier()
#define PG8_SCHED __builtin_amdgcn_sched_barrier(0)
    Unit cur, nxt; int ui = 0;
    if (!S.next(0, cur)) return;
    unsigned cv0[2], cv1[2], nv0[2], nv1[2];
    S.a_voff(0, cur, Rr, Cc, cv0, cv1);
    f32x4 acc[2][2][4][2];
#pragma unroll
    for (int a = 0; a < 2; ++a)
#pragma unroll
        for (int b = 0; b < 2; ++b)
#pragma unroll
            for (int m = 0; m < 4; ++m)
#pragma unroll
                for (int n = 0; n < 2; ++n) acc[a][b][m][n] = (f32x4){0.f, 0.f, 0.f, 0.f};
    bf16x8 At[4][2], B0[2][2], B1[2][2];
    const char* cA = S.a_base(cur); const char* cB = S.b_base(cur);
    PG8_STAGE(PG8_SB(0, 0), cB, voffB); PG8_STAGE(PG8_SB(0, 1), cB + hstep, voffB); PG8_STAGE(PG8_SA(0, 0), cA, cv0); PG8_STAGE(PG8_SA(0, 1), cA, cv1);
    if (wr == 1) PG8_BAR;
    PG8_WAIT_V(2); PG8_BAR;
    PG8_STAGE(PG8_SB(1, 0), cB + kstep, voffB); PG8_STAGE(PG8_SA(1, 0), cA + kstep, cv0); PG8_STAGE(PG8_SB(1, 1), cB + hstep + kstep, voffB);
    PG8_WAIT_V(6); PG8_BAR;
    for (;;) {
        const bool has_next = S.next(ui + 1, nxt);
        const char* nA = cA; const char* nB = cB;
#pragma unroll
        for (int j = 0; j < 2; ++j) { nv0[j] = cv0[j]; nv1[j] = cv1[j]; }
        if (has_next) { nA = S.a_base(nxt); nB = S.b_base(nxt); S.a_voff(ui + 1, nxt, Rr, Cc, nv0, nv1); }
        for (int t = 0; t < nt; t += 2) {
            const bool last = (t == nt - 2);
            const char* a1 = cA + (size_t)(t + 1) * kstep;
            const char* a2 = last ? nA : cA + (size_t)(t + 2) * kstep; const char* b2 = last ? nB : cB + (size_t)(t + 2) * kstep;
            const char* a3 = a2 + kstep; const char* b3 = b2 + kstep;
            unsigned x0[2], x1[2];
#pragma unroll
            for (int j = 0; j < 2; ++j) { x0[j] = last ? nv0[j] : cv0[j]; x1[j] = last ? nv1[j] : cv1[j]; }
            PG8_LDB(B0, 0, 0); PG8_LDB(B1, 0, 1); PG8_SCHED; PG8_LDA(At, 0, 0); PG8_STAGE(PG8_SA(1, 1), a1, cv1);
            PG8_WAIT_V(8); PG8_WAIT_L(0); PG8_BAR; PG8_MMA(0, 0, At, B0); PG8_MMA(0, 1, At, B1); PG8_BAR; PG8_SCHED;
            PG8_LDA(At, 0, 1); PG8_STAGE(PG8_SB(0, 0), b2, voffB); PG8_STAGE(PG8_SB(0, 1), b2 + hstep, voffB); PG8_STAGE(PG8_SA(0, 0), a2, x0);
            PG8_WAIT_V(8); PG8_WAIT_L(0); PG8_BAR; PG8_MMA(1, 0, At, B0); PG8_MMA(1, 1, At, B1); PG8_BAR; PG8_SCHED;
            PG8_LDB(B0, 1, 0); PG8_LDB(B1, 1, 1); PG8_SCHED; PG8_LDA(At, 1, 0); PG8_STAGE(PG8_SA(0, 1), a2, x1);
            PG8_WAIT_V(8); PG8_WAIT_L(0); PG8_BAR; PG8_MMA(0, 0, At, B0); PG8_MMA(0, 1, At, B1); PG8_BAR; PG8_SCHED;
            PG8_LDA(At, 1, 1); PG8_STAGE(PG8_SB(1, 0), b3, voffB); PG8_STAGE(PG8_SB(1, 1), b3 + hstep, voffB); PG8_STAGE(PG8_SA(1, 0), a3, x0);
            PG8_WAIT_V(8); PG8_WAIT_L(0); PG8_BAR; PG8_MMA(1, 0, At, B0); PG8_MMA(1, 1, At, B1); PG8_BAR; PG8_SCHED;
        }
        if (wr == 0) PG8_BAR;
        E(acc, cur, wr, wc, fr, fq);
        if (!has_next) break;
#pragma unroll
        for (int a = 0; a < 2; ++a)
#pragma unroll
            for (int b = 0; b < 2; ++b)
#pragma unroll
                for (int m = 0; m < 4; ++m)
#pragma unroll
                    for (int n = 0; n < 2; ++n) acc[a][b][m][n] = (f32x4){0.f, 0.f, 0.f, 0.f};
        cur = nxt; cA = nA; cB = nB; ++ui;
#pragma unroll
        for (int j = 0; j < 2; ++j) { cv0[j] = nv0[j]; cv1[j] = nv1[j]; }
        if (wr == 1) PG8_BAR;
    }
    PG8_WAIT_V(0);
    PG8_BAR;
#undef PG8_SA
#undef PG8_SB
#undef PG8_STAGE
#undef PG8_LDA
#undef PG8_LDB
#undef PG8_MMA
#undef PG8_WAIT_V
#undef PG8_WAIT_L
#undef PG8_BAR
#undef PG8_SCHED
}
__device__ __forceinline__ const char* uniform_ptr(const char* p) { const unsigned long long v = (unsigned long long)p; const unsigned lo = __builtin_amdgcn_readfirstlane((unsigned)v), hi = __builtin_amdgcn_readfirstlane((unsigned)(v >> 32)); return (const char*)(((unsigned long long)hi << 32) | lo); }
__host__ __device__ __forceinline__ int invperm32(int c) { return ((c >> 2) & 1) * 16 + (c >> 3) * 4 + (c & 3); }
struct BPatch {
    unsigned voff;
    unsigned ldsoff;
};
struct BSrcDown {
    const float* W; size_t estride; int ldb;
    __device__ __forceinline__ void patch(int tid, bool perm, BPatch& P) const {
        const int lane = tid & 63, w = tid >> 6, kr0 = 8 * w, n0 = 4 * lane;
        P.voff = (unsigned)(kr0 * ldb + n0) * 4u;
        { const int n = n0, h = n >> 7, R = n & 127, slot = perm ? ((R & ~31) + invperm32(R & 31)) : R; P.ldsoff = (unsigned)(h * HTB + lds_byte(slot, kr0)); }
    }
    __device__ __forceinline__ const char* base(const Unit& u, int  ) const { const int e = __builtin_amdgcn_readfirstlane(u.e), pn = __builtin_amdgcn_readfirstlane(u.pn); return (const char*)(W + (size_t)e * estride + (size_t)pn * BM); }
    __device__ __forceinline__ size_t rowbytes() const { return (size_t)ldb * 4; }
};

struct BSrcUp {
    const float* Wg; const float* Wu; size_t estride; int ldb;
    __device__ __forceinline__ void patch(int tid, bool perm, BPatch& P) const {
        const int lane = tid & 63, w = tid >> 6, s_ = w & 1, kr0 = 16 * (w >> 1) + 8 * (lane >> 5), c0 = 4 * (lane & 31);
        P.voff = (unsigned)(kr0 * ldb + c0) * 4u;
        { const int R = c0, slot = perm ? ((R & ~31) + invperm32(R & 31)) : R; P.ldsoff = (unsigned)(s_ * HTB + lds_byte(slot, kr0)); }
    }
    __device__ __forceinline__ const char* base(const Unit& u, int wave) const { const int e = __builtin_amdgcn_readfirstlane(u.e), pn = __builtin_amdgcn_readfirstlane(u.pn), sel = __builtin_amdgcn_readfirstlane(wave & 1);
        const unsigned long long m = 0ull - (unsigned long long)(unsigned)sel;
        const float* src = (const float*)(((unsigned long long)Wg & ~m) | ((unsigned long long)Wu & m)); return (const char*)(src + (size_t)e * estride + (size_t)pn * HALF); }
    __device__ __forceinline__ size_t rowbytes() const { return (size_t)ldb * 4; }
};

template <int VAR = 0, class Epi, class Sched, class BSrc>
__device__ __forceinline__ void gemm_phase_fb(MK_LAS unsigned char* lds, const int K, const Sched& S, const BSrc& Bs_, const Epi& E) {
    const int tid = ltid(), wid = __builtin_amdgcn_readfirstlane(tid >> 6), lane = tid & 63, wr = wid >> 2, wc = wid & 3, fr = lane & 15, fq = lane >> 4;
    const int nt = K / BK;
    BPatch P; Bs_.patch(tid, Epi::PERM, P);
    const size_t kstep = (size_t)(BK * 2);
    const size_t rowb = Bs_.rowbytes(), ktb = rowb * BK;
    const unsigned ldsw = (unsigned)wid * 1024u;
    const int aoff = lds_byte(wr * 64 + fr, fq * 8), boff = lds_byte(wc * 32 + fr, fq * 8);
#define PG8_SA(b, h) (((b) * 2 + (h)) * HTB)
#define PG8_SB(b, h) ((4 + (b) * 2 + (h)) * HTB)
#define PG8_STAGE(bufoff, gbase, voff) do { _Pragma("unroll") for (int _i = 0; _i < 2; ++_i) \
        __builtin_amdgcn_global_load_lds((const unsigned*)((const char*)(gbase) + (voff)[_i]), (MK_LAS unsigned*)(lds + (bufoff) + ldsw + _i * 8192), 16, 0, 0); } while (0)
#define PG8_LDA(dst, b, h) do { _Pragma("unroll") for (int m = 0; m < 4; ++m) _Pragma("unroll") for (int k = 0; k < 2; ++k) dst[m][k] = *(const MK_LAS bf16x8*)(lds + PG8_SA(b, h) + aoff + m * 2048 + k * 1024); } while (0)
#define PG8_LDB(dst, b, h) do { _Pragma("unroll") for (int n = 0; n < 2; ++n) _Pragma("unroll") for (int k = 0; k < 2; ++k) dst[n][k] = *(const MK_LAS bf16x8*)(lds + PG8_SB(b, h) + boff + n * 2048 + k * 1024); } while (0)
#define PG8_MMA(ai, bj, At, Bt) do { __builtin_amdgcn_s_setprio(1); _Pragma("unroll") for (int m = 0; m < 4; ++m) _Pragma("unroll") for (int n = 0; n < 2; ++n) _Pragma("unroll") for (int k = 0; k < 2; ++k) \
        acc[ai][bj][m][n] = __builtin_amdgcn_mfma_f32_16x16x32_bf16(Bt[n][k], At[m][k], acc[ai][bj][m][n], 0, 0, 0); __builtin_amdgcn_s_setprio(0); } while (0)
#define PG8_WAIT_V(n) asm volatile("s_waitcnt vmcnt(" #n ")" ::: "memory")
#define PG8_WAIT_L(n) asm volatile("s_waitcnt lgkmcnt(" #n ")" ::: "memory")
#define PG8_BAR __builtin_amdgcn_s_barrier()
#define PG8_SCHED __builtin_amdgcn_sched_barrier(0)
    f32x4 br[8];
#define BF_LOAD(ptr) do { const char* _p = uniform_ptr(ptr); \
        _Pragma("unroll") for (int _j = 0; _j < 8; ++_j) asm volatile("global_load_dwordx4 %0, %1, %2" : "=v"(br[_j]) : "v"(P.voff), "s"(_p + (size_t)_j * rowb) : "memory"); } while (0)
#define BF_CONSUME(NLEFT, b) do { asm volatile("s_waitcnt vmcnt(" #NLEFT ")" : "+v"(br[0]), "+v"(br[1]), "+v"(br[2]), "+v"(br[3]), "+v"(br[4]), "+v"(br[5]), "+v"(br[6]), "+v"(br[7]) :: "memory"); \
        _Pragma("unroll") for (int _i = 0; _i < 4; ++_i) { u32x4 _w; _w.x = cvt_pk_bf16(br[0][_i], br[1][_i]); _w.y = cvt_pk_bf16(br[2][_i], br[3][_i]); _w.z = cvt_pk_bf16(br[4][_i], br[5][_i]); _w.w = cvt_pk_bf16(br[6][_i], br[7][_i]); \
            *(MK_LAS u32x4*)(lds + PG8_SB(b, 0) + P.ldsoff + _i * 64) = _w; } } while (0)
#define BF_FILL(g, b, nptr) do { \
        if ((g) < 20) { if (VAR != 2 && VAR != 3) { const int _c = (g) / 5, _w = (g) % 5; \
            if (_w < 4) fw[_w] = cvt_pk_bf16_c(br[2 * _w][_c], br[2 * _w + 1][_c]); \
            else *(MK_LAS u32x4*)(lds + PG8_SB(b, 0) + P.ldsoff + _c * 64) = (u32x4){fw[0], fw[1], fw[2], fw[3]}; } } \
        else if ((g) < 28 && VAR != 3) { const int _j = (g) - 20; asm volatile("global_load_dwordx4 %0, %1, %2" : "=v"(br[_j]) : "v"(P.voff), "s"(nptr + (size_t)_j * rowb) : "memory"); } } while (0)
#define BF_MMA_FILL(b, nextp) do { const char* _np = uniform_ptr(nextp); unsigned fw[4]; BPatch P; Bs_.patch(ltid(), Epi::PERM, P); \
        asm volatile("s_waitcnt vmcnt(4)" : "+v"(br[0]), "+v"(br[1]), "+v"(br[2]), "+v"(br[3]), "+v"(br[4]), "+v"(br[5]), "+v"(br[6]), "+v"(br[7]) :: "memory"); \
        __builtin_amdgcn_s_setprio(1); \
        _Pragma("unroll") for (int _g = 0; _g < 32; ++_g) { const int _bj = _g >> 4, _m = (_g >> 2) & 3, _n = (_g >> 1) & 1, _k = _g & 1; \
            if (_bj == 0) acc[1][0][_m][_n] = __builtin_amdgcn_mfma_f32_16x16x32_bf16(B0[_n][_k], At[_m][_k], acc[1][0][_m][_n], 0, 0, 0); \
            else acc[1][1][_m][_n] = __builtin_amdgcn_mfma_f32_16x16x32_bf16(B1[_n][_k], At[_m][_k], acc[1][1][_m][_n], 0, 0, 0); \
            BF_FILL(_g, b, _np); \
            __builtin_amdgcn_sched_barrier(0); } \
        __builtin_amdgcn_s_setprio(0); } while (0)
    Unit cur, nxt; int ui = 0;
    if (!S.next(0, cur)) return;
#define AV(dst, unit, half) do { _Pragma("unroll") for (int _j = 0; _j < 2; ++_j) { int _R, _C; stage_rc(ltid() * 16 + _j * 8192, _R, _C); dst[_j] = S.a_off1((unit), (half), _R, _C); } } while (0)
    unsigned cv0[2], cv1[2], nv0[2], nv1[2];
    AV(cv0, 0, 0); AV(cv1, 0, 1);
    f32x4 acc[2][2][4][2];
#pragma unroll
    for (int a = 0; a < 2; ++a)
#pragma unroll
        for (int b = 0; b < 2; ++b)
#pragma unroll
            for (int m = 0; m < 4; ++m)
#pragma unroll
                for (int n = 0; n < 2; ++n) acc[a][b][m][n] = (f32x4){0.f, 0.f, 0.f, 0.f};
    bf16x8 At[4][2], B0[2][2], B1[2][2];
    const char* cA = S.a_base(cur); const char* cB = Bs_.base(cur, wid);
    BF_LOAD(cB); PG8_STAGE(PG8_SA(0, 0), cA, cv0); PG8_STAGE(PG8_SA(0, 1), cA, cv1);
    BF_CONSUME(4, 0);
    BF_LOAD(cB + ktb); PG8_STAGE(PG8_SA(1, 0), cA + kstep, cv0);
    BF_CONSUME(2, 1);
    BF_LOAD(cB + 2 * ktb);
    PG8_WAIT_V(8); PG8_WAIT_L(0);
    if (wr == 1) PG8_BAR;
    PG8_BAR; PG8_BAR;
    for (;;) {
        const bool has_next = S.next(ui + 1, nxt);
        const char* nA = cA; const char* nB = cB;
        if (has_next) { nA = S.a_base(nxt); nB = Bs_.base(nxt, wid); }
        const int un = has_next ? ui + 1 : ui;
        if constexpr (Sched::GATHER) { AV(nv0, un, 0); AV(nv1, un, 1); }
        for (int t = 0; t < nt; t += 2) {
            const bool last = (t == nt - 2);
            const char* a1 = cA + (size_t)(t + 1) * kstep;
            const char* a2 = last ? nA : cA + (size_t)(t + 2) * kstep;
            const char* a3 = a2 + kstep;
            const int km = (VAR == 1) ? 1 : -1;
            const char* b3 = (t + 3 < nt) ? cB + (size_t)((t + 3) & km) * ktb : nB + (size_t)(t + 3 - nt) * ktb;
            const char* b4 = (t + 4 < nt) ? cB + (size_t)((t + 4) & km) * ktb : nB + (size_t)(t + 4 - nt) * ktb;
#define AOFF_H0(_i) (Sched::GATHER ? (last ? nv0[_i] : cv0[_i]) : cv0[_i])
#define AOFF_H1(_i) (Sched::GATHER ? (last ? nv1[_i] : cv1[_i]) : cv0[_i] + (unsigned)(HALF * K * 2))
#define AOFF_C1(_i) (Sched::GATHER ? cv1[_i] : cv0[_i] + (unsigned)(HALF * K * 2))
#define PG8_STAGEF(bufoff, gbase, OFF) do { _Pragma("unroll") for (int _i = 0; _i < 2; ++_i) \
        __builtin_amdgcn_global_load_lds((const unsigned*)((const char*)(gbase) + OFF(_i)), (MK_LAS unsigned*)(lds + (bufoff) + ldsw + _i * 8192), 16, 0, 0); } while (0)
            PG8_LDB(B0, 0, 0); PG8_LDB(B1, 0, 1); PG8_SCHED; PG8_LDA(At, 0, 0); PG8_STAGEF(PG8_SA(1, 1), a1, AOFF_C1);
            PG8_WAIT_V(12); PG8_WAIT_L(0); PG8_BAR; PG8_MMA(0, 0, At, B0); PG8_MMA(0, 1, At, B1); PG8_BAR; PG8_SCHED;
            PG8_LDA(At, 0, 1); PG8_STAGEF(PG8_SA(0, 0), a2, AOFF_H0);
            PG8_WAIT_L(0); PG8_BAR; BF_MMA_FILL(0, b3); PG8_BAR; PG8_SCHED;
            PG8_LDB(B0, 1, 0); PG8_LDB(B1, 1, 1); PG8_SCHED; PG8_LDA(At, 1, 0); PG8_STAGEF(PG8_SA(0, 1), a2, AOFF_H1);
            PG8_WAIT_V(12); PG8_WAIT_L(0); PG8_BAR; PG8_MMA(0, 0, At, B0); PG8_MMA(0, 1, At, B1); PG8_BAR; PG8_SCHED;
            PG8_LDA(At, 1, 1); PG8_STAGEF(PG8_SA(1, 0), a3, AOFF_H0);
            PG8_WAIT_L(0); PG8_BAR; BF_MMA_FILL(1, b4); PG8_BAR; PG8_SCHED;
        }
        if (wr == 0) PG8_BAR;
        E(acc, cur, wr, wc, fr, fq);
        if (!has_next) break;
#pragma unroll
        for (int a = 0; a < 2; ++a)
#pragma unroll
            for (int b = 0; b < 2; ++b)
#pragma unroll
                for (int m = 0; m < 4; ++m)
#pragma unroll
                    for (int n = 0; n < 2; ++n) acc[a][b][m][n] = (f32x4){0.f, 0.f, 0.f, 0.f};
        cur = nxt; cA = nA; cB = nB; ++ui;
        if constexpr (Sched::GATHER) {
#pragma unroll
            for (int j = 0; j < 2; ++j) { cv0[j] = nv0[j]; cv1[j] = nv1[j]; } }
        if (wr == 1) PG8_BAR;
    }
    asm volatile("s_waitcnt vmcnt(0)" : "+v"(br[0]), "+v"(br[1]), "+v"(br[2]), "+v"(br[3]), "+v"(br[4]), "+v"(br[5]), "+v"(br[6]), "+v"(br[7]) :: "memory");
    PG8_BAR;
#undef BF_LOAD
#undef AOFF_H0
#undef AOFF_H1
#undef AOFF_C1
#undef PG8_STAGEF
#undef BF_FILL
#undef BF_MMA_FILL
#undef AV
#undef BF_CONSUME
#undef PG8_SA
#undef PG8_SB
#undef PG8_STAGE
#undef PG8_LDA
#undef PG8_LDB
#undef PG8_MMA
#undef PG8_WAIT_V
#undef PG8_WAIT_L
#undef PG8_BAR
#undef PG8_SCHED
}
struct In { const float *x, *c, *w_ada, *b_ada, *w_in, *lam, *subg, *relb, *w_o, *ln_g, *ln_b, *w_group, *b_group, *w_router, *b_router, *w_gate, *w_up, *w_down; };
struct Ws {
    unsigned* ctl;
    float* mod;
    bf16_t* wt_in;
    bf16_t* wt_o;
    bf16_t* wt_gu;
    bf16_t* wt_d;
    bf16_t* ab;
    bf16_t* proj;
    bf16_t* mixin;
    bf16_t* mixb;
    float* x1;
    float* xa;
    bf16_t* Hb;
    bf16_t* Yb;
    int* tok_of;
    int* tokinfo;
    float* tokw;
    bf16_t* wt_rh;
    bf16_t* wt_rl;
    bf16_t* ablo;
};
constexpr int CTL_CNT = 4096;
constexpr int CTL_WORDS = 8192;

constexpr int LDS_AUX = 131072;
constexpr int LDS_PEXP = LDS_AUX;
constexpr int LDS_PBASE = LDS_AUX + 768;
constexpr int LDS_CNT = LDS_AUX + 1024;
constexpr int LDS_XOFF = LDS_AUX + 1280;
constexpr int LDS_TOKL = LDS_AUX + 2048;
constexpr int LDS_BTAB = LDS_AUX + 2048 + 8192;
constexpr int LDS_MISC = LDS_BTAB + 1088;
constexpr int LDS_BYTES = 147456;
constexpr int LDS_FLAGS = LDS_MISC + 64;
static_assert(LDS_FLAGS + 64 <= LDS_BYTES, "LDS map");

struct Frame { MK_LAS unsigned char* lds; int tid, lane, wave, G, vcu; };

__device__ __forceinline__ void conv_item(const float* __restrict__ W, int K, int N, bf16_t* __restrict__ WT, int k0, int n0, int drow0, MK_LAS float* scr, int lane) {
    const int n4 = (lane & 15) * 4, kq = lane >> 4;
    f32x4 v[16];
#pragma unroll
    for (int i = 0; i < 16; ++i) v[i] = *(const f32x4*)(W + (size_t)(k0 + kq + 4 * i) * N + n0 + n4);
#pragma unroll
    for (int i = 0; i < 16; ++i) { MK_LAS float* p = scr + (kq + 4 * i) * 65 + n4; p[0] = v[i][0]; p[1] = v[i][1]; p[2] = v[i][2]; p[3] = v[i][3]; }
    asm volatile("s_waitcnt lgkmcnt(0)" ::: "memory");
    const int c = lane & 7;
#pragma unroll
    for (int j = 0; j < 8; ++j) { const int n = (lane >> 3) + 8 * j; const MK_LAS float* s = scr + (8 * c) * 65 + n;
        u32x4 o; o.x = cvt_pk_bf16(s[0 * 65], s[1 * 65]); o.y = cvt_pk_bf16(s[2 * 65], s[3 * 65]); o.z = cvt_pk_bf16(s[4 * 65], s[5 * 65]); o.w = cvt_pk_bf16(s[6 * 65], s[7 * 65]);
        st16(WT + (size_t)(drow0 + n) * K + k0 + 8 * c, o); }
    asm volatile("s_waitcnt lgkmcnt(0)" ::: "memory");
}
#if (defined(MK_F32B_DOWN) && defined(MK_F32B_UP)) || defined(MK_BGCONV)
constexpr int CI_E = 0;
#elif defined(MK_F32B_DOWN)
constexpr int CI_E = 1024;
#else
constexpr int CI_E = 1536;
#endif
constexpr int CI_IN = 3072, CI_O = 1024, CI_LAYER = CI_IN + CI_O + NE * CI_E;
__device__ __forceinline__ void conv_dispatch(const In& in, const Ws& w, int l, int r, MK_LAS float* scr, int lane) {
    if (r < CI_IN) { const int kb = r / 96, nb = r % 96; conv_item(in.w_in + (size_t)l * D * INC, D, INC, w.wt_in + (size_t)l * INC * D, kb * 64, nb * 64, nb * 64, scr, lane); return; }
    r -= CI_IN;
    if (r < CI_O) { const int kb = r / 32, nb = r % 32; conv_item(in.w_o + (size_t)l * D * D, D, D, w.wt_o + (size_t)l * D * D, kb * 64, nb * 64, nb * 64, scr, lane); return; }
    r -= CI_O;
    if (CI_E == 0) return;
    const int e = r / (CI_E ? CI_E : 1); r -= e * CI_E;
    const size_t le = (size_t)l * NE + e;
    if (r < 512) { const int kb = r / 16, nb = r % 16, n0 = nb * 64; conv_item(in.w_gate + le * D * DE, D, DE, w.wt_gu + le * 2048 * D, kb * 64, n0, ((n0 >> 7) << 8) + (n0 & 127), scr, lane); return; }
    r -= 512;
    if (r < 512) { const int kb = r / 16, nb = r % 16, n0 = nb * 64; conv_item(in.w_up + le * D * DE, D, DE, w.wt_gu + le * 2048 * D, kb * 64, n0, ((n0 >> 7) << 8) + 128 + (n0 & 127), scr, lane); return; }
    r -= 512;
#ifndef MK_F32B_DOWN
    { const int kb = r / 32, nb = r % 32; conv_item(in.w_down + le * DE * D, DE, D, w.wt_d + le * D * DE, kb * 64, nb * 64, nb * 64, scr, lane); }
#endif
}
__device__ __forceinline__ void phase_convert(const Frame& F, const In& in, const Ws& w, int it_lo, int it_hi) {
    MK_LAS float* scr = (MK_LAS float*)(F.lds + F.wave * 16640);
    const int gw = F.vcu * NWAVES + F.wave, NGW = F.G * NWAVES;
    for (int it = gw + it_lo; it < it_hi; it += NGW) conv_dispatch(in, w, it / CI_LAYER, it % CI_LAYER, scr, F.lane);
}

__device__ __forceinline__ void phase_mod(const Frame& F, const In& in, const Ws& w) {
    MK_LAS float* sc = (MK_LAS float*)(F.lds + 133120 - 133120);
    MK_LAS float* red = (MK_LAS float*)(F.lds + 32768);
    __syncthreads();
    for (int i = F.tid; i < NB * D; i += NTHR) { const float cv = in.c[i]; sc[i] = cv / (1.0f + __expf(-cv)); }
    __syncthreads();
    for (int item = F.vcu; item < 256; item += F.G) {
        const int l = item >> 7, n0 = (item & 127) * 96;
        const int cq = F.tid % 24, ks = F.tid / 24;
        if (ks < 16) {
            const float* wp = in.w_ada + (size_t)l * D * 6 * D + (size_t)(ks * 128) * 6 * D + n0 + cq * 4;
            f32x4 a0 = {0.f, 0.f, 0.f, 0.f}, a1 = a0, a2 = a0, a3 = a0;
#pragma unroll 8
            for (int k = 0; k < 128; ++k) { const f32x4 wv = *(const f32x4*)(wp + (size_t)k * 6 * D); const int kk = ks * 128 + k;
                a0 += wv * sc[kk]; a1 += wv * sc[D + kk]; a2 += wv * sc[2 * D + kk]; a3 += wv * sc[3 * D + kk]; }
            MK_LAS f32x4* rp = (MK_LAS f32x4*)red + (ks * 24 + cq) * 4;
            rp[0] = a0; rp[1] = a1; rp[2] = a2; rp[3] = a3;
        }
        __syncthreads();
        if (F.tid < 384) {
            const int q = F.tid / 16, bb = (F.tid >> 2) & 3, comp = F.tid & 3;
            float s = 0.f;
#pragma unroll
            for (int k2 = 0; k2 < 16; ++k2) s += red[((k2 * 24 + q) * 4 + bb) * 4 + comp];
            const int n = n0 + q * 4 + comp;
            w.mod[((size_t)l * NB + bb) * 6 * D + n] = s + in.b_ada[l * 6 * D + n];
        }
        __syncthreads();
    }
}

__device__ __forceinline__ void phase_modulate(const Frame& F, const float* __restrict__ x, const float* __restrict__ modl, bf16_t* __restrict__ ub) {
    const int gw = F.vcu * NWAVES + F.wave, NGW = F.G * NWAVES;
    for (int t = gw; t < M; t += NGW) {
        const float* mb = modl + (size_t)(t / S) * 6 * D;
        const float* xr = x + (size_t)t * D;
        bf16_t* ur = ub + (size_t)t * D;
#pragma unroll
        for (int j = 0; j < 8; ++j) { const int col = j * 256 + F.lane * 4;
            const f32x4 xv = *(const f32x4*)(xr + col), sh = *(const f32x4*)(mb + col), scv = *(const f32x4*)(mb + D + col);
            const f32x4 u = xv * (scv + 1.0f) + sh;
            u32x2 o; o.x = cvt_pk_bf16(u[0], u[1]); o.y = cvt_pk_bf16(u[2], u[3]);
            *(u32x2*)(ur + col) = o; }
    }
}

__device__ __forceinline__ int t5_bucket(int n) {
    if (n < 16) return n;
    const float v = logf((float)n / 16.0f) / 2.0794415416798357f * 16.0f;
    const int large = 16 + (int)v;
    return large < 31 ? large : 31;
}
__device__ __forceinline__ float permswap_other(float v) {
    auto rr = __builtin_amdgcn_permlane32_swap(__float_as_uint(v), __float_as_uint(v), false, false);
    return (__lane_id() & 32) ? __uint_as_float(rr[0]) : __uint_as_float(rr[1]);
}

#ifdef MK_BGCONV
constexpr int BG_ITEMS = (MK_BGCONV == 2 ? 2 : 3) * 65536;
#ifndef MK_BGMASK
#define MK_BGMASK 0
#endif
struct BgConv { const float* wg; const float* wu; const float* wd; bf16_t* tgu; bf16_t* td; int next, step, cur, mode; f32x2 p[8]; };
struct BgAddr { const float* src; bf16_t* dst; int N, K; };
__device__ __forceinline__ BgAddr bg_addr(const BgConv& g, int r, int lane) {
    r = __builtin_amdgcn_readfirstlane(r);
    const int mat = r >> 16, e = (r >> 11) & 31, kg = lane & 7, np = lane >> 3;
    BgAddr a;
    if (mat < 2) { const int kb = (r >> 6) & 31, n0 = (r & 63) * 16;
        const unsigned long long m = 0ull - (unsigned long long)(unsigned)mat;
        const float* W = (const float*)(((unsigned long long)g.wg & ~m) | ((unsigned long long)g.wu & m));
        a.N = DE; a.K = D;
        a.src = W + (size_t)e * D * DE + (size_t)(kb * 64 + 8 * kg) * DE + n0 + 2 * np;
        a.dst = g.tgu + (size_t)e * 2048 * D + (size_t)(((n0 >> 7) << 8) + (n0 & 127) + mat * 128 + 2 * np) * D + kb * 64 + 8 * kg;
    } else { const int kb = (r >> 7) & 15, n0 = (r & 127) * 16;
        a.N = D; a.K = DE;
        a.src = g.wd + (size_t)e * DE * D + (size_t)(kb * 64 + 8 * kg) * D + n0 + 2 * np;
        a.dst = g.td + (size_t)e * D * DE + (size_t)(n0 + 2 * np) * DE + kb * 64 + 8 * kg;
    }
    return a;
}
__device__ __forceinline__ void bg_load(BgConv& g, int lane) {
    const bool live = g.next < BG_ITEMS; const int r = live ? g.next : BG_ITEMS - 1;
    const BgAddr a = bg_addr(g, r, lane);
    if (g.mode != 2) {
#pragma unroll
    for (int j = 0; j < 8; ++j) g.p[j] = *(const __attribute__((address_space(1))) f32x2*)(unsigned long long)(a.src + (size_t)j * a.N); }
    g.cur = live ? g.next : -1; if (live) g.next += g.step;
}
__device__ __forceinline__ void bg_store(BgConv& g, int lane) {
    if (g.cur >= 0 && g.mode == 1) {
#pragma unroll
        for (int j = 0; j < 8; ++j) asm volatile("" :: "v"(g.p[j]));
        g.cur = -1; }
    if (g.cur >= 0) { const BgAddr a = bg_addr(g, g.cur, lane);
        u32x4 o0, o1;
        o0.x = cvt_pk_bf16(g.p[0][0], g.p[1][0]); o0.y = cvt_pk_bf16(g.p[2][0], g.p[3][0]); o0.z = cvt_pk_bf16(g.p[4][0], g.p[5][0]); o0.w = cvt_pk_bf16(g.p[6][0], g.p[7][0]);
        o1.x = cvt_pk_bf16(g.p[0][1], g.p[1][1]); o1.y = cvt_pk_bf16(g.p[2][1], g.p[3][1]); o1.z = cvt_pk_bf16(g.p[4][1], g.p[5][1]); o1.w = cvt_pk_bf16(g.p[6][1], g.p[7][1]);
        st16(a.dst, o0); st16(a.dst + a.K, o1); g.cur = -1; }
}
#define BG_PARAM , BgConv& bgc
#define BG_ARG , bgc
#else
#define BG_PARAM
#define BG_ARG
#endif

template <int MODE>
__device__ __forceinline__ void attn_pass(MK_LAS unsigned char* lds, const bf16_t* __restrict__ base  , int qcol, int kcol, int vcol, int qb,
                                          const MK_LAS float* btab, f32x16 (&O)[4], float& lsum BG_PARAM) {
    constexpr int DQK = MODE ? 128 : 64, ND0 = DQK / 16, KSTR = DQK * 2 + 16, VSTR = 320, KBYTES = 64 * KSTR, VBYTES = 64 * VSTR, BUF = KBYTES + VBYTES;
    constexpr int NKP = MODE ? 2 : 1;
    const int tid = ltid(), lane = tid & 63, wid = __builtin_amdgcn_readfirstlane(tid >> 6), r32 = lane & 31, hi = lane >> 5;
    const int q0 = qb * 256, qw0 = q0 + wid * 32, q = qw0 + r32;
    const int nt = 4 * qb + 4;
    bf16x8 qf[ND0];
#pragma unroll
    for (int d0 = 0; d0 < ND0; ++d0) qf[d0] = *(const bf16x8*)(base + (size_t)q * INC + qcol + d0 * 16 + hi * 8);
#pragma unroll
    for (int db = 0; db < 4; ++db)
#pragma unroll
        for (int r = 0; r < 16; ++r) O[db][r] = 0.f;
    float mref = 0.f; lsum = 0.f;
    float carry = 0.f;
    MK_LAS unsigned* flags = (MK_LAS unsigned*)(lds + LDS_FLAGS);
    const int krow = MODE ? (tid >> 4) : (tid >> 3), kch = MODE ? (tid & 15) : (tid & 7);
    const int vrow = tid >> 4, vch = tid & 15;
    const bf16_t* kg = base + (size_t)krow * INC + kcol + kch * 8;
    const bf16_t* vg = base + (size_t)vrow * INC + vcol + vch * 8;
    const unsigned kl = krow * KSTR + kch * 16, vl = KBYTES + vrow * VSTR + vch * 16;
    u32x4 kreg[NKP], vreg[2];
#define AT_GLOAD(j) do { const size_t _ro = (size_t)(j) * 64 * INC; \
        _Pragma("unroll") for (int _i = 0; _i < NKP; ++_i) kreg[_i] = *(const u32x4*)(kg + _ro + (size_t)_i * 32 * INC); \
        _Pragma("unroll") for (int _i = 0; _i < 2; ++_i) vreg[_i] = *(const u32x4*)(vg + _ro + (size_t)_i * 32 * INC); } while (0)
#define AT_LWRITE(bufo) do { \
        _Pragma("unroll") for (int _i = 0; _i < NKP; ++_i) *(MK_LAS u32x4*)(lds + (bufo) + kl + _i * 32 * KSTR) = kreg[_i]; \
        _Pragma("unroll") for (int _i = 0; _i < 2; ++_i) *(MK_LAS u32x4*)(lds + (bufo) + vl + _i * 32 * VSTR) = vreg[_i]; } while (0)
    const unsigned ka = r32 * KSTR + hi * 16;
    const unsigned va = KBYTES + (4 * hi + ((lane & 15) >> 2)) * VSTR + (((lane >> 4) & 1) * 16 + (lane & 3) * 4) * 2;
    { const int j0 = MODE ? nt - 1 : 0; AT_GLOAD(j0); AT_LWRITE(0); }
    __syncthreads();
#ifdef MK_BGCONV
#pragma unroll
    for (int d0 = 0; d0 < ND0; ++d0) asm volatile("" : "+v"(qf[d0]));
#endif
#ifdef MK_BGCONV
#pragma unroll (MODE ? 1 : 2)
#endif
    for (int it = 0; it < nt; ++it) {
        const int j = MODE ? nt - 1 - it : it;
        const unsigned bo = (unsigned)(it & 1) * BUF;
#if defined(MK_BGCONV) && !defined(MK_BGLATE)
        if (MODE == 0 && !(it & MK_BGMASK)) bg_store(bgc, lane);
#endif
        if (it + 1 < nt) { const int jn = MODE ? j - 1 : j + 1; AT_GLOAD(jn); }
#ifdef MK_BGCONV
#ifdef MK_BGSPREAD
        const bool bgact = (MODE == 0) && !(it & MK_BGMASK);
        BgAddr bga; bga.src = nullptr; bga.N = 0;
#define BG_BEGIN() do { if (bgact) { const bool live = bgc.next < BG_ITEMS; const int r = live ? bgc.next : BG_ITEMS - 1; bga = bg_addr(bgc, r, lane); bgc.cur = live ? bgc.next : -1; if (live) bgc.next += bgc.step; } } while (0)
#ifndef MK_BGLATE
        BG_BEGIN();
#endif
#define BG_LD(jj) do { if (bgact) { asm volatile("" :: "v"(bgc.p[jj]));        \
            bgc.p[jj] = *(const __attribute__((address_space(1))) f32x2*)(unsigned long long)(bga.src + (size_t)(jj) * bga.N); } } while (0)
#ifdef MK_BGLATE
#define BG_FENCE() do { if (bgact) __builtin_amdgcn_sched_barrier(0); } while (0)
#else
#define BG_FENCE() __builtin_amdgcn_sched_barrier(0)
#endif
        BG_FENCE();
#else
        if (MODE == 0 && !(it & MK_BGMASK)) bg_load(bgc, lane);
#define BG_LD(jj) do { } while (0)
#define BG_FENCE() do { } while (0)
#endif
#else
#define BG_LD(jj) do { } while (0)
#define BG_FENCE() do { } while (0)
#endif
        const bool skip = MODE ? (64 * j >= qw0 + 32) : (64 * j > qw0 + 31);
        f32x16 sT[2]; bf16x8 pf[2][2];
        if (!skip) {
            const float cinit = MODE ? 0.f : -mref;
#pragma unroll
            for (int kb = 0; kb < 2; ++kb) {
                bf16x8 kf[ND0];
#pragma unroll
                for (int d0 = 0; d0 < ND0; ++d0) kf[d0] = *(const MK_LAS bf16x8*)(lds + bo + ka + kb * 32 * KSTR + d0 * 32);
#pragma unroll
                for (int r = 0; r < 16; ++r) sT[kb][r] = cinit;
                __builtin_amdgcn_sched_barrier(0);
#pragma unroll
                for (int d0 = 0; d0 < ND0; ++d0) sT[kb] = __builtin_amdgcn_mfma_f32_32x32x16_bf16(kf[d0], qf[d0], sT[kb], 0, 0, 0);
            }
        }
#if defined(MK_BGSPREAD) && defined(MK_BGLATE)
        if (bgact) { bg_store(bgc, lane); } BG_BEGIN();
#endif
        BG_FENCE(); BG_LD(0); BG_LD(1); BG_LD(2); BG_FENCE();
        if (!skip) {
            const int kbase = 64 * j + 4 * hi;
            if (MODE == 0) {
                if (j >= 4 * qb - 2) {
#pragma unroll
                    for (int kb = 0; kb < 2; ++kb)
#pragma unroll
                        for (int r = 0; r < 16; ++r) { int rel = q - (kbase + 32 * kb + (r & 3) + 8 * (r >> 2)); rel = rel < 0 ? 0 : (rel > 128 ? 128 : rel); sT[kb][r] += btab[rel]; }
                }
                if (j >= 4 * qb) {
#pragma unroll
                    for (int kb = 0; kb < 2; ++kb)
#pragma unroll
                        for (int r = 0; r < 16; ++r) { const int key = kbase + 32 * kb + (r & 3) + 8 * (r >> 2); if (key > q) sT[kb][r] = -INFINITY; }
                }
                float ma = fmaxf(fmaxf(sT[0][0], sT[0][1]), sT[1][0]), mb = fmaxf(fmaxf(sT[0][2], sT[0][3]), sT[1][1]);
                ma = fmaxf(fmaxf(ma, sT[1][2]), sT[1][3]);
#pragma unroll
                for (int r = 4; r < 16; r += 4) { ma = fmaxf(fmaxf(ma, sT[0][r]), sT[0][r + 1]); mb = fmaxf(fmaxf(mb, sT[0][r + 2]), sT[0][r + 3]);
                    ma = fmaxf(fmaxf(ma, sT[1][r]), sT[1][r + 1]); mb = fmaxf(fmaxf(mb, sT[1][r + 2]), sT[1][r + 3]); }
                float grow = fmaxf(ma, mb);
                grow = fmaxf(grow, permswap_other(grow));
                if (it == 0 || !__all(grow <= 8.0f)) {
                    const float delta = (it == 0) ? grow : fmaxf(grow, 0.f);
                    const float alpha = __builtin_amdgcn_exp2f(-delta);
                    mref += delta; lsum *= alpha;
#pragma unroll
                    for (int kb = 0; kb < 2; ++kb)
#pragma unroll
                        for (int r = 0; r < 16; ++r) sT[kb][r] -= delta;
#pragma unroll
                    for (int db = 0; db < 4; ++db)
#pragma unroll
                        for (int r = 0; r < 16; ++r) O[db][r] *= alpha;
                }
                f32x2 ps2 = {0.f, 0.f};
#pragma unroll
                for (int kb = 0; kb < 2; ++kb)
#pragma unroll
                    for (int r = 0; r < 16; r += 2) { const float p0 = __builtin_amdgcn_exp2f(sT[kb][r]), p1 = __builtin_amdgcn_exp2f(sT[kb][r + 1]); sT[kb][r] = p0; sT[kb][r + 1] = p1; ps2 += (f32x2){p0, p1}; }
                lsum += ps2[0] + ps2[1];
            } else {
                const bool band = (j >= 4 * qb);
                float suf = carry;
#pragma unroll
                for (int kb = 1; kb >= 0; --kb) {
                    float Lr[16], gs[4], pg[4];
#pragma unroll
                    for (int g4 = 0; g4 < 4; ++g4) {
                        float sgrp = 0.f;
#pragma unroll
                        for (int i = 0; i < 4; ++i) { const int r = g4 * 4 + i; const float z = sT[kb][r];
                            float L = -(fmaxf(z, 0.f) + __builtin_amdgcn_logf(1.0f + __builtin_amdgcn_exp2f(-fabsf(z))));
                            if (band) { const int key = kbase + 32 * kb + i + 8 * g4; if (key >= q) L = 0.f; }
                            Lr[r] = L; sgrp += L; }
                        gs[g4] = sgrp;
                    }
#pragma unroll
                    for (int g4 = 0; g4 < 4; ++g4) pg[g4] = permswap_other(gs[g4]);
#pragma unroll
                    for (int g4 = 3; g4 >= 0; --g4) {
                        float cacc = suf + (hi == 0 ? pg[g4] : 0.f);
#pragma unroll
                        for (int i = 3; i >= 0; --i) { const int r = g4 * 4 + i; cacc += Lr[r]; const float z = sT[kb][r];
                            float a = __builtin_amdgcn_exp2f(z + cacc);
                            if (band) { const int key = kbase + 32 * kb + i + 8 * g4; if (key >= q) a = 0.f; }
                            sT[kb][r] = a; }
                        suf += gs[g4] + pg[g4];
                    }
                }
                carry = suf;
            }
#pragma unroll
            for (int kb = 0; kb < 2; ++kb)
#pragma unroll
                for (int s = 0; s < 2; ++s) { u32x4 w; w.x = cvt_pk_bf16(sT[kb][8 * s + 0], sT[kb][8 * s + 1]); w.y = cvt_pk_bf16(sT[kb][8 * s + 2], sT[kb][8 * s + 3]);
                    w.z = cvt_pk_bf16(sT[kb][8 * s + 4], sT[kb][8 * s + 5]); w.w = cvt_pk_bf16(sT[kb][8 * s + 6], sT[kb][8 * s + 7]); pf[kb][s] = __builtin_bit_cast(bf16x8, w); }
        }
        BG_FENCE(); BG_LD(3); BG_LD(4); BG_LD(5); BG_FENCE();
        if (!skip) {
            {
                bf16x8 af[3];
#define AT_VFRAG(m, dst) do { const MK_LAS unsigned char* _vp = lds + bo + va + (32 * (((m) >> 1) & 1) + 16 * ((m) & 1)) * VSTR + ((m) >> 2) * 64; \
                    const s16x4 _a0 = __builtin_bit_cast(s16x4, __builtin_amdgcn_ds_read_tr16_b64_v4i16((MK_LAS s16x4*)_vp)); \
                    const s16x4 _a1 = __builtin_bit_cast(s16x4, __builtin_amdgcn_ds_read_tr16_b64_v4i16((MK_LAS s16x4*)(_vp + 8 * VSTR))); \
                    dst[0] = _a0[0]; dst[1] = _a0[1]; dst[2] = _a0[2]; dst[3] = _a0[3]; dst[4] = _a1[0]; dst[5] = _a1[1]; dst[6] = _a1[2]; dst[7] = _a1[3]; } while (0)
                AT_VFRAG(0, af[0]); AT_VFRAG(1, af[1]);
                __builtin_amdgcn_sched_barrier(0);
#pragma unroll
                for (int m = 0; m < 16; ++m) {
                    if (m + 2 < 16) AT_VFRAG(m + 2, af[(m + 2) % 3]);
                    __builtin_amdgcn_sched_barrier(0);
                    O[m >> 2] = __builtin_amdgcn_mfma_f32_32x32x16_bf16(af[m % 3], pf[(m >> 1) & 1][m & 1], O[m >> 2], 0, 0, 0);
                    __builtin_amdgcn_sched_barrier(0);
                }
#undef AT_VFRAG
            }
        }
        BG_FENCE(); BG_LD(6); BG_LD(7); BG_FENCE();
#undef BG_LD
#undef BG_FENCE
#ifdef BG_BEGIN
#undef BG_BEGIN
#endif
        if (it + 1 < nt) AT_LWRITE((unsigned)((it + 1) & 1) * BUF);
        if (MODE == 1) { const bool dead = __all(carry < -160.0f); if (lane == 0) flags[(it & 1) * 8 + wid] = dead ? 1u : 0u; }
        __syncthreads();
        if (MODE == 1) {
            const u32x4 f0 = *(const MK_LAS u32x4*)(flags + (it & 1) * 8), f1 = *(const MK_LAS u32x4*)(flags + (it & 1) * 8 + 4);
            if ((f0.x & f0.y & f0.z & f0.w & f1.x & f1.y & f1.z & f1.w) != 0u) break;
        }
    }
#ifdef MK_BGCONV
    if (MODE == 0) bg_store(bgc, lane);
#endif
#undef AT_GLOAD
#undef AT_LWRITE
}

__device__ __forceinline__ void attn_unit_diff(const Frame& F, const bf16_t* __restrict__ proj, bf16_t* __restrict__ mixin, int b, int h, int qb,
                                               const float* __restrict__ relb, const float* __restrict__ lamp, float lam_init, const float* __restrict__ subg BG_PARAM) {
    MK_LAS float* btab = (MK_LAS float*)(F.lds + LDS_BTAB);
    MK_LAS float* misc = (MK_LAS float*)(F.lds + LDS_MISC);
    if (F.tid < 264) { const int m = F.tid / 132, i = F.tid % 132;
        float v = 0.f;
        if (i < 128) v = (relb[(t5_bucket(i) * NH + h) * 2 + m] - relb[(31 * NH + h) * 2 + m]) * LOG2E;
        btab[m * 132 + i] = v; }
    if (F.wave == 7) { float a = lamp[F.lane] * lamp[64 + F.lane], c2 = lamp[128 + F.lane] * lamp[192 + F.lane]; a = wave_sum(a); c2 = wave_sum(c2);
        if (F.lane == 0) misc[4] = expf(a) - expf(c2) + lam_init; }
    __syncthreads();
    const float lam = misc[4];
    const bf16_t* base = proj + (size_t)b * S * INC;
    const int hi = F.lane >> 5, r32 = F.lane & 31;
    f32x16 O[4]; float ls;
    MK_LAS u32x4* stash = (MK_LAS u32x4*)(F.lds + 59392) + F.tid;
    attn_pass<0>(F.lds, base, (2 * h) * 64, 1024 + (2 * h) * 64, 2048 + h * 128, qb, btab, O, ls BG_ARG);
    { const float inv = 1.0f / (ls + permswap_other(ls));
#pragma unroll
        for (int db = 0; db < 4; ++db)
#pragma unroll
            for (int r = 0; r < 16; r += 8) { u32x4 pk;
                pk.x = cvt_pk_bf16(O[db][r] * inv, O[db][r + 1] * inv); pk.y = cvt_pk_bf16(O[db][r + 2] * inv, O[db][r + 3] * inv);
                pk.z = cvt_pk_bf16(O[db][r + 4] * inv, O[db][r + 5] * inv); pk.w = cvt_pk_bf16(O[db][r + 6] * inv, O[db][r + 7] * inv);
                stash[(db * 2 + (r >> 3)) * NTHR] = pk; } }
    attn_pass<0>(F.lds, base, (2 * h + 1) * 64, 1024 + (2 * h + 1) * 64, 2048 + h * 128, qb, btab + 132, O, ls BG_ARG);
    const float inv1 = lam / (ls + permswap_other(ls));
    float ss = 0.f;
#pragma unroll
    for (int db = 0; db < 4; ++db)
#pragma unroll
        for (int r8 = 0; r8 < 16; r8 += 8) { const u32x4 pk = stash[(db * 2 + (r8 >> 3)) * NTHR];
#pragma unroll
            for (int i = 0; i < 4; ++i) { const unsigned w = pk[i]; const int r = r8 + 2 * i;
                const float oa = bf16_lo(w) - O[db][r] * inv1, ob = bf16_hi(w) - O[db][r + 1] * inv1;
                O[db][r] = oa; O[db][r + 1] = ob; ss += oa * oa + ob * ob; } }
    ss += permswap_other(ss);
    const float rn = rsqrtf(ss * (1.0f / 128.0f) + SUBLN_EPS) * (1.0f - lam_init);
    const int q = qb * 256 + F.wave * 32 + r32;
    bf16_t* orow = mixin + (size_t)(b * S + q) * D + h * 128;
#pragma unroll
    for (int db = 0; db < 4; ++db)
#pragma unroll
        for (int g4 = 0; g4 < 4; ++g4) { const int d0 = 32 * db + 8 * g4 + 4 * hi; const f32x4 gv = *(const f32x4*)(subg + d0);
            u32x2 o; o.x = cvt_pk_bf16(O[db][4 * g4] * rn * gv[0], O[db][4 * g4 + 1] * rn * gv[1]); o.y = cvt_pk_bf16(O[db][4 * g4 + 2] * rn * gv[2], O[db][4 * g4 + 3] * rn * gv[3]);
            *(u32x2*)(orow + d0) = o; }
}
__device__ __forceinline__ void attn_unit_sb(const Frame& F, const bf16_t* __restrict__ proj, bf16_t* __restrict__ mixin, int b, int h, int qb) {
    const bf16_t* base = proj + (size_t)b * S * INC;
    const int hi = F.lane >> 5, r32 = F.lane & 31;
    f32x16 O[4]; float ls;
#ifdef MK_BGCONV
    BgConv bgc; bgc.next = BG_ITEMS; bgc.cur = -1; bgc.step = 0; bgc.mode = 0;
#pragma unroll
    for (int j = 0; j < 8; ++j) bgc.p[j] = (f32x2){0.f, 0.f};
#endif
    attn_pass<1>(F.lds, base, 3072 + h * 128, 4096 + h * 128, 5120 + h * 128, qb, nullptr, O, ls BG_ARG);
    const int q = qb * 256 + F.wave * 32 + r32;
    bf16_t* orow = mixin + (size_t)(b * S + q) * D + 1024 + h * 128;
#pragma unroll
    for (int db = 0; db < 4; ++db)
#pragma unroll
        for (int g4 = 0; g4 < 4; ++g4) { const int d0 = 32 * db + 8 * g4 + 4 * hi;
            u32x2 o; o.x = cvt_pk_bf16(O[db][4 * g4], O[db][4 * g4 + 1]); o.y = cvt_pk_bf16(O[db][4 * g4 + 2], O[db][4 * g4 + 3]);
            *(u32x2*)(orow + d0) = o; }
}
__device__ __forceinline__ void phase_attention(const Frame& F, const In& in, const Ws& w, int l, int mask = 3) {
    const float lam_init = 0.8f - 0.6f * expf(-0.3f * (float)l);
#ifdef MK_BGCONV
    BgConv bgc; bgc.wg = in.w_gate + (size_t)l * NE * D * DE; bgc.wu = in.w_up + (size_t)l * NE * D * DE; bgc.wd = in.w_down + (size_t)l * NE * DE * D;
    bgc.tgu = w.wt_gu + (size_t)l * NE * 2048 * D; bgc.td = w.wt_d + (size_t)l * NE * D * DE;
    bgc.next = ((mask & 1) && !(mask & 4)) ? (int)blockIdx.x * NWAVES + F.wave : BG_ITEMS; bgc.step = F.G * NWAVES; bgc.cur = -1; bgc.mode = mask >> 4;
#pragma unroll
    for (int j = 0; j < 8; ++j) bgc.p[j] = (f32x2){0.f, 0.f};
#endif
    for (int it = F.vcu; it < 512; it += F.G) {
        const int sb = it >> 8, i = it & 255, bh = i >> 3, pr = i & 7, b = bh >> 3, h = bh & 7;
        if (!((mask >> sb) & 1)) continue;
        if (!sb) {
            attn_unit_diff(F, w.proj, w.mixin, b, h, 15 - pr, in.relb, in.lam + l * 256, lam_init, in.subg + l * 128 BG_ARG);
            attn_unit_diff(F, w.proj, w.mixin, b, h, pr, in.relb, in.lam + l * 256, lam_init, in.subg + l * 128 BG_ARG);
        } else {
            attn_unit_sb(F, w.proj, w.mixin, b, h, 15 - pr);
            attn_unit_sb(F, w.proj, w.mixin, b, h, pr);
        }
    }
#ifdef MK_BGCONV
    while (bgc.next < BG_ITEMS) { bg_load(bgc, F.lane); bg_store(bgc, F.lane); }
#endif
}

#define ROWF4(base, j) ((f32x4*)((char*)(base) + (((j) < 4) ? of0 : of1) + ((j) & 3) * 1024))
#define ROWH4(base, j) ((u32x2*)((char*)(base) + oh0 + (j) * 512))
__device__ __forceinline__ void phase_router_t(const Frame& F, const In& in, const Ws& w) {
    const int gt = F.vcu * NTHR + F.tid, NGT = F.G * NTHR;
    for (int i = gt; i < DEPTH * 48 * D; i += NGT) { const int l = i / (48 * D), r = i % (48 * D), n = r / D, k = r % D;
        const float v = n < 4 ? in.w_group[((size_t)l * D + k) * 4 + n] : (n < 36 ? in.w_router[((size_t)l * D + k) * 32 + (n - 4)] : 0.f);
        const unsigned hi = cvt_pk_bf16(v, 0.f) & 0xffffu; const float lo = v - __uint_as_float(hi << 16);
        w.wt_rh[i] = (bf16_t)hi; w.wt_rl[i] = (bf16_t)(cvt_pk_bf16(lo, 0.f) & 0xffffu); }
}
__device__ __forceinline__ void phase_ln1_route(const Frame& F, const In& in, const Ws& w, int l) {
    const float* modl = w.mod + (size_t)l * NB * 6 * D;
    const float* lng = in.ln_g + (size_t)(l * 2) * D; const float* lnb = in.ln_b + (size_t)(l * 2) * D;
    const float* xin = l == 0 ? in.x : w.xa;
    const bf16_t* wh = w.wt_rh + (size_t)l * 48 * D; const bf16_t* wlo = w.wt_rl + (size_t)l * 48 * D;
    const float* bg = in.b_group + l * 4; const float* br = in.b_router + l * 32;
#ifdef MK_XCNT
    int* cnt = (int*)(w.ctl + CTL_CNT) + l * 256;
#else
    int* cnt = (int*)(w.ctl + CTL_CNT) + l * 32;
#endif
    MK_LAS float* lg = (MK_LAS float*)F.lds;
    MK_LAS float* part = (MK_LAS float*)(F.lds + 16384);
    for (int pass = F.vcu; pass < M / 64; pass += F.G) {
        const int t0 = pass * 64;
#ifdef MK_LNPAR
        { const float* mbp = modl + (size_t)(t0 / S) * 6 * D; MK_LAS f32x4* pl = (MK_LAS f32x4*)(F.lds + 40960);
          __syncthreads();
          pl[F.tid] = *(const f32x4*)(mbp + 2 * D + F.tid * 4); pl[512 + F.tid] = *(const f32x4*)(lng + F.tid * 4); pl[1024 + F.tid] = *(const f32x4*)(lnb + F.tid * 4);
          pl[1536 + F.tid] = *(const f32x4*)(mbp + 3 * D + F.tid * 4); pl[2048 + F.tid] = *(const f32x4*)(mbp + 4 * D + F.tid * 4);
          __syncthreads(); }
#define PARL(k, j) (*(const MK_LAS f32x4*)(F.lds + 40960 + (k) * 8192 + F.lane * 16 + (j) * 1024))
#endif
        {
            const int tw = t0 + F.wave * 8;
            const float* mb = modl + (size_t)(tw / S) * 6 * D;
            const unsigned of0 = (unsigned)F.lane * 16u, of1 = of0 + 4096u, oh0 = (unsigned)F.lane * 8u;
            f32x4 xv[8]; u32x2 mv[8];
#ifdef MK_BF16RES
            u32x2 xh[8];
            const bf16_t* xinh = (const bf16_t*)w.xa;
#define LN1_LOADX(t_) do { if (l == 0) { const float* xr = xin + (size_t)(t_) * D; _Pragma("unroll") for (int j = 0; j < 8; ++j) xv[j] = *ROWF4(xr, j); } \
                           else { const bf16_t* xr = xinh + (size_t)(t_) * D; _Pragma("unroll") for (int j = 0; j < 8; ++j) xh[j] = *ROWH4(xr, j); } } while (0)
#define LN1_X(j) (l == 0 ? xv[j] : (f32x4){bf16_lo(xh[j].x), bf16_hi(xh[j].x), bf16_lo(xh[j].y), bf16_hi(xh[j].y)})
#else
#define LN1_LOADX(t_) do { const float* xr = xin + (size_t)(t_) * D; _Pragma("unroll") for (int j = 0; j < 8; ++j) xv[j] = *ROWF4(xr, j); } while (0)
#define LN1_X(j) xv[j]
#endif
            { const bf16_t* mr = w.mixb + (size_t)tw * D; LN1_LOADX(tw);
#pragma unroll
              for (int j = 0; j < 8; ++j) { mv[j] = *ROWH4(mr, j); } }
#pragma unroll 1
            for (int i = 0; i < 8; ++i) {
                const int t = tw + i;
                f32x4 v[8]; float s = 0.f;
#pragma unroll
#ifdef MK_LNPAR
                for (int j = 0; j < 8; ++j) { const f32x4 g1 = PARL(0, j) + 1.0f;
#else
                for (int j = 0; j < 8; ++j) { const f32x4 g1 = *ROWF4(mb + 2 * D, j) + 1.0f;
#endif
                    f32x4 mx; mx[0] = bf16_lo(mv[j].x); mx[1] = bf16_hi(mv[j].x); mx[2] = bf16_lo(mv[j].y); mx[3] = bf16_hi(mv[j].y);
                    v[j] = LN1_X(j) * ALPHA + g1 * mx; s += (v[j][0] + v[j][1]) + (v[j][2] + v[j][3]); }
                if (i < 7) {
                    const bf16_t* mr = w.mixb + (size_t)(t + 1) * D; LN1_LOADX(t + 1);
#pragma unroll
                    for (int j = 0; j < 8; ++j) { mv[j] = *ROWH4(mr, j); }
                }
                const float mu = wave_sum(s) * (1.0f / D);
                float s2 = 0.f;
#pragma unroll
                for (int j = 0; j < 8; ++j) { v[j] = v[j] - mu; s2 += (v[j][0] * v[j][0] + v[j][1] * v[j][1]) + (v[j][2] * v[j][2] + v[j][3] * v[j][3]); }
                const float rs = rsqrtf(wave_sum(s2) * (1.0f / D) + LN_EPS);
                float* x1r = w.x1 + (size_t)t * D; bf16_t* abr = w.ab + (size_t)t * D; bf16_t* alr = w.ablo + (size_t)t * D;
#pragma unroll
                for (int j = 0; j < 8; ++j) {
#ifdef MK_LNPAR
                    const f32x4 gg = PARL(1, j), bb = PARL(2, j);
#else
                    const f32x4 gg = *ROWF4(lng, j), bb = *ROWF4(lnb, j);
#endif
                    const f32x4 xo = v[j] * rs * gg + bb;
#ifdef MK_BF16RES
                    { u32x2 xp; xp.x = cvt_pk_bf16(xo[0], xo[1]); xp.y = cvt_pk_bf16(xo[2], xo[3]); *ROWH4((bf16_t*)w.x1 + (size_t)t * D, j) = xp; }
#else
                    *ROWF4(x1r, j) = xo;
#endif
#ifdef MK_LNPAR
                    const f32x4 sh = PARL(3, j), scv = PARL(4, j);
#else
                    const f32x4 sh = *ROWF4(mb + 3 * D, j), scv = *ROWF4(mb + 4 * D, j);
#endif
                    const f32x4 u = xo * (scv + 1.0f) + sh;
                    u32x2 o; o.x = cvt_pk_bf16(u[0], u[1]); o.y = cvt_pk_bf16(u[2], u[3]);
                    *ROWH4(abr, j) = o;
                    u32x2 ol; ol.x = cvt_pk_bf16(u[0] - bf16_lo(o.x), u[1] - bf16_hi(o.x)); ol.y = cvt_pk_bf16(u[2] - bf16_lo(o.y), u[3] - bf16_hi(o.y));
                    *ROWH4(alr, j) = ol; }
            }
        }
#undef LN1_LOADX
#undef LN1_X
        asm volatile("s_waitcnt vmcnt(0)" ::: "memory");
        __syncthreads();
#ifdef MK_ROUTK
        {
            const int fr = F.lane & 15, fq = F.lane >> 4, kbase = F.wave * 256 + fq * 8;
            const bf16_t* ah = w.ab + (size_t)(t0 + fr) * D + kbase;
            const bf16_t* al = w.ablo + (size_t)(t0 + fr) * D + kbase;
            const bf16_t* bh = wh + (size_t)fr * D + kbase;
            const bf16_t* bl = wlo + (size_t)fr * D + kbase;
            f32x4 acc[4][3];
#pragma unroll
            for (int rt = 0; rt < 4; ++rt)
#pragma unroll
                for (int nt = 0; nt < 3; ++nt) acc[rt][nt] = (f32x4){0.f, 0.f, 0.f, 0.f};
#pragma unroll 2
            for (int sidx = 0; sidx < 8; ++sidx) {
                bf16x8 fbh[3], fbl[3];
#pragma unroll
                for (int nt = 0; nt < 3; ++nt) { fbh[nt] = *(const bf16x8*)(bh + (size_t)nt * 16 * D + sidx * 32); fbl[nt] = *(const bf16x8*)(bl + (size_t)nt * 16 * D + sidx * 32); }
#pragma unroll
                for (int rt = 0; rt < 4; ++rt) { const bf16x8 fah = *(const bf16x8*)(ah + (size_t)rt * 16 * D + sidx * 32), fal = *(const bf16x8*)(al + (size_t)rt * 16 * D + sidx * 32);
#pragma unroll
                    for (int nt = 0; nt < 3; ++nt) {
                        acc[rt][nt] = __builtin_amdgcn_mfma_f32_16x16x32_bf16(fah, fbh[nt], acc[rt][nt], 0, 0, 0);
                        acc[rt][nt] = __builtin_amdgcn_mfma_f32_16x16x32_bf16(fah, fbl[nt], acc[rt][nt], 0, 0, 0);
                        acc[rt][nt] = __builtin_amdgcn_mfma_f32_16x16x32_bf16(fal, fbh[nt], acc[rt][nt], 0, 0, 0); } }
            }
            MK_LAS f32x4* red = (MK_LAS f32x4*)(F.lds + 16384);
#pragma unroll
            for (int rt = 0; rt < 4; ++rt)
#pragma unroll
                for (int nt = 0; nt < 3; ++nt) red[(F.wave * 12 + rt * 3 + nt) * 64 + F.lane] = acc[rt][nt];
            __syncthreads();
            for (int idx = F.tid; idx < 768; idx += NTHR) { const int tile = idx >> 6, ln = idx & 63, rt = tile / 3, nt = tile - rt * 3, lfr = ln & 15, lfq = ln >> 4;
                f32x4 o = red[tile * 64 + ln];
#pragma unroll
                for (int wv = 1; wv < 8; ++wv) o += red[(wv * 12 + tile) * 64 + ln];
#pragma unroll
                for (int r = 0; r < 4; ++r) lg[(rt * 16 + lfq * 4 + r) * 49 + nt * 16 + lfr] = o[r]; }
            __syncthreads();
        }
#else
        {
            const int rt = F.wave & 3, kh = F.wave >> 2, fr = F.lane & 15, fq = F.lane >> 4;
            const bf16_t* ah = w.ab + (size_t)(t0 + rt * 16 + fr) * D + kh * 1024 + fq * 8;
            const bf16_t* al = w.ablo + (size_t)(t0 + rt * 16 + fr) * D + kh * 1024 + fq * 8;
            const bf16_t* bh = wh + (size_t)fr * D + kh * 1024 + fq * 8;
            const bf16_t* bl = wlo + (size_t)fr * D + kh * 1024 + fq * 8;
            f32x4 acc[3];
#pragma unroll
            for (int nt = 0; nt < 3; ++nt) acc[nt] = (f32x4){0.f, 0.f, 0.f, 0.f};
#pragma unroll 4
            for (int sidx = 0; sidx < 32; ++sidx) {
                const bf16x8 fah = *(const bf16x8*)(ah + sidx * 32), fal = *(const bf16x8*)(al + sidx * 32);
#pragma unroll
                for (int nt = 0; nt < 3; ++nt) { const bf16x8 fbh = *(const bf16x8*)(bh + (size_t)nt * 16 * D + sidx * 32), fbl = *(const bf16x8*)(bl + (size_t)nt * 16 * D + sidx * 32);
                    acc[nt] = __builtin_amdgcn_mfma_f32_16x16x32_bf16(fah, fbh, acc[nt], 0, 0, 0);
                    acc[nt] = __builtin_amdgcn_mfma_f32_16x16x32_bf16(fah, fbl, acc[nt], 0, 0, 0);
                    acc[nt] = __builtin_amdgcn_mfma_f32_16x16x32_bf16(fal, fbh, acc[nt], 0, 0, 0); }
            }
            if (kh == 1) {
#pragma unroll
                for (int nt = 0; nt < 3; ++nt) *(MK_LAS f32x4*)(part + ((rt * 3 + nt) * 64 + F.lane) * 4) = acc[nt];
            }
            __syncthreads();
            if (kh == 0) {
#pragma unroll
                for (int nt = 0; nt < 3; ++nt) { const f32x4 o = acc[nt] + *(const MK_LAS f32x4*)(part + ((rt * 3 + nt) * 64 + F.lane) * 4);
#pragma unroll
                    for (int r = 0; r < 4; ++r) lg[(rt * 16 + fq * 4 + r) * 49 + nt * 16 + fr] = o[r]; }
            }
            __syncthreads();
        }
#endif
        if (F.tid < 64) {
            const int t = t0 + F.tid; const MK_LAS float* lr = lg + F.tid * 49;
            float gl[4]; int gi = 0;
#pragma unroll
            for (int i = 0; i < 4; ++i) gl[i] = lr[i] + bg[i];
            float gm = gl[0];
#pragma unroll
            for (int i = 1; i < 4; ++i) if (gl[i] > gm) { gm = gl[i]; gi = i; }
            float gsum = 0.f;
#pragma unroll
            for (int i = 0; i < 4; ++i) gsum += expf(gl[i] - gm);
            const float gp = 1.0f / gsum;
            float el[8];
#pragma unroll
            for (int j = 0; j < 8; ++j) el[j] = lr[4 + gi * 8 + j] + br[gi * 8 + j];
            int i0 = 0; float v0 = el[0];
#pragma unroll
            for (int j = 1; j < 8; ++j) if (el[j] > v0) { v0 = el[j]; i0 = j; }
            int i1 = 0; float v1 = -INFINITY;
#pragma unroll
            for (int j = 0; j < 8; ++j) if (j != i0 && el[j] > v1) { v1 = el[j]; i1 = j; }
            const float e1 = expf(v1 - v0);
            const float w0 = gp / (1.0f + e1), w1 = gp * e1 / (1.0f + e1);
            const int ea = gi * 8 + i0, eb = gi * 8 + i1;
#ifdef MK_RANKAGG
            MK_LAS int* hist = (MK_LAS int*)(F.lds + 32768);
            if (F.tid < 32) hist[F.tid] = 0;
            asm volatile("s_waitcnt lgkmcnt(0)" ::: "memory"); __builtin_amdgcn_wave_barrier();
            const int la = __atomic_fetch_add(hist + ea, 1, __ATOMIC_RELAXED), lb = __atomic_fetch_add(hist + eb, 1, __ATOMIC_RELAXED);
            asm volatile("s_waitcnt lgkmcnt(0)" ::: "memory"); __builtin_amdgcn_wave_barrier();
#ifdef MK_XCNT
            if (F.tid < 32) { const int c = hist[F.tid]; hist[32 + F.tid] = c ? atomicAdd(&cnt[(t0 >> 11) * 32 + F.tid], c) : 0; }
#else
            if (F.tid < 32) { const int c = hist[F.tid]; hist[32 + F.tid] = c ? atomicAdd(&cnt[F.tid], c) : 0; }
#endif
            asm volatile("s_waitcnt vmcnt(0) lgkmcnt(0)" ::: "memory"); __builtin_amdgcn_wave_barrier();
            const int ra = hist[32 + ea] + la, rb = hist[32 + eb] + lb;
#else
            const int ra = atomicAdd(&cnt[ea], 1), rb = atomicAdd(&cnt[eb], 1);
#endif
#ifdef MK_XCNT
            w.tok_of[(ea * 8 + (t >> 11)) * 2048 + ra] = t; w.tok_of[(eb * 8 + (t >> 11)) * 2048 + rb] = t;
#else
            w.tok_of[ea * M + ra] = t; w.tok_of[eb * M + rb] = t;
#endif
            *(int4*)(w.tokinfo + 4 * t) = make_int4(ea, ra, eb, rb);
            *(float2*)(w.tokw + 2 * t) = make_float2(w0, w1);
        }
        __syncthreads();
    }
}

__device__ __forceinline__ void moe_tables(const Frame& F, const Ws& w, int l) {
    MK_LAS int* pexp = (MK_LAS int*)(F.lds + LDS_PEXP);
    MK_LAS int* pbase = (MK_LAS int*)(F.lds + LDS_PBASE);
    MK_LAS int* cl = (MK_LAS int*)(F.lds + LDS_CNT);
#ifdef MK_XCNT
    const int* cnt = (const int*)(w.ctl + CTL_CNT) + l * 256;
    MK_LAS unsigned short* xoff = (MK_LAS unsigned short*)(F.lds + LDS_XOFF);
    __syncthreads();
    if (F.tid < 32) { int cx[8];
#pragma unroll
        for (int x = 0; x < 8; ++x) cx[x] = cnt[x * 32 + F.tid];
        int p = 0;
#pragma unroll
        for (int x = 0; x < 8; ++x) { xoff[F.tid * 8 + x] = (unsigned short)p; p += cx[x]; }
        cl[F.tid] = p; }
#else
    const int* cnt = (const int*)(w.ctl + CTL_CNT) + l * 32;
    __syncthreads();
    if (F.tid < 32) cl[F.tid] = cnt[F.tid];
#endif
    __syncthreads();
    if (F.tid == 0) { int p = 0; for (int e = 0; e < NE; ++e) { pbase[e] = p; const int np = (cl[e] + 255) >> 8; for (int i = 0; i < np; ++i) pexp[p + i] = e; p += np; } pbase[NE] = p; }
    __syncthreads();
}
template <class Sched>
__device__ __forceinline__ void moe_gather_table(const Frame& F, const Ws& w, const Sched& Sc) {
    MK_LAS int* tokl = (MK_LAS int*)(F.lds + LDS_TOKL);
    const MK_LAS int* pbase = (const MK_LAS int*)(F.lds + LDS_PBASE);
    const MK_LAS int* cl = (const MK_LAS int*)(F.lds + LDS_CNT);
    for (int i = 0; i < MAXU; ++i) { Unit u; if (!Sc.next(i, u)) break;
        if (F.tid < 256) { const int e = u.e; int rank = (u.pm - pbase[e]) * 256 + F.tid; const int ce = cl[e]; rank = rank < ce ? rank : ce - 1;
#ifdef MK_XCNT
            const MK_LAS unsigned short* xo = (const MK_LAS unsigned short*)(F.lds + LDS_XOFF) + e * 8;
            int x = 0;
#pragma unroll
            for (int k = 1; k < 8; ++k) x += (rank >= (int)xo[k]) ? 1 : 0;
            tokl[i * 256 + F.tid] = w.tok_of[(e * 8 + x) * 2048 + rank - (int)xo[x]]; } }
#else
            tokl[i * 256 + F.tid] = w.tok_of[e * M + rank]; } }
#endif
    __syncthreads();
}

__device__ __forceinline__ void phase_ln2(const Frame& F, const In& in, const Ws& w, int l, float* __restrict__ xout, const float* __restrict__ nmod) {
    const float* modl = w.mod + (size_t)l * NB * 6 * D;
    const float* lng = in.ln_g + (size_t)(l * 2 + 1) * D; const float* lnb = in.ln_b + (size_t)(l * 2 + 1) * D;
    const MK_LAS int* pbase = (const MK_LAS int*)(F.lds + LDS_PBASE);
    const int gw = F.vcu * NWAVES + F.wave, NGW = F.G * NWAVES;
    const unsigned of0 = (unsigned)F.lane * 16u, of1 = of0 + 4096u, oh0 = (unsigned)F.lane * 8u;
    for (int tb = gw * 8; tb < M; tb += NGW * 8) {
        const int bidx = tb / S;
        const float* mb = modl + (size_t)bidx * 6 * D;
#ifdef MK_LNPAR
        { MK_LAS f32x4* pl = (MK_LAS f32x4*)(F.lds + 40960);
          __syncthreads();
          pl[F.tid] = *(const f32x4*)(mb + 5 * D + F.tid * 4); pl[512 + F.tid] = *(const f32x4*)(lng + F.tid * 4); pl[1024 + F.tid] = *(const f32x4*)(lnb + F.tid * 4);
          if (nmod) { const float* nbp = nmod + (size_t)bidx * 6 * D; pl[1536 + F.tid] = *(const f32x4*)(nbp + F.tid * 4); pl[2048 + F.tid] = *(const f32x4*)(nbp + D + F.tid * 4); }
          __syncthreads(); }
#ifndef PARL
#define PARL(k, j) (*(const MK_LAS f32x4*)(F.lds + 40960 + (k) * 8192 + F.lane * 16 + (j) * 1024))
#endif
#endif
#ifdef MK_BF16RES
        u32x2 xv[8], ya[8], yb[8]; float2 tw, tw_n;
#define LN2_LOADX(_xr, j) xv[j] = *ROWH4((const bf16_t*)w.x1 + (size_t)(_xr) * D, j)
#define LN2_X(j) ((f32x4){bf16_lo(xv[j].x), bf16_hi(xv[j].x), bf16_lo(xv[j].y), bf16_hi(xv[j].y)})
#else
        f32x4 xv[8]; u32x2 ya[8], yb[8]; float2 tw, tw_n;
#define LN2_LOADX(_xr, j) xv[j] = *ROWF4(w.x1 + (size_t)(_xr) * D, j)
#define LN2_X(j) xv[j]
#endif
#ifdef MK_XCNT
#define LN2_XOFF(e_, t_) ((int)((const MK_LAS unsigned short*)(F.lds + LDS_XOFF))[(e_) * 8 + ((t_) >> 11)])
#else
#define LN2_XOFF(e_, t_) 0
#endif
#define LN2_FETCH(t) do { const int4 _ti = *(const int4*)(w.tokinfo + 4 * (t)); tw_n = *(const float2*)(w.tokw + 2 * (t)); \
            const int _r0 = __builtin_amdgcn_readfirstlane(pbase[_ti.x] * 256 + _ti.y + LN2_XOFF(_ti.x, t)), _r1 = __builtin_amdgcn_readfirstlane(pbase[_ti.z] * 256 + _ti.w + LN2_XOFF(_ti.z, t)); \
            const bf16_t* _y0 = w.Yb + (size_t)_r0 * D; const bf16_t* _y1 = w.Yb + (size_t)_r1 * D; \
            _Pragma("unroll") for (int j = 0; j < 8; ++j) { LN2_LOADX(t, j); ya[j] = *ROWH4(_y0, j); yb[j] = *ROWH4(_y1, j); } } while (0)
        LN2_FETCH(tb); tw = tw_n;
#pragma unroll 1
        for (int i = 0; i < 8; ++i) {
            const int t = tb + i;
            f32x4 v[8]; float s = 0.f;
#pragma unroll
            for (int j = 0; j < 8; ++j) {
                const u32x2 a = ya[j], c2 = yb[j];
                f32x4 y; y[0] = tw.x * bf16_lo(a.x) + tw.y * bf16_lo(c2.x); y[1] = tw.x * bf16_hi(a.x) + tw.y * bf16_hi(c2.x);
                y[2] = tw.x * bf16_lo(a.y) + tw.y * bf16_lo(c2.y); y[3] = tw.x * bf16_hi(a.y) + tw.y * bf16_hi(c2.y);
#ifdef MK_LNPAR
                const f32x4 g2 = PARL(0, j) + 1.0f;
#else
                const f32x4 g2 = *ROWF4(mb + 5 * D, j) + 1.0f;
#endif
                v[j] = LN2_X(j) * ALPHA + g2 * y;
                s += (v[j][0] + v[j][1]) + (v[j][2] + v[j][3]); }
            if (i < 7) { LN2_FETCH(t + 1); }
            const float mu = wave_sum(s) * (1.0f / D);
            float s2 = 0.f;
#pragma unroll
            for (int j = 0; j < 8; ++j) { v[j] = v[j] - mu; s2 += (v[j][0] * v[j][0] + v[j][1] * v[j][1]) + (v[j][2] * v[j][2] + v[j][3] * v[j][3]); }
            const float rs = rsqrtf(wave_sum(s2) * (1.0f / D) + LN_EPS);
            float* xor_ = xout + (size_t)t * D; bf16_t* abr = w.ab + (size_t)t * D;
#pragma unroll
            for (int j = 0; j < 8; ++j) {
#ifdef MK_LNPAR
                const f32x4 gg = PARL(1, j), bb = PARL(2, j);
#else
                const f32x4 gg = *ROWF4(lng, j), bb = *ROWF4(lnb, j);
#endif
                const f32x4 xo = v[j] * rs * gg + bb;
#ifdef MK_BF16RES
                if (nmod) { u32x2 xp; xp.x = cvt_pk_bf16(xo[0], xo[1]); xp.y = cvt_pk_bf16(xo[2], xo[3]); *ROWH4((bf16_t*)xout + (size_t)t * D, j) = xp; }
                else *ROWF4(xor_, j) = xo;
#else
                *ROWF4(xor_, j) = xo;
#endif
#ifdef MK_LNPAR
                if (nmod) { const f32x4 sh = PARL(3, j), scv = PARL(4, j);
#else
                if (nmod) { const float* nb = nmod + (size_t)bidx * 6 * D; const f32x4 sh = *ROWF4(nb, j), scv = *ROWF4(nb + D, j);
#endif
                    const f32x4 u = xo * (scv + 1.0f) + sh; u32x2 o; o.x = cvt_pk_bf16(u[0], u[1]); o.y = cvt_pk_bf16(u[2], u[3]); *ROWH4(abr, j) = o; }
            }
            tw = tw_n;
        }
#undef LN2_FETCH
#undef LN2_XOFF
#undef LN2_LOADX
#undef LN2_X
    }
}
struct Args { In in; Ws w; float* out; int l, cv_lo, cv_hi, pad; };

__device__ __forceinline__ Frame make_frame(unsigned char* lds_generic) {
    Frame F; F.lds = (MK_LAS unsigned char*)lds_generic;
    F.tid = ltid(); F.lane = F.tid & 63; F.wave = __builtin_amdgcn_readfirstlane(F.tid >> 6);
    F.G = gridDim.x; { const int bx = blockIdx.x; F.vcu = (F.G % 8 == 0) ? (bx % 8) * (F.G / 8) + bx / 8 : bx; }
    return F;
}

template <int PH>
__device__ __forceinline__ void run_phase(const Frame& F, const Args& a, int l) {
    const In& in = a.in; const Ws& w = a.w;
    if constexpr (PH == 0) { phase_convert(F, in, w, a.cv_lo, a.cv_hi); phase_mod(F, in, w); phase_router_t(F, in, w); }
    if constexpr (PH == 1) { phase_modulate(F, in.x, w.mod, w.ab); }
    if constexpr (PH == 2) { SchedDense Sd; Sd.init(w.ab, w.wt_in + (size_t)l * INC * D, M, INC, D, F.G, (int)blockIdx.x); EpiProj E{w.proj}; gemm_phase(F.lds, D, Sd, E); }
    if constexpr (PH == 3) { phase_attention(F, in, w, l); }
    if constexpr (PH == 31) { phase_attention(F, in, w, l, 1); }
    if constexpr (PH == 32) { phase_attention(F, in, w, l, 2); }
    if constexpr (PH == 34) { phase_attention(F, in, w, l, 3 | 16); }
    if constexpr (PH == 35) { phase_attention(F, in, w, l, 3 | 32); }
    if constexpr (PH == 33) { phase_attention(F, in, w, l, 7); }
    if constexpr (PH == 4) { SchedDense Sd; Sd.init(w.mixin, w.wt_o + (size_t)l * D * D, M, D, D, F.G, (int)blockIdx.x);
        EpiDown E{w.mixb}; gemm_phase(F.lds, D, Sd, E); }
    if constexpr (PH == 5) { phase_ln1_route(F, in, w, l); }
    if constexpr (PH == 6) { moe_tables(F, w, l);
        SchedMoe<true> Sm; Sm.A = w.ab; Sm.Bt = w.wt_gu + (size_t)l * NE * 2048 * D; Sm.estride = (size_t)2048 * D; Sm.K = D;
        Sm.nunits = ((const MK_LAS int*)(F.lds + LDS_PBASE))[NE] * 8; Sm.G = F.G; Sm.c = (int)blockIdx.x;
        Sm.pexp = (const MK_LAS int*)(F.lds + LDS_PEXP); Sm.tokl = (const MK_LAS int*)(F.lds + LDS_TOKL);
        moe_gather_table(F, w, Sm);
#ifdef MK_F32B_UP
        BSrcUp Bu{in.w_gate + (size_t)l * NE * D * DE, in.w_up + (size_t)l * NE * D * DE, (size_t)D * DE, DE};
        EpiGU E{w.Hb}; gemm_phase_fb(F.lds, D, Sm, Bu, E); }
#else
        EpiGU E{w.Hb}; gemm_phase(F.lds, D, Sm, E); }
#endif
    if constexpr (PH >= 60 && PH <= 69) { moe_tables(F, w, l);
        SchedMoe<true> Sm; Sm.A = w.ab; Sm.Bt = w.wt_gu + (size_t)l * NE * 2048 * D; Sm.estride = (size_t)2048 * D; Sm.K = D;
        Sm.nunits = ((const MK_LAS int*)(F.lds + LDS_PBASE))[NE] * 8; Sm.G = F.G; Sm.c = (int)blockIdx.x;
        Sm.pexp = (const MK_LAS int*)(F.lds + LDS_PEXP); Sm.tokl = (const MK_LAS int*)(F.lds + LDS_TOKL);
        moe_gather_table(F, w, Sm);
        BSrcUp Bu{in.w_gate + (size_t)l * NE * D * DE, in.w_up + (size_t)l * NE * D * DE, (size_t)D * DE, DE};
        EpiGU E{w.wt_gu}; gemm_phase_fb<PH - 60>(F.lds, D, Sm, Bu, E); }
    if constexpr (PH >= 70 && PH <= 79) { moe_tables(F, w, l);
        SchedMoe<false> Sm; Sm.A = w.Hb; Sm.Bt = w.wt_d + (size_t)l * NE * D * DE; Sm.estride = (size_t)D * DE; Sm.K = DE;
        Sm.nunits = ((const MK_LAS int*)(F.lds + LDS_PBASE))[NE] * 8; Sm.G = F.G; Sm.c = (int)blockIdx.x;
        Sm.pexp = (const MK_LAS int*)(F.lds + LDS_PEXP); Sm.tokl = nullptr;
        BSrcDown Bd{in.w_down + (size_t)l * NE * DE * D, (size_t)DE * D, D};
        EpiDown E{w.wt_gu}; gemm_phase_fb<PH - 70>(F.lds, DE, Sm, Bd, E); }
    if constexpr (PH == 7) { moe_tables(F, w, l);
        SchedMoe<false> Sm; Sm.A = w.Hb; Sm.Bt = w.wt_d + (size_t)l * NE * D * DE; Sm.estride = (size_t)D * DE; Sm.K = DE;
        Sm.nunits = ((const MK_LAS int*)(F.lds + LDS_PBASE))[NE] * 8; Sm.G = F.G; Sm.c = (int)blockIdx.x;
        Sm.pexp = (const MK_LAS int*)(F.lds + LDS_PEXP); Sm.tokl = nullptr;
#ifdef MK_F32B_DOWN
        BSrcDown Bd{in.w_down + (size_t)l * NE * DE * D, (size_t)DE * D, D};
        EpiDown E{w.Yb}; gemm_phase_fb(F.lds, DE, Sm, Bd, E); }
#else
        EpiDown E{w.Yb}; gemm_phase(F.lds, DE, Sm, E); }
#endif
    if constexpr (PH == 8) { moe_tables(F, w, l);
        phase_ln2(F, in, w, l, l == DEPTH - 1 ? a.out : w.xa, l == DEPTH - 1 ? nullptr : w.mod + (size_t)(l + 1) * NB * 6 * D); }
}

template <int PH>
__global__ void __launch_bounds__(NTHR, 2) k_phase(Args a) {
    extern __shared__ __attribute__((aligned(16))) unsigned char lds_raw[];
    const Frame F = make_frame(lds_raw);
    run_phase<PH>(F, a, a.l);
}

static inline Ws carve(char* base, size_t& end, int nlw = DEPTH) {
    Ws w; size_t o = 0;
    auto take = [&](size_t bytes) { char* p = base + o; o += (bytes + 255) & ~(size_t)255; return p; };
    w.ctl = (unsigned*)take((size_t)CTL_WORDS * 4);
    w.mod = (float*)take((size_t)DEPTH * NB * 6 * D * 4);
    w.wt_in = (bf16_t*)take((size_t)nlw * INC * D * 2);
    w.wt_o = (bf16_t*)take((size_t)nlw * D * D * 2);
    w.ab = (bf16_t*)take((size_t)M * D * 2);
    w.proj = (bf16_t*)take((size_t)M * INC * 2);
    w.mixin = (bf16_t*)take((size_t)M * D * 2);
    w.mixb = (bf16_t*)take((size_t)M * D * 2);
    w.ablo = (bf16_t*)take((size_t)M * D * 2);
    w.x1 = (float*)take((size_t)M * D * 4);
    w.xa = (float*)take((size_t)M * D * 4);
    w.Hb = (bf16_t*)take((size_t)PROWS * DE * 2);
    w.Yb = (bf16_t*)take((size_t)PROWS * D * 2);
    w.tok_of = (int*)take((size_t)NE * M * 4);
    w.tokinfo = (int*)take((size_t)M * 16);
    w.tokw = (float*)take((size_t)M * 8);
    w.wt_rh = (bf16_t*)take((size_t)DEPTH * 48 * D * 2);
    w.wt_rl = (bf16_t*)take((size_t)DEPTH * 48 * D * 2);
    w.wt_gu = (bf16_t*)take((size_t)nlw * NE * 2048 * D * 2);
    w.wt_d = (bf16_t*)take((size_t)nlw * NE * D * DE * 2);
    end = o; return w;
}
static inline In make_in(void* const* d_in) {
    In in; const float* const* p = (const float* const*)d_in;
    in.x = p[0]; in.c = p[1]; in.w_ada = p[2]; in.b_ada = p[3]; in.w_in = p[4]; in.lam = p[5]; in.subg = p[6]; in.relb = p[7]; in.w_o = p[8]; in.ln_g = p[9]; in.ln_b = p[10];
    in.w_group = p[11]; in.b_group = p[12]; in.w_router = p[13]; in.b_router = p[14]; in.w_gate = p[15]; in.w_up = p[16]; in.w_down = p[17];
    return in;
}
template <int PH>
static inline void launch_phase(const Args& a, int grid, hipStream_t st) {
    static bool attr = false;
    if (!attr) { attr = true; (void)hipFuncSetAttribute((const void*)k_phase<PH>, hipFuncAttributeMaxDynamicSharedMemorySize, LDS_BYTES); }
    hipLaunchKernelGGL(k_phase<PH>, dim3(grid), dim3(NTHR), LDS_BYTES, st, a);
}
}
namespace mk {
typedef const __attribute__((address_space(4))) Args* KArgsPtr;
__device__ __forceinline__ void load_args(Args& a) {
    KArgsPtr p = (KArgsPtr)__builtin_amdgcn_kernarg_segment_ptr();
    asm volatile("" : "+s"(p));
    __builtin_memcpy(&a, p, sizeof(Args));
}
#ifndef MK_REPEAT_PH
#define MK_REPEAT_PH -1
#endif
#define MK_PHASE1(PH, l) do { Args _a; load_args(_a); const Frame _F = make_frame(lds_raw); run_phase<PH>(_F, _a, (l)); } while (0)
#ifndef MK_REPEAT_AS
#define MK_REPEAT_AS MK_REPEAT_PH
#endif
#ifndef MK_REPEAT_N
#define MK_REPEAT_N 1
#endif
#define MK_PHASE(PH, l) do { MK_PHASE1(PH, l); if ((PH) == MK_REPEAT_PH && (l) == 0) { MK_BARRIER(); MK_PHASE1(MK_REPEAT_AS, l); if (MK_REPEAT_N > 1) { MK_BARRIER(); MK_PHASE1(MK_REPEAT_AS, l); } } } while (0)
#define MK_BARRIER() do { Args _a; load_args(_a); XcdBarrier _b; _b.bar = _a.w.ctl; _b.x = xb_xcc_id(); _b.st = (volatile LAS unsigned*)(F.lds + LDS_MISC); xcd_barrier(_b); } while (0)
__global__ void __launch_bounds__(NTHR, 2) k_mega(Args a) {
    extern __shared__ __attribute__((aligned(16))) unsigned char lds_raw[];
    const Frame F = make_frame(lds_raw);
    if (F.tid < 16) ((MK_LAS unsigned*)(F.lds + LDS_MISC))[F.tid] = 0u;
    __syncthreads();
    (void)xcd_barrier_post(a.w.ctl, (volatile LAS unsigned*)(F.lds + LDS_MISC));
    MK_PHASE(0, 0); MK_BARRIER();
    MK_PHASE(1, 0); MK_BARRIER();
#define MK_LAYER(l, last) do { \
        MK_PHASE(2, l); MK_BARRIER(); MK_PHASE(3, l); MK_BARRIER(); MK_PHASE(4, l); MK_BARRIER(); MK_PHASE(5, l); MK_BARRIER(); \
        MK_PHASE(6, l); MK_BARRIER(); MK_PHASE(7, l); MK_BARRIER(); MK_PHASE(8, l); if (!(last)) MK_BARRIER(); } while (0)
    MK_LAYER(0, false);
    MK_LAYER(1, true);
}
}

extern "C" void kernel_launch(void* const* d_in, const int* in_sizes, int n_in, void* d_out, int out_size, void* d_ws, size_t ws_size, hipStream_t stream) {
    static int grid = 0;
    if (grid == 0) {
        int dev = 0, cus = 0, per_cu = 0;
        (void)hipGetDevice(&dev); (void)hipDeviceGetAttribute(&cus, hipDeviceAttributeMultiprocessorCount, dev);
        if (hipFuncSetAttribute((const void*)mk::k_mega, hipFuncAttributeMaxDynamicSharedMemorySize, mk::LDS_BYTES) != hipSuccess) { fprintf(stderr, "kernel_launch: hipFuncSetAttribute failed\n"); grid = -1; return; }
        if (hipOccupancyMaxActiveBlocksPerMultiprocessor(&per_cu, (const void*)mk::k_mega, mk::NTHR, mk::LDS_BYTES) != hipSuccess || per_cu < 1)
            fprintf(stderr, "kernel_launch: occupancy query reports %d workgroups per CU\n", per_cu);
        (void)hipGetLastError();
        grid = cus > 0 ? cus : 256;
    }
    if (grid < 0) return;
    size_t end = 0;
    mk::Ws w = mk::carve((char*)d_ws, end, mk::DEPTH);
    if (end > ws_size) { fprintf(stderr, "kernel_launch: workspace too small: need %zu, have %zu\n", end, ws_size); return; }
    (void)hipMemsetAsync(w.ctl, 0, (size_t)mk::CTL_WORDS * 4, stream);
    mk::Args a; memset(&a, 0, sizeof(a));
    a.in = mk::make_in(d_in); a.w = w; a.out = (float*)d_out; a.l = 0; a.cv_lo = 0; a.cv_hi = mk::DEPTH * mk::CI_LAYER;
#ifdef MK_MULTI
    mk::launch_phase<0>(a, grid, stream); mk::launch_phase<1>(a, grid, stream);
    for (int l = 0; l < mk::DEPTH; ++l) { a.l = l;
        mk::launch_phase<2>(a, grid, stream); mk::launch_phase<3>(a, grid, stream); mk::launch_phase<4>(a, grid, stream); mk::launch_phase<5>(a, grid, stream);
        mk::launch_phase<6>(a, grid, stream); mk::launch_phase<7>(a, grid, stream); mk::launch_phase<8>(a, grid, stream); }
#else
    hipLaunchKernelGGL(mk::k_mega, dim3(grid), dim3(mk::NTHR), mk::LDS_BYTES, stream, a);
#endif
}
```

```cpp
#include <hip/hip_runtime.h>
#include <hip/hip_bf16.h>
#include <cstdio>
#include <cstdint>
#include <cmath>
#include <cstring>
#define MK_BGCONV 2
#define MK_BGMASK 1
#define MK_F32B_DOWN 1
#define MK_BF16RES 1
#define MK_BGSPREAD 1
#define MK_RANKAGG 1
#define MK_LNPAR 1
#define MK_ROUTK 1
#define MK_TABREUSE 1
#define XB_TMO      128
#define XB_XCNT(j)  (256  + 64 * (j))
#define XB_XSUB(j)  (1280 + 64 * (j))
#define XB_XGEN(j)  (2304 + 64 * (j))
#define XB_TOP      3328
#define XB_TOPGEN   3392
#define XCD_BAR_WORDS 3456
#define XB_SPIN_CAP (1u << 22)
#define LAS __attribute__((address_space(3)))

__device__ __forceinline__ unsigned xb_ld(unsigned* p)              { return __hip_atomic_load(p, __ATOMIC_RELAXED, __HIP_MEMORY_SCOPE_AGENT); }
__device__ __forceinline__ unsigned xb_add(unsigned* p, unsigned v) { return __hip_atomic_fetch_add(p, v, __ATOMIC_RELAXED, __HIP_MEMORY_SCOPE_AGENT); }
__device__ __forceinline__ unsigned xb_xcc_id() { return (unsigned)__builtin_amdgcn_s_getreg((3 << 11) | 20) & 0xFu; }
#define XB_SPIN(cond, bar) do { unsigned _sp = 0; while (cond) { __builtin_amdgcn_s_sleep(1); \
    if ((++_sp & 255u) == 0u) { if (xb_ld(&(bar)[XB_TMO])) break; if (_sp > XB_SPIN_CAP) { atomicAdd(&(bar)[XB_TMO], 1u); break; } } } } while (0)

struct XcdBarrier {
    unsigned* bar; unsigned x;
    volatile LAS unsigned* st;
};

__device__ __forceinline__ XcdBarrier xcd_barrier_post(unsigned* bar, volatile LAS unsigned* st) {
    XcdBarrier b; b.bar = bar; b.x = xb_xcc_id(); b.st = st;
    if (threadIdx.x == 0) (void)xb_add(&bar[XB_XCNT(b.x)], 1u);
    return b;
}
__device__ __forceinline__ void xcd_barrier_complete(unsigned* bar, unsigned x, unsigned& nloc, unsigned& nx) {
    const unsigned G = gridDim.x * gridDim.y * gridDim.z;
    unsigned sum, cnt, mine, sp = 0u;
    for (;;) {
        sum = 0u; cnt = 0u; mine = 0u;
#pragma unroll
        for (unsigned j = 0; j < 16; ++j) { const unsigned c = xb_ld(&bar[XB_XCNT(j)]); sum += c; cnt += (c > 0u) ? 1u : 0u; mine = (j == x) ? c : mine; }
        if (sum == G) break;
        __builtin_amdgcn_s_sleep(1);
        if ((++sp & 255u) == 0u) { if (xb_ld(&bar[XB_TMO])) break; if (sp > XB_SPIN_CAP) { atomicAdd(&bar[XB_TMO], 1u); break; } }
    }
    nloc = mine > 0u ? mine : 1u; nx = cnt > 0u ? cnt : 1u;
}

__device__ __forceinline__ void xcd_barrier(const XcdBarrier& b) {
    asm volatile("s_waitcnt vmcnt(0)" ::: "memory");
    __syncthreads();
    if (threadIdx.x == 0) {
        unsigned* bar = b.bar;
        __builtin_amdgcn_s_waitcnt(0);
        unsigned nloc = b.st[0], nx = b.st[1];
        if (nloc == 0u) { xcd_barrier_complete(bar, b.x, nloc, nx); b.st[0] = nloc; b.st[1] = nx; }
        const unsigned old = xb_add(&bar[XB_XSUB(b.x)], 1u);
        const unsigned gen = old / nloc;
        if (old + 1u == (gen + 1u) * nloc) {
            __builtin_amdgcn_fence(__ATOMIC_RELEASE, "agent");
            asm volatile("s_waitcnt vmcnt(0)" ::: "memory");
            const unsigned og = xb_add(&bar[XB_TOP], 1u);
            const unsigned tg = og / nx;
            if (og + 1u == (tg + 1u) * nx) xb_add(&bar[XB_TOPGEN], 1u);
            else XB_SPIN(xb_ld(&bar[XB_TOPGEN]) == tg, bar);
            __builtin_amdgcn_fence(__ATOMIC_ACQUIRE, "agent");
            xb_add(&bar[XB_XGEN(b.x)], 1u);
            asm volatile("s_waitcnt vmcnt(0)" ::: "memory");
        } else {
            XB_SPIN(xb_ld(&bar[XB_XGEN(b.x)]) == gen, bar);
            __builtin_amdgcn_fence(__ATOMIC_ACQUIRE, "agent");
            asm volatile("s_waitcnt vmcnt(0)" ::: "memory");
        }
    }
    __syncthreads();
}

namespace mk {
#define MK_LAS __attribute__((address_space(3)))
typedef unsigned short bf16_t;
typedef short bf16x8 __attribute__((ext_vector_type(8)));
typedef short s16x4 __attribute__((ext_vector_type(4)));
typedef float f32x2 __attribute__((ext_vector_type(2)));
typedef float f32x4 __attribute__((ext_vector_type(4)));
typedef float f32x16 __attribute__((ext_vector_type(16)));
typedef unsigned u32x2 __attribute__((ext_vector_type(2)));
typedef unsigned u32x4 __attribute__((ext_vector_type(4)));

constexpr int D = 2048, NB = 4, S = 4096, M = NB * S, INC = 6144, NE = 32, DE = 1024, NH = 8, DEPTH = 2;
constexpr int NWAVES = 8, NTHR = 512;
constexpr float LOG2E = 1.4426950408889634f;
constexpr float LN_EPS = 1e-5f, SUBLN_EPS = 1e-5f;
constexpr float ALPHA = 1.4142135623730951f;
constexpr int PMAXP = 161;
constexpr int PROWS = PMAXP * 256;
constexpr int MAXU = 8;

__device__ __forceinline__ void st16(void* p, u32x4 v) {
#ifdef MK_WT
    asm volatile("global_store_dwordx4 %0, %1, off sc1\n\ts_nop 1" :: "v"(p), "v"(v) : "memory");
#else
    *(u32x4*)p = v;
#endif
}
__device__ __forceinline__ unsigned cvt_pk_bf16(float lo, float hi) { unsigned r; asm volatile("v_cvt_pk_bf16_f32 %0, %1, %2" : "=v"(r) : "v"(lo), "v"(hi)); return r; }
typedef __bf16 bf16v2 __attribute__((ext_vector_type(2)));
__device__ __forceinline__ unsigned cvt_pk_bf16_c(float lo, float hi) { const f32x2 v = {lo, hi}; return __builtin_bit_cast(unsigned, __builtin_convertvector(v, bf16v2)); }
__device__ __forceinline__ float bf16_lo(unsigned w) { return __uint_as_float(w << 16); }
__device__ __forceinline__ float bf16_hi(unsigned w) { return __uint_as_float(w & 0xffff0000u); }
__device__ __forceinline__ float wave_sum(float v) {
#pragma unroll
    for (int o = 1; o < 64; o <<= 1) v += __shfl_xor(v, o);
    return v;
}
__device__ __forceinline__ int ltid() { int t = threadIdx.x; asm volatile("" : "+v"(t)); return t; }
__device__ __forceinline__ int crow(int r, int hi) { return (r & 3) + 8 * (r >> 2) + 4 * hi; }

constexpr int BM = 256, BK = 64, HALF = 128, HTB = HALF * BK * 2, STAGE_BYTES = 8 * HTB, NXCD = 8, WGM = 8;
__host__ __device__ __forceinline__ int lds_byte(int r, int c) { const int st = (r >> 4) * 2 + (c >> 5), rr = r & 15, cc = c & 31, ob = rr * 64 + cc * 2; return st * 1024 + (ob ^ (((ob >> 9) & 1) << 5)); }
__host__ __device__ __forceinline__ void stage_rc(int b, int& R, int& C) { const int st = b / 1024, sb = b % 1024, swz = sb ^ (((sb >> 9) & 1) << 5); R = (st >> 1) * 16 + swz / 64; C = (st & 1) * 32 + (swz % 64) / 2; }
__host__ __device__ __forceinline__ int perm32(int rho) { const int n = rho >> 4, i = rho & 15; return 8 * (i >> 2) + 4 * n + (i & 3); }

struct Unit { int pm, pn, e; };

struct SchedDense {
    static constexpr bool GATHER = false;
    const bf16_t* A; const bf16_t* Bt; int K;
    int nM, nN, nwg, G, c;
    __device__ void init(const bf16_t* A_, const bf16_t* Bt_, int Mr, int N, int K_, int G_, int c_) { A = A_; Bt = Bt_; K = K_; nM = Mr / BM; nN = N / BM; nwg = nM * nN; G = G_; c = c_; }
    __device__ __forceinline__ bool next(int i, Unit& u) const {
        const long L = (long)i * G + c; if (L >= nwg) return false;
        int wgid = (int)L; { const int q = nwg / NXCD, r = nwg % NXCD, xcd = wgid % NXCD, off = wgid / NXCD; wgid = (xcd < r ? xcd * (q + 1) : r * (q + 1) + (xcd - r) * q) + off; }
        const int nig = WGM * nN, gid = wgid / nig, fm = gid * WGM, gsz = (nM - fm) < WGM ? (nM - fm) : WGM;
        u.pm = fm + ((wgid % nig) % gsz); u.pn = (wgid % nig) / gsz; u.e = 0; return true;
    }
    __device__ __forceinline__ const char* a_base(const Unit& u) const { return (const char*)A + (size_t)u.pm * BM * K * 2; }
    __device__ __forceinline__ const char* b_base(const Unit& u) const { return (const char*)Bt + (size_t)u.pn * BM * K * 2; }
    __device__ __forceinline__ void a_voff(int, const Unit&, const int (&R)[2], const int (&C)[2], unsigned (&v0)[2], unsigned (&v1)[2]) const {
#pragma unroll
        for (int j = 0; j < 2; ++j) { v0[j] = (unsigned)(R[j] * K + C[j]) * 2u; v1[j] = v0[j] + (unsigned)(HALF * K * 2); }
    }
};
template <bool GATHER_>
struct SchedMoe {
    static constexpr bool GATHER = GATHER_;
    const bf16_t* A; const bf16_t* Bt; size_t estride; int K;
    int nunits, G, c;
    const MK_LAS int* pexp;
    const MK_LAS int* tokl;
    __device__ __forceinline__ bool next(int i, Unit& u) const {
        const int L = i * G + c; if (L >= nunits || i >= MAXU) return false;
        int wgid = L; { const int q = nunits / NXCD, r = nunits % NXCD, xcd = wgid % NXCD, off = wgid / NXCD; wgid = (xcd < r ? xcd * (q + 1) : r * (q + 1) + (xcd - r) * q) + off; }
        u.pm = wgid >> 3; u.pn = wgid & 7; u.e = pexp[u.pm]; return true;
    }
    __device__ __forceinline__ const char* a_base(const Unit& u) const { return GATHER ? (const char*)A : (const char*)A + (size_t)u.pm * BM * K * 2; }
    __device__ __forceinline__ const char* b_base(const Unit& u) const { return (const char*)Bt + ((size_t)u.e * estride + (size_t)u.pn * BM * K) * 2; }
    __device__ __forceinline__ unsigned a_off1(int i, int half, int R, int C) const {
        if (GATHER) return (unsigned)(tokl[i * 256 + half * HALF + R] * K + C) * 2u;
        return (unsigned)((R + half * HALF) * K + C) * 2u;
    }
    __device__ __forceinline__ void a_voff(int i, const Unit&, const int (&R)[2], const int (&C)[2], unsigned (&v0)[2], unsigned (&v1)[2]) const {
#pragma unroll
        for (int j = 0; j < 2; ++j) {
            if (GATHER) { const int t0 = tokl[i * 256 + R[j]], t1 = tokl[i * 256 + HALF + R[j]];
                v0[j] = (unsigned)(t0 * K + C[j]) * 2u; v1[j] = (unsigned)(t1 * K + C[j]) * 2u; }
            else { v0[j] = (unsigned)(R[j] * K + C[j]) * 2u; v1[j] = v0[j] + (unsigned)(HALF * K * 2); }
        }
    }
};

struct EpiProj {
    static constexpr bool PERM = true;
    bf16_t* O;
    __device__ __forceinline__ void operator()(const f32x4 (&acc)[2][2][4][2], const Unit& u, int wr, int wc, int fr, int fq) const {
        const int row0 = u.pm * BM + wr * 64 + fr, col0 = u.pn * BM + wc * 32 + 8 * fq;
        const float s = (u.pn < 4) ? 0.125f * LOG2E : ((u.pn >= 12 && u.pn < 16) ? 0.08838834764831845f * LOG2E : 1.0f);
#pragma unroll
        for (int ai = 0; ai < 2; ++ai)
#pragma unroll
            for (int m = 0; m < 4; ++m) { bf16_t* rowp = O + (size_t)(row0 + ai * HALF + m * 16) * INC + col0;
#pragma unroll
                for (int bj = 0; bj < 2; ++bj) { const f32x4 v0 = acc[ai][bj][m][0] * s, v1 = acc[ai][bj][m][1] * s;
                    u32x4 w; w.x = cvt_pk_bf16(v0[0], v0[1]); w.y = cvt_pk_bf16(v0[2], v0[3]); w.z = cvt_pk_bf16(v1[0], v1[1]); w.w = cvt_pk_bf16(v1[2], v1[3]);
                    st16(rowp + bj * HALF, w); } }
    }
};
struct EpiWo {
    static constexpr bool PERM = false;
    const float* x; const float* gate; float* H;
    __device__ __forceinline__ void operator()(const f32x4 (&acc)[2][2][4][2], const Unit& u, int wr, int wc, int fr, int fq) const {
        const int row0 = u.pm * BM + wr * 64 + fr, col0 = u.pn * BM + wc * 32 + 4 * fq;
        const float* gp = gate + (size_t)(u.pm >> 4) * 6 * D + col0;
        f32x4 gv[2][2];
#pragma unroll
        for (int bj = 0; bj < 2; ++bj)
#pragma unroll
            for (int n = 0; n < 2; ++n) gv[bj][n] = *(const f32x4*)(gp + bj * HALF + n * 16) + 1.0f;
#pragma unroll
        for (int ai = 0; ai < 2; ++ai)
#pragma unroll
            for (int m = 0; m < 4; ++m) { const size_t off = (size_t)(row0 + ai * HALF + m * 16) * D + col0;
#pragma unroll
                for (int bj = 0; bj < 2; ++bj)
#pragma unroll
                    for (int n = 0; n < 2; ++n) { const f32x4 xv = *(const f32x4*)(x + off + bj * HALF + n * 16);
                        *(f32x4*)(H + off + bj * HALF + n * 16) = xv * ALPHA + gv[bj][n] * acc[ai][bj][m][n]; } }
    }
};
struct EpiGU {
    static constexpr bool PERM = true;
    bf16_t* Hb;
    __device__ __forceinline__ void operator()(const f32x4 (&acc)[2][2][4][2], const Unit& u, int wr, int wc, int fr, int fq) const {
        const int row0 = u.pm * BM + wr * 64 + fr, col0 = u.pn * HALF + wc * 32 + 8 * fq;
#pragma unroll
        for (int ai = 0; ai < 2; ++ai)
#pragma unroll
            for (int m = 0; m < 4; ++m) { bf16_t* rowp = Hb + (size_t)(row0 + ai * HALF + m * 16) * DE + col0;
                float h[8];
#pragma unroll
                for (int n = 0; n < 2; ++n)
#pragma unroll
                    for (int j = 0; j < 4; ++j) { const float g = acc[ai][0][m][n][j], up = acc[ai][1][m][n][j];
                        h[n * 4 + j] = g * __builtin_amdgcn_rcpf(1.0f + __builtin_amdgcn_exp2f(-g * LOG2E)) * up; }
                u32x4 w; w.x = cvt_pk_bf16(h[0], h[1]); w.y = cvt_pk_bf16(h[2], h[3]); w.z = cvt_pk_bf16(h[4], h[5]); w.w = cvt_pk_bf16(h[6], h[7]);
                st16(rowp, w); }
    }
};
struct EpiDown {
    static constexpr bool PERM = true;
    bf16_t* Y;
    __device__ __forceinline__ void operator()(const f32x4 (&acc)[2][2][4][2], const Unit& u, int wr, int wc, int fr, int fq) const {
        const int row0 = u.pm * BM + wr * 64 + fr, col0 = u.pn * BM + wc * 32 + 8 * fq;
#pragma unroll
        for (int ai = 0; ai < 2; ++ai)
#pragma unroll
            for (int m = 0; m < 4; ++m) { bf16_t* rowp = Y + (size_t)(row0 + ai * HALF + m * 16) * D + col0;
#pragma unroll
                for (int bj = 0; bj < 2; ++bj) { const f32x4 v0 = acc[ai][bj][m][0], v1 = acc[ai][bj][m][1];
                    u32x4 w; w.x = cvt_pk_bf16(v0[0], v0[1]); w.y = cvt_pk_bf16(v0[2], v0[3]); w.z = cvt_pk_bf16(v1[0], v1[1]); w.w = cvt_pk_bf16(v1[2], v1[3]);
                    st16(rowp + bj * HALF, w); } }
    }
};

template <class Epi, class Sched>
__device__ __forceinline__ void gemm_phase(MK_LAS unsigned char* lds, const int K, const Sched& S, const Epi& E) {
    const int tid = ltid(), wid = __builtin_amdgcn_readfirstlane(tid >> 6), lane = tid & 63, wr = wid >> 2, wc = wid & 3, fr = lane & 15, fq = lane >> 4;
    const int nt = K / BK;
    int Rr[2], Cc[2]; unsigned voffB[2];
#pragma unroll
    for (int i = 0; i < 2; ++i) { int R, C; stage_rc(tid * 16 + i * 8192, R, C); const int Rb = Epi::PERM ? ((R & ~31) + perm32(R & 31)) : R;
        Rr[i] = R; Cc[i] = C; voffB[i] = (unsigned)(Rb * K + C) * 2u; }
    const size_t kstep = (size_t)(BK * 2);
    const size_t hstep = (size_t)HALF * K * 2;
    const unsigned ldsw = (unsigned)wid * 1024u;
    const int aoff = lds_byte(wr * 64 + fr, fq * 8), boff = lds_byte(wc * 32 + fr, fq * 8);
#define PG8_SA(b, h) (((b) * 2 + (h)) * HTB)
#define PG8_SB(b, h) ((4 + (b) * 2 + (h)) * HTB)
#define PG8_STAGE(bufoff, gbase, voff) do { _Pragma("unroll") for (int _i = 0; _i < 2; ++_i) \
        __builtin_amdgcn_global_load_lds((const unsigned*)((const char*)(gbase) + (voff)[_i]), (MK_LAS unsigned*)(lds + (bufoff) + ldsw + _i * 8192), 16, 0, 0); } while (0)
#define PG8_LDA(dst, b, h) do { _Pragma("unroll") for (int m = 0; m < 4; ++m) _Pragma("unroll") for (int k = 0; k < 2; ++k) dst[m][k] = *(const MK_LAS bf16x8*)(lds + PG8_SA(b, h) + aoff + m * 2048 + k * 1024); } while (0)
#define PG8_LDB(dst, b, h) do { _Pragma("unroll") for (int n = 0; n < 2; ++n) _Pragma("unroll") for (int k = 0; k < 2; ++k) dst[n][k] = *(const MK_LAS bf16x8*)(lds + PG8_SB(b, h) + boff + n * 2048 + k * 1024); } while (0)
#define PG8_MMA(ai, bj, At, Bt) do { __builtin_amdgcn_s_setprio(1); _Pragma("unroll") for (int m = 0; m < 4; ++m) _Pragma("unroll") for (int n = 0; n < 2; ++n) _Pragma("unroll") for (int k = 0; k < 2; ++k) \
        acc[ai][bj][m][n] = __builtin_amdgcn_mfma_f32_16x16x32_bf16(Bt[n][k], At[m][k], acc[ai][bj][m][n], 0, 0, 0); __builtin_amdgcn_s_setprio(0); } while (0)
#define PG8_WAIT_V(n) asm volatile("s_waitcnt vmcnt(" #n ")" ::: "memory")
#define PG8_WAIT_L(n) asm volatile("s_waitcnt lgkmcnt(" #n ")" ::: "memory")
#define PG8_BAR __builtin_amdgcn_s_barrier()
#define PG8_SCHED __builtin_amdgcn_sched_barrier(0)
    Unit cur, nxt; int ui = 0;
    if (!S.next(0, cur)) return;
    unsigned cv0[2], cv1[2], nv0[2], nv1[2];
    S.a_voff(0, cur, Rr, Cc, cv0, cv1);
    f32x4 acc[2][2][4][2];
#pragma unroll
    for (int a = 0; a < 2; ++a)
#pragma unroll
        for (int b = 0; b < 2; ++b)
#pragma unroll
            for (int m = 0; m < 4; ++m)
#pragma unroll
                for (int n = 0; n < 2; ++n) acc[a][b][m][n] = (f32x4){0.f, 0.f, 0.f, 0.f};
    bf16x8 At[4][2], B0[2][2], B1[2][2];
    const char* cA = S.a_base(cur); const char* cB = S.b_base(cur);
    PG8_STAGE(PG8_SB(0, 0), cB, voffB); PG8_STAGE(PG8_SB(0, 1), cB + hstep, voffB); PG8_STAGE(PG8_SA(0, 0), cA, cv0); PG8_STAGE(PG8_SA(0, 1), cA, cv1);
    if (wr == 1) PG8_BAR;
    PG8_WAIT_V(2); PG8_BAR;
    PG8_STAGE(PG8_SB(1, 0), cB + kstep, voffB); PG8_STAGE(PG8_SA(1, 0), cA + kstep, cv0); PG8_STAGE(PG8_SB(1, 1), cB + hstep + kstep, voffB);
    PG8_WAIT_V(6); PG8_BAR;
    for (;;) {
        const bool has_next = S.next(ui + 1, nxt);
        const char* nA = cA; const char* nB = cB;
#pragma unroll
        for (int j = 0; j < 2; ++j) { nv0[j] = cv0[j]; nv1[j] = cv1[j]; }
        if (has_next) { nA = S.a_base(nxt); nB = S.b_base(nxt); S.a_voff(ui + 1, nxt, Rr, Cc, nv0, nv1); }
        for (int t = 0; t < nt; t += 2) {
            const bool last = (t == nt - 2);
            const char* a1 = cA + (size_t)(t + 1) * kstep;
            const char* a2 = last ? nA : cA + (size_t)(t + 2) * kstep; const char* b2 = last ? nB : cB + (size_t)(t + 2) * kstep;
            const char* a3 = a2 + kstep; const char* b3 = b2 + kstep;
            unsigned x0[2], x1[2];
#pragma unroll
            for (int j = 0; j < 2; ++j) { x0[j] = last ? nv0[j] : cv0[j]; x1[j] = last ? nv1[j] : cv1[j]; }
            PG8_LDB(B0, 0, 0); PG8_LDB(B1, 0, 1); PG8_SCHED; PG8_LDA(At, 0, 0); PG8_STAGE(PG8_SA(1, 1), a1, cv1);
            PG8_WAIT_V(8); PG8_WAIT_L(0); PG8_BAR; PG8_MMA(0, 0, At, B0); PG8_MMA(0, 1, At, B1); PG8_BAR; PG8_SCHED;
            PG8_LDA(At, 0, 1); PG8_STAGE(PG8_SB(0, 0), b2, voffB); PG8_STAGE(PG8_SB(0, 1), b2 + hstep, voffB); PG8_STAGE(PG8_SA(0, 0), a2, x0);
            PG8_WAIT_V(8); PG8_WAIT_L(0); PG8_BAR; PG8_MMA(1, 0, At, B0); PG8_MMA(1, 1, At, B1); PG8_BAR; PG8_SCHED;
            PG8_LDB(B0, 1, 0); PG8_LDB(B1, 1, 1); PG8_SCHED; PG8_LDA(At, 1, 0); PG8_STAGE(PG8_SA(0, 1), a2, x1);
            PG8_WAIT_V(8); PG8_WAIT_L(0); PG8_BAR; PG8_MMA(0, 0, At, B0); PG8_MMA(0, 1, At, B1); PG8_BAR; PG8_SCHED;
            PG8_LDA(At, 1, 1); PG8_STAGE(PG8_SB(1, 0), b3, voffB); PG8_STAGE(PG8_SB(1, 1), b3 + hstep, voffB); PG8_STAGE(PG8_SA(1, 0), a3, x0);
            PG8_WAIT_V(8); PG8_WAIT_L(0); PG8_BAR; PG8_MMA(1, 0, At, B0); PG8_MMA(1, 1, At, B1); PG8_BAR; PG8_SCHED;
        }
        if (wr == 0) PG8_BAR;
        E(acc, cur, wr, wc, fr, fq);
        if (!has_next) break;
#pragma unroll
        for (int a = 0; a < 2; ++a)
#pragma unroll
            for (int b = 0; b < 2; ++b)
#pragma unroll
                for (int m = 0; m < 4; ++m)
#pragma unroll
                    for (int n = 0; n < 2; ++n) acc[a][b][m][n] = (f32x4){0.f, 0.f, 0.f, 0.f};
        cur = nxt; cA = nA; cB = nB; ++ui;
#pragma unroll
        for (int j = 0; j < 2; ++j) { cv0[j] = nv0[j]; cv1[j] = nv1[j]; }
        if (wr == 1) PG8_BAR;
    }
    PG8_WAIT_V(0);
    PG8_BAR;
#undef PG8_SA
#undef PG8_SB
#undef PG8_STAGE
#undef PG8_LDA
#undef PG8_LDB
#undef PG8_MMA
#undef PG8_WAIT_V
#undef PG8_WAIT_L
#undef PG8_BAR
#undef PG8_SCHED
}
__device__ __forceinline__ const char* uniform_ptr(const char* p) { const unsigned long long v = (unsigned long long)p; const unsigned lo = __builtin_amdgcn_readfirstlane((unsigned)v), hi = __builtin_amdgcn_readfirstlane((unsigned)(v >> 32)); return (const char*)(((unsigned long long)hi << 32) | lo); }
__host__ __device__ __forceinline__ int invperm32(int c) { return ((c >> 2) & 1) * 16 + (c >> 3) * 4 + (c & 3); }
struct BPatch {
    unsigned voff;
    unsigned ldsoff;
};
struct BSrcDown {
    const float* W; size_t estride; int ldb;
    __device__ __forceinline__ void patch(int tid, bool perm, BPatch& P) const {
        const int lane = tid & 63, w = tid >> 6, kr0 = 8 * w, n0 = 4 * lane;
        P.voff = (unsigned)(kr0 * ldb + n0) * 4u;
        { const int n = n0, h = n >> 7, R = n & 127, slot = perm ? ((R & ~31) + invperm32(R & 31)) : R; P.ldsoff = (unsigned)(h * HTB + lds_byte(slot, kr0)); }
    }
    __device__ __forceinline__ const char* base(const Unit& u, int  ) const { const int e = __builtin_amdgcn_readfirstlane(u.e), pn = __builtin_amdgcn_readfirstlane(u.pn); return (const char*)(W + (size_t)e * estride + (size_t)pn * BM); }
    __device__ __forceinline__ size_t rowbytes() const { return (size_t)ldb * 4; }
};

struct BSrcUp {
    const float* Wg; const float* Wu; size_t estride; int ldb;
    __device__ __forceinline__ void patch(int tid, bool perm, BPatch& P) const {
        const int lane = tid & 63, w = tid >> 6, s_ = w & 1, kr0 = 16 * (w >> 1) + 8 * (lane >> 5), c0 = 4 * (lane & 31);
        P.voff = (unsigned)(kr0 * ldb + c0) * 4u;
        { const int R = c0, slot = perm ? ((R & ~31) + invperm32(R & 31)) : R; P.ldsoff = (unsigned)(s_ * HTB + lds_byte(slot, kr0)); }
    }
    __device__ __forceinline__ const char* base(const Unit& u, int wave) const { const int e = __builtin_amdgcn_readfirstlane(u.e), pn = __builtin_amdgcn_readfirstlane(u.pn), sel = __builtin_amdgcn_readfirstlane(wave & 1);
        const unsigned long long m = 0ull - (unsigned long long)(unsigned)sel;
        const float* src = (const float*)(((unsigned long long)Wg & ~m) | ((unsigned long long)Wu & m)); return (const char*)(src + (size_t)e * estride + (size_t)pn * HALF); }
    __device__ __forceinline__ size_t rowbytes() const { return (size_t)ldb * 4; }
};

template <int VAR = 0, class Epi, class Sched, class BSrc>
__device__ __forceinline__ void gemm_phase_fb(MK_LAS unsigned char* lds, const int K, const Sched& S, const BSrc& Bs_, const Epi& E) {
    const int tid = ltid(), wid = __builtin_amdgcn_readfirstlane(tid >> 6), lane = tid & 63, wr = wid >> 2, wc = wid & 3, fr = lane & 15, fq = lane >> 4;
    const int nt = K / BK;
    BPatch P; Bs_.patch(tid, Epi::PERM, P);
    const size_t kstep = (size_t)(BK * 2);
    const size_t rowb = Bs_.rowbytes(), ktb = rowb * BK;
    const unsigned ldsw = (unsigned)wid * 1024u;
    const int aoff = lds_byte(wr * 64 + fr, fq * 8), boff = lds_byte(wc * 32 + fr, fq * 8);
#define PG8_SA(b, h) (((b) * 2 + (h)) * HTB)
#define PG8_SB(b, h) ((4 + (b) * 2 + (h)) * HTB)
#define PG8_STAGE(bufoff, gbase, voff) do { _Pragma("unroll") for (int _i = 0; _i < 2; ++_i) \
        __builtin_amdgcn_global_load_lds((const unsigned*)((const char*)(gbase) + (voff)[_i]), (MK_LAS unsigned*)(lds + (bufoff) + ldsw + _i * 8192), 16, 0, 0); } while (0)
#define PG8_LDA(dst, b, h) do { _Pragma("unroll") for (int m = 0; m < 4; ++m) _Pragma("unroll") for (int k = 0; k < 2; ++k) dst[m][k] = *(const MK_LAS bf16x8*)(lds + PG8_SA(b, h) + aoff + m * 2048 + k * 1024); } while (0)
#define PG8_LDB(dst, b, h) do { _Pragma("unroll") for (int n = 0; n < 2; ++n) _Pragma("unroll") for (int k = 0; k < 2; ++k) dst[n][k] = *(const MK_LAS bf16x8*)(lds + PG8_SB(b, h) + boff + n * 2048 + k * 1024); } while (0)
#define PG8_MMA(ai, bj, At, Bt) do { __builtin_amdgcn_s_setprio(1); _Pragma("unroll") for (int m = 0; m < 4; ++m) _Pragma("unroll") for (int n = 0; n < 2; ++n) _Pragma("unroll") for (int k = 0; k < 2; ++k) \
        acc[ai][bj][m][n] = __builtin_amdgcn_mfma_f32_16x16x32_bf16(Bt[n][k], At[m][k], acc[ai][bj][m][n], 0, 0, 0); __builtin_amdgcn_s_setprio(0); } while (0)
#define PG8_WAIT_V(n) asm volatile("s_waitcnt vmcnt(" #n ")" ::: "memory")
#define PG8_WAIT_L(n) asm volatile("s_waitcnt lgkmcnt(" #n ")" ::: "memory")
#define PG8_BAR __builtin_amdgcn_s_barrier()
#define PG8_SCHED __builtin_amdgcn_sched_barrier(0)
    f32x4 br[8];
#define BF_LOAD(ptr) do { const char* _p = uniform_ptr(ptr); \
        _Pragma("unroll") for (int _j = 0; _j < 8; ++_j) asm volatile("global_load_dwordx4 %0, %1, %2" : "=v"(br[_j]) : "v"(P.voff), "s"(_p + (size_t)_j * rowb) : "memory"); } while (0)
#define BF_CONSUME(NLEFT, b) do { asm volatile("s_waitcnt vmcnt(" #NLEFT ")" : "+v"(br[0]), "+v"(br[1]), "+v"(br[2]), "+v"(br[3]), "+v"(br[4]), "+v"(br[5]), "+v"(br[6]), "+v"(br[7]) :: "memory"); \
        _Pragma("unroll") for (int _i = 0; _i < 4; ++_i) { u32x4 _w; _w.x = cvt_pk_bf16(br[0][_i], br[1][_i]); _w.y = cvt_pk_bf16(br[2][_i], br[3][_i]); _w.z = cvt_pk_bf16(br[4][_i], br[5][_i]); _w.w = cvt_pk_bf16(br[6][_i], br[7][_i]); \
            *(MK_LAS u32x4*)(lds + PG8_SB(b, 0) + P.ldsoff + _i * 64) = _w; } } while (0)
#define BF_FILL(g, b, nptr) do { \
        if ((g) < 20) { if (VAR != 2 && VAR != 3) { const int _c = (g) / 5, _w = (g) % 5; \
            if (_w < 4) fw[_w] = cvt_pk_bf16_c(br[2 * _w][_c], br[2 * _w + 1][_c]); \
            else *(MK_LAS u32x4*)(lds + PG8_SB(b, 0) + P.ldsoff + _c * 64) = (u32x4){fw[0], fw[1], fw[2], fw[3]}; } } \
        else if ((g) < 28 && VAR != 3) { const int _j = (g) - 20; asm volatile("global_load_dwordx4 %0, %1, %2" : "=v"(br[_j]) : "v"(P.voff), "s"(nptr + (size_t)_j * rowb) : "memory"); } } while (0)
#define BF_MMA_FILL(b, nextp) do { const char* _np = uniform_ptr(nextp); unsigned fw[4]; BPatch P; Bs_.patch(ltid(), Epi::PERM, P); \
        asm volatile("s_waitcnt vmcnt(4)" : "+v"(br[0]), "+v"(br[1]), "+v"(br[2]), "+v"(br[3]), "+v"(br[4]), "+v"(br[5]), "+v"(br[6]), "+v"(br[7]) :: "memory"); \
        __builtin_amdgcn_s_setprio(1); \
        _Pragma("unroll") for (int _g = 0; _g < 32; ++_g) { const int _bj = _g >> 4, _m = (_g >> 2) & 3, _n = (_g >> 1) & 1, _k = _g & 1; \
            if (_bj == 0) acc[1][0][_m][_n] = __builtin_amdgcn_mfma_f32_16x16x32_bf16(B0[_n][_k], At[_m][_k], acc[1][0][_m][_n], 0, 0, 0); \
            else acc[1][1][_m][_n] = __builtin_amdgcn_mfma_f32_16x16x32_bf16(B1[_n][_k], At[_m][_k], acc[1][1][_m][_n], 0, 0, 0); \
            BF_FILL(_g, b, _np); \
            __builtin_amdgcn_sched_barrier(0); } \
        __builtin_amdgcn_s_setprio(0); } while (0)
    Unit cur, nxt; int ui = 0;
    if (!S.next(0, cur)) return;
#define AV(dst, unit, half) do { _Pragma("unroll") for (int _j = 0; _j < 2; ++_j) { int _R, _C; stage_rc(ltid() * 16 + _j * 8192, _R, _C); dst[_j] = S.a_off1((unit), (half), _R, _C); } } while (0)
    unsigned cv0[2], cv1[2], nv0[2], nv1[2];
    AV(cv0, 0, 0); AV(cv1, 0, 1);
    f32x4 acc[2][2][4][2];
#pragma unroll
    for (int a = 0; a < 2; ++a)
#pragma unroll
        for (int b = 0; b < 2; ++b)
#pragma unroll
            for (int m = 0; m < 4; ++m)
#pragma unroll
                for (int n = 0; n < 2; ++n) acc[a][b][m][n] = (f32x4){0.f, 0.f, 0.f, 0.f};
    bf16x8 At[4][2], B0[2][2], B1[2][2];
    const char* cA = S.a_base(cur); const char* cB = Bs_.base(cur, wid);
    BF_LOAD(cB); PG8_STAGE(PG8_SA(0, 0), cA, cv0); PG8_STAGE(PG8_SA(0, 1), cA, cv1);
    BF_CONSUME(4, 0);
    BF_LOAD(cB + ktb); PG8_STAGE(PG8_SA(1, 0), cA + kstep, cv0);
    BF_CONSUME(2, 1);
    BF_LOAD(cB + 2 * ktb);
    PG8_WAIT_V(8); PG8_WAIT_L(0);
    if (wr == 1) PG8_BAR;
    PG8_BAR; PG8_BAR;
    for (;;) {
        const bool has_next = S.next(ui + 1, nxt);
        const char* nA = cA; const char* nB = cB;
        if (has_next) { nA = S.a_base(nxt); nB = Bs_.base(nxt, wid); }
        const int un = has_next ? ui + 1 : ui;
        if constexpr (Sched::GATHER) { AV(nv0, un, 0); AV(nv1, un, 1); }
        for (int t = 0; t < nt; t += 2) {
            const bool last = (t == nt - 2);
            const char* a1 = cA + (size_t)(t + 1) * kstep;
            const char* a2 = last ? nA : cA + (size_t)(t + 2) * kstep;
            const char* a3 = a2 + kstep;
            const int km = (VAR == 1) ? 1 : -1;
            const char* b3 = (t + 3 < nt) ? cB + (size_t)((t + 3) & km) * ktb : nB + (size_t)(t + 3 - nt) * ktb;
            const char* b4 = (t + 4 < nt) ? cB + (size_t)((t + 4) & km) * ktb : nB + (size_t)(t + 4 - nt) * ktb;
#define AOFF_H0(_i) (Sched::GATHER ? (last ? nv0[_i] : cv0[_i]) : cv0[_i])
#define AOFF_H1(_i) (Sched::GATHER ? (last ? nv1[_i] : cv1[_i]) : cv0[_i] + (unsigned)(HALF * K * 2))
#define AOFF_C1(_i) (Sched::GATHER ? cv1[_i] : cv0[_i] + (unsigned)(HALF * K * 2))
#define PG8_STAGEF(bufoff, gbase, OFF) do { _Pragma("unroll") for (int _i = 0; _i < 2; ++_i) \
        __builtin_amdgcn_global_load_lds((const unsigned*)((const char*)(gbase) + OFF(_i)), (MK_LAS unsigned*)(lds + (bufoff) + ldsw + _i * 8192), 16, 0, 0); } while (0)
            PG8_LDB(B0, 0, 0); PG8_LDB(B1, 0, 1); PG8_SCHED; PG8_LDA(At, 0, 0); PG8_STAGEF(PG8_SA(1, 1), a1, AOFF_C1);
            PG8_WAIT_V(12); PG8_WAIT_L(0); PG8_BAR; PG8_MMA(0, 0, At, B0); PG8_MMA(0, 1, At, B1); PG8_BAR; PG8_SCHED;
            PG8_LDA(At, 0, 1); PG8_STAGEF(PG8_SA(0, 0), a2, AOFF_H0);
            PG8_WAIT_L(0); PG8_BAR; BF_MMA_FILL(0, b3); PG8_BAR; PG8_SCHED;
            PG8_LDB(B0, 1, 0); PG8_LDB(B1, 1, 1); PG8_SCHED; PG8_LDA(At, 1, 0); PG8_STAGEF(PG8_SA(0, 1), a2, AOFF_H1);
            PG8_WAIT_V(12); PG8_WAIT_L(0); PG8_BAR; PG8_MMA(0, 0, At, B0); PG8_MMA(0, 1, At, B1); PG8_BAR; PG8_SCHED;
            PG8_LDA(At, 1, 1); PG8_STAGEF(PG8_SA(1, 0), a3, AOFF_H0);
            PG8_WAIT_L(0); PG8_BAR; BF_MMA_FILL(1, b4); PG8_BAR; PG8_SCHED;
        }
        if (wr == 0) PG8_BAR;
        E(acc, cur, wr, wc, fr, fq);
        if (!has_next) break;
#pragma unroll
        for (int a = 0; a < 2; ++a)
#pragma unroll
            for (int b = 0; b < 2; ++b)
#pragma unroll
                for (int m = 0; m < 4; ++m)
#pragma unroll
                    for (int n = 0; n < 2; ++n) acc[a][b][m][n] = (f32x4){0.f, 0.f, 0.f, 0.f};
        cur = nxt; cA = nA; cB = nB; ++ui;
        if constexpr (Sched::GATHER) {
#pragma unroll
            for (int j = 0; j < 2; ++j) { cv0[j] = nv0[j]; cv1[j] = nv1[j]; } }
        if (wr == 1) PG8_BAR;
    }
    asm volatile("s_waitcnt vmcnt(0)" : "+v"(br[0]), "+v"(br[1]), "+v"(br[2]), "+v"(br[3]), "+v"(br[4]), "+v"(br[5]), "+v"(br[6]), "+v"(br[7]) :: "memory");
    PG8_BAR;
#undef BF_LOAD
#undef AOFF_H0
#undef AOFF_H1
#undef AOFF_C1
#undef PG8_STAGEF
#undef BF_FILL
#undef BF_MMA_FILL
#undef AV
#undef BF_CONSUME
#undef PG8_SA
#undef PG8_SB
#undef PG8_STAGE
#undef PG8_LDA
#undef PG8_LDB
#undef PG8_MMA
#undef PG8_WAIT_V
#undef PG8_WAIT_L
#undef PG8_BAR
#undef PG8_SCHED
}
struct In { const float *x, *c, *w_ada, *b_ada, *w_in, *lam, *subg, *relb, *w_o, *ln_g, *ln_b, *w_group, *b_group, *w_router, *b_router, *w_gate, *w_up, *w_down; };
struct Ws {
    unsigned* ctl;
    float* mod;
    bf16_t* wt_in;
    bf16_t* wt_o;
    bf16_t* wt_gu;
    bf16_t* wt_d;
    bf16_t* ab;
    bf16_t* proj;
    bf16_t* mixin;
    bf16_t* mixb;
    float* x1;
    float* xa;
    bf16_t* Hb;
    bf16_t* Yb;
    int* tok_of;
    int* tokinfo;
    float* tokw;
    bf16_t* wt_rh;
    bf16_t* wt_rl;
    bf16_t* ablo;
};
constexpr int CTL_CNT = 4096;
constexpr int CTL_WORDS = 8192;

constexpr int LDS_AUX = 131072;
constexpr int LDS_PEXP = LDS_AUX;
constexpr int LDS_PBASE = LDS_AUX + 768;
constexpr int LDS_CNT = LDS_AUX + 1024;
constexpr int LDS_XOFF = LDS_AUX + 1280;
constexpr int LDS_TOKL = LDS_AUX + 2048;
constexpr int LDS_BTAB = LDS_AUX + 2048 + 8192;
constexpr int LDS_MISC = LDS_BTAB + 1088;
constexpr int LDS_BYTES = 147456;
constexpr int LDS_FLAGS = LDS_MISC + 64;
static_assert(LDS_FLAGS + 64 <= LDS_BYTES, "LDS map");

struct Frame { MK_LAS unsigned char* lds; int tid, lane, wave, G, vcu; };

__device__ __forceinline__ void conv_item(const float* __restrict__ W, int K, int N, bf16_t* __restrict__ WT, int k0, int n0, int drow0, MK_LAS float* scr, int lane) {
    const int n4 = (lane & 15) * 4, kq = lane >> 4;
    f32x4 v[16];
#pragma unroll
    for (int i = 0; i < 16; ++i) v[i] = *(const f32x4*)(W + (size_t)(k0 + kq + 4 * i) * N + n0 + n4);
#pragma unroll
    for (int i = 0; i < 16; ++i) { MK_LAS float* p = scr + (kq + 4 * i) * 65 + n4; p[0] = v[i][0]; p[1] = v[i][1]; p[2] = v[i][2]; p[3] = v[i][3]; }
    asm volatile("s_waitcnt lgkmcnt(0)" ::: "memory");
    const int c = lane & 7;
#pragma unroll
    for (int j = 0; j < 8; ++j) { const int n = (lane >> 3) + 8 * j; const MK_LAS float* s = scr + (8 * c) * 65 + n;
        u32x4 o; o.x = cvt_pk_bf16(s[0 * 65], s[1 * 65]); o.y = cvt_pk_bf16(s[2 * 65], s[3 * 65]); o.z = cvt_pk_bf16(s[4 * 65], s[5 * 65]); o.w = cvt_pk_bf16(s[6 * 65], s[7 * 65]);
        st16(WT + (size_t)(drow0 + n) * K + k0 + 8 * c, o); }
    asm volatile("s_waitcnt lgkmcnt(0)" ::: "memory");
}
#if (defined(MK_F32B_DOWN) && defined(MK_F32B_UP)) || defined(MK_BGCONV)
constexpr int CI_E = 0;
#elif defined(MK_F32B_DOWN)
constexpr int CI_E = 1024;
#else
constexpr int CI_E = 1536;
#endif
constexpr int CI_IN = 3072, CI_O = 1024, CI_LAYER = CI_IN + CI_O + NE * CI_E;
__device__ __forceinline__ void conv_dispatch(const In& in, const Ws& w, int l, int r, MK_LAS float* scr, int lane) {
    if (r < CI_IN) { const int kb = r / 96, nb = r % 96; conv_item(in.w_in + (size_t)l * D * INC, D, INC, w.wt_in + (size_t)l * INC * D, kb * 64, nb * 64, nb * 64, scr, lane); return; }
    r -= CI_IN;
    if (r < CI_O) { const int kb = r / 32, nb = r % 32; conv_item(in.w_o + (size_t)l * D * D, D, D, w.wt_o + (size_t)l * D * D, kb * 64, nb * 64, nb * 64, scr, lane); return; }
    r -= CI_O;
    if (CI_E == 0) return;
    const int e = r / (CI_E ? CI_E : 1); r -= e * CI_E;
    const size_t le = (size_t)l * NE + e;
    if (r < 512) { const int kb = r / 16, nb = r % 16, n0 = nb * 64; conv_item(in.w_gate + le * D * DE, D, DE, w.wt_gu + le * 2048 * D, kb * 64, n0, ((n0 >> 7) << 8) + (n0 & 127), scr, lane); return; }
    r -= 512;
    if (r < 512) { const int kb = r / 16, nb = r % 16, n0 = nb * 64; conv_item(in.w_up + le * D * DE, D, DE, w.wt_gu + le * 2048 * D, kb * 64, n0, ((n0 >> 7) << 8) + 128 + (n0 & 127), scr, lane); return; }
    r -= 512;
#ifndef MK_F32B_DOWN
    { const int kb = r / 32, nb = r % 32; conv_item(in.w_down + le * DE * D, DE, D, w.wt_d + le * D * DE, kb * 64, nb * 64, nb * 64, scr, lane); }
#endif
}
__device__ __forceinline__ void phase_convert(const Frame& F, const In& in, const Ws& w, int it_lo, int it_hi) {
    MK_LAS float* scr = (MK_LAS float*)(F.lds + F.wave * 16640);
    const int gw = F.vcu * NWAVES + F.wave, NGW = F.G * NWAVES;
    for (int it = gw + it_lo; it < it_hi; it += NGW) conv_dispatch(in, w, it / CI_LAYER, it % CI_LAYER, scr, F.lane);
}

__device__ __forceinline__ void phase_mod(const Frame& F, const In& in, const Ws& w) {
    MK_LAS float* sc = (MK_LAS float*)(F.lds + 133120 - 133120);
    MK_LAS float* red = (MK_LAS float*)(F.lds + 32768);
    __syncthreads();
    for (int i = F.tid; i < NB * D; i += NTHR) { const float cv = in.c[i]; sc[i] = cv / (1.0f + __expf(-cv)); }
    __syncthreads();
    for (int item = F.vcu; item < 256; item += F.G) {
        const int l = item >> 7, n0 = (item & 127) * 96;
        const int cq = F.tid % 24, ks = F.tid / 24;
        if (ks < 16) {
            const float* wp = in.w_ada + (size_t)l * D * 6 * D + (size_t)(ks * 128) * 6 * D + n0 + cq * 4;
            f32x4 a0 = {0.f, 0.f, 0.f, 0.f}, a1 = a0, a2 = a0, a3 = a0;
#pragma unroll 8
            for (int k = 0; k < 128; ++k) { const f32x4 wv = *(const f32x4*)(wp + (size_t)k * 6 * D); const int kk = ks * 128 + k;
                a0 += wv * sc[kk]; a1 += wv * sc[D + kk]; a2 += wv * sc[2 * D + kk]; a3 += wv * sc[3 * D + kk]; }
            MK_LAS f32x4* rp = (MK_LAS f32x4*)red + (ks * 24 + cq) * 4;
            rp[0] = a0; rp[1] = a1; rp[2] = a2; rp[3] = a3;
        }
        __syncthreads();
        if (F.tid < 384) {
            const int q = F.tid / 16, bb = (F.tid >> 2) & 3, comp = F.tid & 3;
            float s = 0.f;
#pragma unroll
            for (int k2 = 0; k2 < 16; ++k2) s += red[((k2 * 24 + q) * 4 + bb) * 4 + comp];
            const int n = n0 + q * 4 + comp;
            w.mod[((size_t)l * NB + bb) * 6 * D + n] = s + in.b_ada[l * 6 * D + n];
        }
        __syncthreads();
    }
}

__device__ __forceinline__ void phase_modulate(const Frame& F, const float* __restrict__ x, const float* __restrict__ modl, bf16_t* __restrict__ ub) {
    const int gw = F.vcu * NWAVES + F.wave, NGW = F.G * NWAVES;
    for (int t = gw; t < M; t += NGW) {
        const float* mb = modl + (size_t)(t / S) * 6 * D;
        const float* xr = x + (size_t)t * D;
        bf16_t* ur = ub + (size_t)t * D;
#pragma unroll
        for (int j = 0; j < 8; ++j) { const int col = j * 256 + F.lane * 4;
            const f32x4 xv = *(const f32x4*)(xr + col), sh = *(const f32x4*)(mb + col), scv = *(const f32x4*)(mb + D + col);
            const f32x4 u = xv * (scv + 1.0f) + sh;
            u32x2 o; o.x = cvt_pk_bf16(u[0], u[1]); o.y = cvt_pk_bf16(u[2], u[3]);
            *(u32x2*)(ur + col) = o; }
    }
}

__device__ __forceinline__ int t5_bucket(int n) {
    if (n < 16) return n;
    const float v = logf((float)n / 16.0f) / 2.0794415416798357f * 16.0f;
    const int large = 16 + (int)v;
    return large < 31 ? large : 31;
}
__device__ __forceinline__ float permswap_other(float v) {
    auto rr = __builtin_amdgcn_permlane32_swap(__float_as_uint(v), __float_as_uint(v), false, false);
    return (__lane_id() & 32) ? __uint_as_float(rr[0]) : __uint_as_float(rr[1]);
}

#ifdef MK_BGCONV
constexpr int BG_ITEMS = (MK_BGCONV == 2 ? 2 : 3) * 65536;
#ifndef MK_BGMASK
#define MK_BGMASK 0
#endif
struct BgConv { const float* wg; const float* wu; const float* wd; bf16_t* tgu; bf16_t* td; int next, step, cur, mode; f32x2 p[8]; };
struct BgAddr { const float* src; bf16_t* dst; int N, K; };
__device__ __forceinline__ BgAddr bg_addr(const BgConv& g, int r, int lane) {
    r = __builtin_amdgcn_readfirstlane(r);
    const int mat = r >> 16, e = (r >> 11) & 31, kg = lane & 7, np = lane >> 3;
    BgAddr a;
    if (mat < 2) { const int kb = (r >> 6) & 31, n0 = (r & 63) * 16;
        const unsigned long long m = 0ull - (unsigned long long)(unsigned)mat;
        const float* W = (const float*)(((unsigned long long)g.wg & ~m) | ((unsigned long long)g.wu & m));
        a.N = DE; a.K = D;
        a.src = W + (size_t)e * D * DE + (size_t)(kb * 64 + 8 * kg) * DE + n0 + 2 * np;
        a.dst = g.tgu + (size_t)e * 2048 * D + (size_t)(((n0 >> 7) << 8) + (n0 & 127) + mat * 128 + 2 * np) * D + kb * 64 + 8 * kg;
    } else { const int kb = (r >> 7) & 15, n0 = (r & 127) * 16;
        a.N = D; a.K = DE;
        a.src = g.wd + (size_t)e * DE * D + (size_t)(kb * 64 + 8 * kg) * D + n0 + 2 * np;
        a.dst = g.td + (size_t)e * D * DE + (size_t)(n0 + 2 * np) * DE + kb * 64 + 8 * kg;
    }
    return a;
}
__device__ __forceinline__ void bg_load(BgConv& g, int lane) {
    const bool live = g.next < BG_ITEMS; const int r = live ? g.next : BG_ITEMS - 1;
    const BgAddr a = bg_addr(g, r, lane);
    if (g.mode != 2) {
#pragma unroll
    for (int j = 0; j < 8; ++j) g.p[j] = *(const __attribute__((address_space(1))) f32x2*)(unsigned long long)(a.src + (size_t)j * a.N); }
    g.cur = live ? g.next : -1; if (live) g.next += g.step;
}
__device__ __forceinline__ void bg_store(BgConv& g, int lane) {
    if (g.cur >= 0 && g.mode == 1) {
#pragma unroll
        for (int j = 0; j < 8; ++j) asm volatile("" :: "v"(g.p[j]));
        g.cur = -1; }
    if (g.cur >= 0) { const BgAddr a = bg_addr(g, g.cur, lane);
        u32x4 o0, o1;
        o0.x = cvt_pk_bf16(g.p[0][0], g.p[1][0]); o0.y = cvt_pk_bf16(g.p[2][0], g.p[3][0]); o0.z = cvt_pk_bf16(g.p[4][0], g.p[5][0]); o0.w = cvt_pk_bf16(g.p[6][0], g.p[7][0]);
        o1.x = cvt_pk_bf16(g.p[0][1], g.p[1][1]); o1.y = cvt_pk_bf16(g.p[2][1], g.p[3][1]); o1.z = cvt_pk_bf16(g.p[4][1], g.p[5][1]); o1.w = cvt_pk_bf16(g.p[6][1], g.p[7][1]);
        st16(a.dst, o0); st16(a.dst + a.K, o1); g.cur = -1; }
}
#define BG_PARAM , BgConv& bgc
#define BG_ARG , bgc
#else
#define BG_PARAM
#define BG_ARG
#endif

template <int MODE>
__device__ __forceinline__ void attn_pass(MK_LAS unsigned char* lds, const bf16_t* __restrict__ base  , int qcol, int kcol, int vcol, int qb,
                                          const MK_LAS float* btab, f32x16 (&O)[4], float& lsum BG_PARAM) {
    constexpr int DQK = MODE ? 128 : 64, ND0 = DQK / 16, KSTR = DQK * 2 + 16, VSTR = 320, KBYTES = 64 * KSTR, VBYTES = 64 * VSTR, BUF = KBYTES + VBYTES;
    constexpr int NKP = MODE ? 2 : 1;
    const int tid = ltid(), lane = tid & 63, wid = __builtin_amdgcn_readfirstlane(tid >> 6), r32 = lane & 31, hi = lane >> 5;
    const int q0 = qb * 256, qw0 = q0 + wid * 32, q = qw0 + r32;
    const int nt = 4 * qb + 4;
    bf16x8 qf[ND0];
#pragma unroll
    for (int d0 = 0; d0 < ND0; ++d0) qf[d0] = *(const bf16x8*)(base + (size_t)q * INC + qcol + d0 * 16 + hi * 8);
#pragma unroll
    for (int db = 0; db < 4; ++db)
#pragma unroll
        for (int r = 0; r < 16; ++r) O[db][r] = 0.f;
    float mref = 0.f; lsum = 0.f;
    float carry = 0.f;
    MK_LAS unsigned* flags = (MK_LAS unsigned*)(lds + LDS_FLAGS);
    const int krow = MODE ? (tid >> 4) : (tid >> 3), kch = MODE ? (tid & 15) : (tid & 7);
    const int vrow = tid >> 4, vch = tid & 15;
    const bf16_t* kg = base + (size_t)krow * INC + kcol + kch * 8;
    const bf16_t* vg = base + (size_t)vrow * INC + vcol + vch * 8;
    const unsigned kl = krow * KSTR + kch * 16, vl = KBYTES + vrow * VSTR + vch * 16;
    u32x4 kreg[NKP], vreg[2];
#define AT_GLOAD(j) do { const size_t _ro = (size_t)(j) * 64 * INC; \
        _Pragma("unroll") for (int _i = 0; _i < NKP; ++_i) kreg[_i] = *(const u32x4*)(kg + _ro + (size_t)_i * 32 * INC); \
        _Pragma("unroll") for (int _i = 0; _i < 2; ++_i) vreg[_i] = *(const u32x4*)(vg + _ro + (size_t)_i * 32 * INC); } while (0)
#define AT_LWRITE(bufo) do { \
        _Pragma("unroll") for (int _i = 0; _i < NKP; ++_i) *(MK_LAS u32x4*)(lds + (bufo) + kl + _i * 32 * KSTR) = kreg[_i]; \
        _Pragma("unroll") for (int _i = 0; _i < 2; ++_i) *(MK_LAS u32x4*)(lds + (bufo) + vl + _i * 32 * VSTR) = vreg[_i]; } while (0)
    const unsigned ka = r32 * KSTR + hi * 16;
    const unsigned va = KBYTES + (4 * hi + ((lane & 15) >> 2)) * VSTR + (((lane >> 4) & 1) * 16 + (lane & 3) * 4) * 2;
    { const int j0 = MODE ? nt - 1 : 0; AT_GLOAD(j0); AT_LWRITE(0); }
    __syncthreads();
#ifdef MK_BGCONV
#pragma unroll
    for (int d0 = 0; d0 < ND0; ++d0) asm volatile("" : "+v"(qf[d0]));
#endif
#ifdef MK_BGCONV
#pragma unroll (MODE ? 1 : 2)
#endif
    for (int it = 0; it < nt; ++it) {
        const int j = MODE ? nt - 1 - it : it;
        const unsigned bo = (unsigned)(it & 1) * BUF;
#if defined(MK_BGCONV) && !defined(MK_BGLATE)
        if (MODE == 0 && !(it & MK_BGMASK)) bg_store(bgc, lane);
#endif
        if (it + 1 < nt) { const int jn = MODE ? j - 1 : j + 1; AT_GLOAD(jn); }
#ifdef MK_BGCONV
#ifdef MK_BGSPREAD
        const bool bgact = (MODE == 0) && !(it & MK_BGMASK);
        BgAddr bga; bga.src = nullptr; bga.N = 0;
#define BG_BEGIN() do { if (bgact) { const bool live = bgc.next < BG_ITEMS; const int r = live ? bgc.next : BG_ITEMS - 1; bga = bg_addr(bgc, r, lane); bgc.cur = live ? bgc.next : -1; if (live) bgc.next += bgc.step; } } while (0)
#ifndef MK_BGLATE
        BG_BEGIN();
#endif
#define BG_LD(jj) do { if (bgact) { asm volatile("" :: "v"(bgc.p[jj]));        \
            bgc.p[jj] = *(const __attribute__((address_space(1))) f32x2*)(unsigned long long)(bga.src + (size_t)(jj) * bga.N); } } while (0)
#ifdef MK_BGLATE
#define BG_FENCE() do { if (bgact) __builtin_amdgcn_sched_barrier(0); } while (0)
#else
#define BG_FENCE() __builtin_amdgcn_sched_barrier(0)
#endif
        BG_FENCE();
#else
        if (MODE == 0 && !(it & MK_BGMASK)) bg_load(bgc, lane);
#define BG_LD(jj) do { } while (0)
#define BG_FENCE() do { } while (0)
#endif
#else
#define BG_LD(jj) do { } while (0)
#define BG_FENCE() do { } while (0)
#endif
        const bool skip = MODE ? (64 * j >= qw0 + 32) : (64 * j > qw0 + 31);
        f32x16 sT[2]; bf16x8 pf[2][2];
        if (!skip) {
            const float cinit = MODE ? 0.f : -mref;
#pragma unroll
            for (int kb = 0; kb < 2; ++kb) {
                bf16x8 kf[ND0];
#pragma unroll
                for (int d0 = 0; d0 < ND0; ++d0) kf[d0] = *(const MK_LAS bf16x8*)(lds + bo + ka + kb * 32 * KSTR + d0 * 32);
#pragma unroll
                for (int r = 0; r < 16; ++r) sT[kb][r] = cinit;
                __builtin_amdgcn_sched_barrier(0);
#pragma unroll
                for (int d0 = 0; d0 < ND0; ++d0) sT[kb] = __builtin_amdgcn_mfma_f32_32x32x16_bf16(kf[d0], qf[d0], sT[kb], 0, 0, 0);
            }
        }
#if defined(MK_BGSPREAD) && defined(MK_BGLATE)
        if (bgact) { bg_store(bgc, lane); } BG_BEGIN();
#endif
        BG_FENCE(); BG_LD(0); BG_LD(1); BG_LD(2); BG_FENCE();
        if (!skip) {
            const int kbase = 64 * j + 4 * hi;
            if (MODE == 0) {
                if (j >= 4 * qb - 2) {
#pragma unroll
                    for (int kb = 0; kb < 2; ++kb)
#pragma unroll
                        for (int r = 0; r < 16; ++r) { int rel = q - (kbase + 32 * kb + (r & 3) + 8 * (r >> 2)); rel = rel < 0 ? 0 : (rel > 128 ? 128 : rel); sT[kb][r] += btab[rel]; }
                }
                if (j >= 4 * qb) {
#pragma unroll
                    for (int kb = 0; kb < 2; ++kb)
#pragma unroll
                        for (int r = 0; r < 16; ++r) { const int key = kbase + 32 * kb + (r & 3) + 8 * (r >> 2); if (key > q) sT[kb][r] = -INFINITY; }
                }
                float ma = fmaxf(fmaxf(sT[0][0], sT[0][1]), sT[1][0]), mb = fmaxf(fmaxf(sT[0][2], sT[0][3]), sT[1][1]);
                ma = fmaxf(fmaxf(ma, sT[1][2]), sT[1][3]);
#pragma unroll
                for (int r = 4; r < 16; r += 4) { ma = fmaxf(fmaxf(ma, sT[0][r]), sT[0][r + 1]); mb = fmaxf(fmaxf(mb, sT[0][r + 2]), sT[0][r + 3]);
                    ma = fmaxf(fmaxf(ma, sT[1][r]), sT[1][r + 1]); mb = fmaxf(fmaxf(mb, sT[1][r + 2]), sT[1][r + 3]); }
                float grow = fmaxf(ma, mb);
                grow = fmaxf(grow, permswap_other(grow));
                if (it == 0 || !__all(grow <= 8.0f)) {
                    const float delta = (it == 0) ? grow : fmaxf(grow, 0.f);
                    const float alpha = __builtin_amdgcn_exp2f(-delta);
                    mref += delta; lsum *= alpha;
#pragma unroll
                    for (int kb = 0; kb < 2; ++kb)
#pragma unroll
                        for (int r = 0; r < 16; ++r) sT[kb][r] -= delta;
#pragma unroll
                    for (int db = 0; db < 4; ++db)
#pragma unroll
                        for (int r = 0; r < 16; ++r) O[db][r] *= alpha;
                }
                f32x2 ps2 = {0.f, 0.f};
#pragma unroll
                for (int kb = 0; kb < 2; ++kb)
#pragma unroll
                    for (int r = 0; r < 16; r += 2) { const float p0 = __builtin_amdgcn_exp2f(sT[kb][r]), p1 = __builtin_amdgcn_exp2f(sT[kb][r + 1]); sT[kb][r] = p0; sT[kb][r + 1] = p1; ps2 += (f32x2){p0, p1}; }
                lsum += ps2[0] + ps2[1];
            } else {
                const bool band = (j >= 4 * qb);
                float suf = carry;
#pragma unroll
                for (int kb = 1; kb >= 0; --kb) {
                    float Lr[16], gs[4], pg[4];
#pragma unroll
                    for (int g4 = 0; g4 < 4; ++g4) {
                        float sgrp = 0.f;
#pragma unroll
                        for (int i = 0; i < 4; ++i) { const int r = g4 * 4 + i; const float z = sT[kb][r];
                            float L = -(fmaxf(z, 0.f) + __builtin_amdgcn_logf(1.0f + __builtin_amdgcn_exp2f(-fabsf(z))));
                            if (band) { const int key = kbase + 32 * kb + i + 8 * g4; if (key >= q) L = 0.f; }
                            Lr[r] = L; sgrp += L; }
                        gs[g4] = sgrp;
                    }
#pragma unroll
                    for (int g4 = 0; g4 < 4; ++g4) pg[g4] = permswap_other(gs[g4]);
#pragma unroll
                    for (int g4 = 3; g4 >= 0; --g4) {
                        float cacc = suf + (hi == 0 ? pg[g4] : 0.f);
#pragma unroll
                        for (int i = 3; i >= 0; --i) { const int r = g4 * 4 + i; cacc += Lr[r]; const float z = sT[kb][r];
                            float a = __builtin_amdgcn_exp2f(z + cacc);
                            if (band) { const int key = kbase + 32 * kb + i + 8 * g4; if (key >= q) a = 0.f; }
                            sT[kb][r] = a; }
                        suf += gs[g4] + pg[g4];
                    }
                }
                carry = suf;
            }
#pragma unroll
            for (int kb = 0; kb < 2; ++kb)
#pragma unroll
                for (int s = 0; s < 2; ++s) { u32x4 w; w.x = cvt_pk_bf16(sT[kb][8 * s + 0], sT[kb][8 * s + 1]); w.y = cvt_pk_bf16(sT[kb][8 * s + 2], sT[kb][8 * s + 3]);
                    w.z = cvt_pk_bf16(sT[kb][8 * s + 4], sT[kb][8 * s + 5]); w.w = cvt_pk_bf16(sT[kb][8 * s + 6], sT[kb][8 * s + 7]); pf[kb][s] = __builtin_bit_cast(bf16x8, w); }
        }
        BG_FENCE(); BG_LD(3); BG_LD(4); BG_LD(5); BG_FENCE();
        if (!skip) {
            {
                bf16x8 af[3];
#define AT_VFRAG(m, dst) do { const MK_LAS unsigned char* _vp = lds + bo + va + (32 * (((m) >> 1) & 1) + 16 * ((m) & 1)) * VSTR + ((m) >> 2) * 64; \
                    const s16x4 _a0 = __builtin_bit_cast(s16x4, __builtin_amdgcn_ds_read_tr16_b64_v4i16((MK_LAS s16x4*)_vp)); \
                    const s16x4 _a1 = __builtin_bit_cast(s16x4, __builtin_amdgcn_ds_read_tr16_b64_v4i16((MK_LAS s16x4*)(_vp + 8 * VSTR))); \
                    dst[0] = _a0[0]; dst[1] = _a0[1]; dst[2] = _a0[2]; dst[3] = _a0[3]; dst[4] = _a1[0]; dst[5] = _a1[1]; dst[6] = _a1[2]; dst[7] = _a1[3]; } while (0)
                AT_VFRAG(0, af[0]); AT_VFRAG(1, af[1]);
                __builtin_amdgcn_sched_barrier(0);
#pragma unroll
                for (int m = 0; m < 16; ++m) {
                    if (m + 2 < 16) AT_VFRAG(m + 2, af[(m + 2) % 3]);
                    __builtin_amdgcn_sched_barrier(0);
                    O[m >> 2] = __builtin_amdgcn_mfma_f32_32x32x16_bf16(af[m % 3], pf[(m >> 1) & 1][m & 1], O[m >> 2], 0, 0, 0);
                    __builtin_amdgcn_sched_barrier(0);
                }
#undef AT_VFRAG
            }
        }
        BG_FENCE(); BG_LD(6); BG_LD(7); BG_FENCE();
#undef BG_LD
#undef BG_FENCE
#ifdef BG_BEGIN
#undef BG_BEGIN
#endif
        if (it + 1 < nt) AT_LWRITE((unsigned)((it + 1) & 1) * BUF);
        if (MODE == 1) { const bool dead = __all(carry < -160.0f); if (lane == 0) flags[(it & 1) * 8 + wid] = dead ? 1u : 0u; }
        __syncthreads();
        if (MODE == 1) {
            const u32x4 f0 = *(const MK_LAS u32x4*)(flags + (it & 1) * 8), f1 = *(const MK_LAS u32x4*)(flags + (it & 1) * 8 + 4);
            if ((f0.x & f0.y & f0.z & f0.w & f1.x & f1.y & f1.z & f1.w) != 0u) break;
        }
    }
#ifdef MK_BGCONV
    if (MODE == 0) bg_store(bgc, lane);
#endif
#undef AT_GLOAD
#undef AT_LWRITE
}

__device__ __forceinline__ void attn_unit_diff(const Frame& F, const bf16_t* __restrict__ proj, bf16_t* __restrict__ mixin, int b, int h, int qb,
                                               const float* __restrict__ relb, const float* __restrict__ lamp, float lam_init, const float* __restrict__ subg BG_PARAM) {
    MK_LAS float* btab = (MK_LAS float*)(F.lds + LDS_BTAB);
    MK_LAS float* misc = (MK_LAS float*)(F.lds + LDS_MISC);
    if (F.tid < 264) { const int m = F.tid / 132, i = F.tid % 132;
        float v = 0.f;
        if (i < 128) v = (relb[(t5_bucket(i) * NH + h) * 2 + m] - relb[(31 * NH + h) * 2 + m]) * LOG2E;
        btab[m * 132 + i] = v; }
    if (F.wave == 7) { float a = lamp[F.lane] * lamp[64 + F.lane], c2 = lamp[128 + F.lane] * lamp[192 + F.lane]; a = wave_sum(a); c2 = wave_sum(c2);
        if (F.lane == 0) misc[4] = expf(a) - expf(c2) + lam_init; }
    __syncthreads();
    const float lam = misc[4];
    const bf16_t* base = proj + (size_t)b * S * INC;
    const int hi = F.lane >> 5, r32 = F.lane & 31;
    f32x16 O[4]; float ls;
    MK_LAS u32x4* stash = (MK_LAS u32x4*)(F.lds + 59392) + F.tid;
    attn_pass<0>(F.lds, base, (2 * h) * 64, 1024 + (2 * h) * 64, 2048 + h * 128, qb, btab, O, ls BG_ARG);
    { const float inv = 1.0f / (ls + permswap_other(ls));
#pragma unroll
        for (int db = 0; db < 4; ++db)
#pragma unroll
            for (int r = 0; r < 16; r += 8) { u32x4 pk;
                pk.x = cvt_pk_bf16(O[db][r] * inv, O[db][r + 1] * inv); pk.y = cvt_pk_bf16(O[db][r + 2] * inv, O[db][r + 3] * inv);
                pk.z = cvt_pk_bf16(O[db][r + 4] * inv, O[db][r + 5] * inv); pk.w = cvt_pk_bf16(O[db][r + 6] * inv, O[db][r + 7] * inv);
                stash[(db * 2 + (r >> 3)) * NTHR] = pk; } }
    attn_pass<0>(F.lds, base, (2 * h + 1) * 64, 1024 + (2 * h + 1) * 64, 2048 + h * 128, qb, btab + 132, O, ls BG_ARG);
    const float inv1 = lam / (ls + permswap_other(ls));
    float ss = 0.f;
#pragma unroll
    for (int db = 0; db < 4; ++db)
#pragma unroll
        for (int r8 = 0; r8 < 16; r8 += 8) { const u32x4 pk = stash[(db * 2 + (r8 >> 3)) * NTHR];
#pragma unroll
            for (int i = 0; i < 4; ++i) { const unsigned w = pk[i]; const int r = r8 + 2 * i;
                const float oa = bf16_lo(w) - O[db][r] * inv1, ob = bf16_hi(w) - O[db][r + 1] * inv1;
                O[db][r] = oa; O[db][r + 1] = ob; ss += oa * oa + ob * ob; } }
    ss += permswap_other(ss);
    const float rn = rsqrtf(ss * (1.0f / 128.0f) + SUBLN_EPS) * (1.0f - lam_init);
    const int q = qb * 256 + F.wave * 32 + r32;
    bf16_t* orow = mixin + (size_t)(b * S + q) * D + h * 128;
#pragma unroll
    for (int db = 0; db < 4; ++db)
#pragma unroll
        for (int g4 = 0; g4 < 4; ++g4) { const int d0 = 32 * db + 8 * g4 + 4 * hi; const f32x4 gv = *(const f32x4*)(subg + d0);
            u32x2 o; o.x = cvt_pk_bf16(O[db][4 * g4] * rn * gv[0], O[db][4 * g4 + 1] * rn * gv[1]); o.y = cvt_pk_bf16(O[db][4 * g4 + 2] * rn * gv[2], O[db][4 * g4 + 3] * rn * gv[3]);
            *(u32x2*)(orow + d0) = o; }
}
__device__ __forceinline__ void attn_unit_sb(const Frame& F, const bf16_t* __restrict__ proj, bf16_t* __restrict__ mixin, int b, int h, int qb) {
    const bf16_t* base = proj + (size_t)b * S * INC;
    const int hi = F.lane >> 5, r32 = F.lane & 31;
    f32x16 O[4]; float ls;
#ifdef MK_BGCONV
    BgConv bgc; bgc.next = BG_ITEMS; bgc.cur = -1; bgc.step = 0; bgc.mode = 0;
#pragma unroll
    for (int j = 0; j < 8; ++j) bgc.p[j] = (f32x2){0.f, 0.f};
#endif
    attn_pass<1>(F.lds, base, 3072 + h * 128, 4096 + h * 128, 5120 + h * 128, qb, nullptr, O, ls BG_ARG);
    const int q = qb * 256 + F.wave * 32 + r32;
    bf16_t* orow = mixin + (size_t)(b * S + q) * D + 1024 + h * 128;
#pragma unroll
    for (int db = 0; db < 4; ++db)
#pragma unroll
        for (int g4 = 0; g4 < 4; ++g4) { const int d0 = 32 * db + 8 * g4 + 4 * hi;
            u32x2 o; o.x = cvt_pk_bf16(O[db][4 * g4], O[db][4 * g4 + 1]); o.y = cvt_pk_bf16(O[db][4 * g4 + 2], O[db][4 * g4 + 3]);
            *(u32x2*)(orow + d0) = o; }
}
__device__ __forceinline__ void phase_attention(const Frame& F, const In& in, const Ws& w, int l, int mask = 3) {
    const float lam_init = 0.8f - 0.6f * expf(-0.3f * (float)l);
#ifdef MK_BGCONV
    BgConv bgc; bgc.wg = in.w_gate + (size_t)l * NE * D * DE; bgc.wu = in.w_up + (size_t)l * NE * D * DE; bgc.wd = in.w_down + (size_t)l * NE * DE * D;
    bgc.tgu = w.wt_gu + (size_t)l * NE * 2048 * D; bgc.td = w.wt_d + (size_t)l * NE * D * DE;
    bgc.next = ((mask & 1) && !(mask & 4)) ? (int)blockIdx.x * NWAVES + F.wave : BG_ITEMS; bgc.step = F.G * NWAVES; bgc.cur = -1; bgc.mode = mask >> 4;
#pragma unroll
    for (int j = 0; j < 8; ++j) bgc.p[j] = (f32x2){0.f, 0.f};
#endif
    for (int it = F.vcu; it < 512; it += F.G) {
        const int sb = it >> 8, i = it & 255, bh = i >> 3, pr = i & 7, b = bh >> 3, h = bh & 7;
        if (!((mask >> sb) & 1)) continue;
        if (!sb) {
            attn_unit_diff(F, w.proj, w.mixin, b, h, 15 - pr, in.relb, in.lam + l * 256, lam_init, in.subg + l * 128 BG_ARG);
            attn_unit_diff(F, w.proj, w.mixin, b, h, pr, in.relb, in.lam + l * 256, lam_init, in.subg + l * 128 BG_ARG);
        } else {
            attn_unit_sb(F, w.proj, w.mixin, b, h, 15 - pr);
            attn_unit_sb(F, w.proj, w.mixin, b, h, pr);
        }
    }
#ifdef MK_BGCONV
    while (bgc.next < BG_ITEMS) { bg_load(bgc, F.lane); bg_store(bgc, F.lane); }
#endif
}

#define ROWF4(base, j) ((f32x4*)((char*)(base) + (((j) < 4) ? of0 : of1) + ((j) & 3) * 1024))
#define ROWH4(base, j) ((u32x2*)((char*)(base) + oh0 + (j) * 512))
__device__ __forceinline__ void phase_router_t(const Frame& F, const In& in, const Ws& w) {
    const int gt = F.vcu * NTHR + F.tid, NGT = F.G * NTHR;
    for (int i = gt; i < DEPTH * 48 * D; i += NGT) { const int l = i / (48 * D), r = i % (48 * D), n = r / D, k = r % D;
        const float v = n < 4 ? in.w_group[((size_t)l * D + k) * 4 + n] : (n < 36 ? in.w_router[((size_t)l * D + k) * 32 + (n - 4)] : 0.f);
        const unsigned hi = cvt_pk_bf16(v, 0.f) & 0xffffu; const float lo = v - __uint_as_float(hi << 16);
        w.wt_rh[i] = (bf16_t)hi; w.wt_rl[i] = (bf16_t)(cvt_pk_bf16(lo, 0.f) & 0xffffu); }
}
__device__ __forceinline__ void phase_ln1_route(const Frame& F, const In& in, const Ws& w, int l) {
    const float* modl = w.mod + (size_t)l * NB * 6 * D;
    const float* lng = in.ln_g + (size_t)(l * 2) * D; const float* lnb = in.ln_b + (size_t)(l * 2) * D;
    const float* xin = l == 0 ? in.x : w.xa;
    const bf16_t* wh = w.wt_rh + (size_t)l * 48 * D; const bf16_t* wlo = w.wt_rl + (size_t)l * 48 * D;
    const float* bg = in.b_group + l * 4; const float* br = in.b_router + l * 32;
#ifdef MK_XCNT
    int* cnt = (int*)(w.ctl + CTL_CNT) + l * 256;
#else
    int* cnt = (int*)(w.ctl + CTL_CNT) + l * 32;
#endif
    MK_LAS float* lg = (MK_LAS float*)F.lds;
    MK_LAS float* part = (MK_LAS float*)(F.lds + 16384);
    for (int pass = F.vcu; pass < M / 64; pass += F.G) {
        const int t0 = pass * 64;
#ifdef MK_LNPAR
        { const float* mbp = modl + (size_t)(t0 / S) * 6 * D; MK_LAS f32x4* pl = (MK_LAS f32x4*)(F.lds + 40960);
          __syncthreads();
          pl[F.tid] = *(const f32x4*)(mbp + 2 * D + F.tid * 4); pl[512 + F.tid] = *(const f32x4*)(lng + F.tid * 4); pl[1024 + F.tid] = *(const f32x4*)(lnb + F.tid * 4);
          pl[1536 + F.tid] = *(const f32x4*)(mbp + 3 * D + F.tid * 4); pl[2048 + F.tid] = *(const f32x4*)(mbp + 4 * D + F.tid * 4);
          __syncthreads(); }
#define PARL(k, j) (*(const MK_LAS f32x4*)(F.lds + 40960 + (k) * 8192 + F.lane * 16 + (j) * 1024))
#endif
        {
            const int tw = t0 + F.wave * 8;
            const float* mb = modl + (size_t)(tw / S) * 6 * D;
            const unsigned of0 = (unsigned)F.lane * 16u, of1 = of0 + 4096u, oh0 = (unsigned)F.lane * 8u;
            f32x4 xv[8]; u32x2 mv[8];
#ifdef MK_BF16RES
            u32x2 xh[8];
            const bf16_t* xinh = (const bf16_t*)w.xa;
#define LN1_LOADX(t_) do { if (l == 0) { const float* xr = xin + (size_t)(t_) * D; _Pragma("unroll") for (int j = 0; j < 8; ++j) xv[j] = *ROWF4(xr, j); } \
                           else { const bf16_t* xr = xinh + (size_t)(t_) * D; _Pragma("unroll") for (int j = 0; j < 8; ++j) xh[j] = *ROWH4(xr, j); } } while (0)
#define LN1_X(j) (l == 0 ? xv[j] : (f32x4){bf16_lo(xh[j].x), bf16_hi(xh[j].x), bf16_lo(xh[j].y), bf16_hi(xh[j].y)})
#else
#define LN1_LOADX(t_) do { const float* xr = xin + (size_t)(t_) * D; _Pragma("unroll") for (int j = 0; j < 8; ++j) xv[j] = *ROWF4(xr, j); } while (0)
#define LN1_X(j) xv[j]
#endif
            { const bf16_t* mr = w.mixb + (size_t)tw * D; LN1_LOADX(tw);
#pragma unroll
              for (int j = 0; j < 8; ++j) { mv[j] = *ROWH4(mr, j); } }
#pragma unroll 1
            for (int i = 0; i < 8; ++i) {
                const int t = tw + i;
                f32x4 v[8]; float s = 0.f;
#pragma unroll
#ifdef MK_LNPAR
                for (int j = 0; j < 8; ++j) { const f32x4 g1 = PARL(0, j) + 1.0f;
#else
                for (int j = 0; j < 8; ++j) { const f32x4 g1 = *ROWF4(mb + 2 * D, j) + 1.0f;
#endif
                    f32x4 mx; mx[0] = bf16_lo(mv[j].x); mx[1] = bf16_hi(mv[j].x); mx[2] = bf16_lo(mv[j].y); mx[3] = bf16_hi(mv[j].y);
                    v[j] = LN1_X(j) * ALPHA + g1 * mx; s += (v[j][0] + v[j][1]) + (v[j][2] + v[j][3]); }
                if (i < 7) {
                    const bf16_t* mr = w.mixb + (size_t)(t + 1) * D; LN1_LOADX(t + 1);
#pragma unroll
                    for (int j = 0; j < 8; ++j) { mv[j] = *ROWH4(mr, j); }
                }
                const float mu = wave_sum(s) * (1.0f / D);
                float s2 = 0.f;
#pragma unroll
                for (int j = 0; j < 8; ++j) { v[j] = v[j] - mu; s2 += (v[j][0] * v[j][0] + v[j][1] * v[j][1]) + (v[j][2] * v[j][2] + v[j][3] * v[j][3]); }
                const float rs = rsqrtf(wave_sum(s2) * (1.0f / D) + LN_EPS);
                float* x1r = w.x1 + (size_t)t * D; bf16_t* abr = w.ab + (size_t)t * D; bf16_t* alr = w.ablo + (size_t)t * D;
#pragma unroll
                for (int j = 0; j < 8; ++j) {
#ifdef MK_LNPAR
                    const f32x4 gg = PARL(1, j), bb = PARL(2, j);
#else
                    const f32x4 gg = *ROWF4(lng, j), bb = *ROWF4(lnb, j);
#endif
                    const f32x4 xo = v[j] * rs * gg + bb;
#ifdef MK_BF16RES
                    { u32x2 xp; xp.x = cvt_pk_bf16(xo[0], xo[1]); xp.y = cvt_pk_bf16(xo[2], xo[3]); *ROWH4((bf16_t*)w.x1 + (size_t)t * D, j) = xp; }
#else
                    *ROWF4(x1r, j) = xo;
#endif
#ifdef MK_LNPAR
                    const f32x4 sh = PARL(3, j), scv = PARL(4, j);
#else
                    const f32x4 sh = *ROWF4(mb + 3 * D, j), scv = *ROWF4(mb + 4 * D, j);
#endif
                    const f32x4 u = xo * (scv + 1.0f) + sh;
                    u32x2 o; o.x = cvt_pk_bf16(u[0], u[1]); o.y = cvt_pk_bf16(u[2], u[3]);
                    *ROWH4(abr, j) = o;
                    u32x2 ol; ol.x = cvt_pk_bf16(u[0] - bf16_lo(o.x), u[1] - bf16_hi(o.x)); ol.y = cvt_pk_bf16(u[2] - bf16_lo(o.y), u[3] - bf16_hi(o.y));
                    *ROWH4(alr, j) = ol; }
            }
        }
#undef LN1_LOADX
#undef LN1_X
        asm volatile("s_waitcnt vmcnt(0)" ::: "memory");
        __syncthreads();
#ifdef MK_ROUTK
        {
            const int fr = F.lane & 15, fq = F.lane >> 4, kbase = F.wave * 256 + fq * 8;
            const bf16_t* ah = w.ab + (size_t)(t0 + fr) * D + kbase;
            const bf16_t* al = w.ablo + (size_t)(t0 + fr) * D + kbase;
            const bf16_t* bh = wh + (size_t)fr * D + kbase;
            const bf16_t* bl = wlo + (size_t)fr * D + kbase;
            f32x4 acc[4][3];
#pragma unroll
            for (int rt = 0; rt < 4; ++rt)
#pragma unroll
                for (int nt = 0; nt < 3; ++nt) acc[rt][nt] = (f32x4){0.f, 0.f, 0.f, 0.f};
#pragma unroll 4
            for (int sidx = 0; sidx < 8; ++sidx) {
                bf16x8 fbh[3], fbl[3];
#pragma unroll
                for (int nt = 0; nt < 3; ++nt) { fbh[nt] = *(const bf16x8*)(bh + (size_t)nt * 16 * D + sidx * 32); fbl[nt] = *(const bf16x8*)(bl + (size_t)nt * 16 * D + sidx * 32); }
#pragma unroll
                for (int rt = 0; rt < 4; ++rt) { const bf16x8 fah = *(const bf16x8*)(ah + (size_t)rt * 16 * D + sidx * 32), fal = *(const bf16x8*)(al + (size_t)rt * 16 * D + sidx * 32);
#pragma unroll
                    for (int nt = 0; nt < 3; ++nt) {
                        acc[rt][nt] = __builtin_amdgcn_mfma_f32_16x16x32_bf16(fah, fbh[nt], acc[rt][nt], 0, 0, 0);
                        acc[rt][nt] = __builtin_amdgcn_mfma_f32_16x16x32_bf16(fah, fbl[nt], acc[rt][nt], 0, 0, 0);
                        acc[rt][nt] = __builtin_amdgcn_mfma_f32_16x16x32_bf16(fal, fbh[nt], acc[rt][nt], 0, 0, 0); } }
            }
            MK_LAS f32x4* red = (MK_LAS f32x4*)(F.lds + 16384);
#pragma unroll
            for (int rt = 0; rt < 4; ++rt)
#pragma unroll
                for (int nt = 0; nt < 3; ++nt) red[(F.wave * 12 + rt * 3 + nt) * 64 + F.lane] = acc[rt][nt];
            __syncthreads();
            for (int idx = F.tid; idx < 768; idx += NTHR) { const int tile = idx >> 6, ln = idx & 63, rt = tile / 3, nt = tile - rt * 3, lfr = ln & 15, lfq = ln >> 4;
                f32x4 o = red[tile * 64 + ln];
#pragma unroll
                for (int wv = 1; wv < 8; ++wv) o += red[(wv * 12 + tile) * 64 + ln];
#pragma unroll
                for (int r = 0; r < 4; ++r) lg[(rt * 16 + lfq * 4 + r) * 49 + nt * 16 + lfr] = o[r]; }
            __syncthreads();
        }
#else
        {
            const int rt = F.wave & 3, kh = F.wave >> 2, fr = F.lane & 15, fq = F.lane >> 4;
            const bf16_t* ah = w.ab + (size_t)(t0 + rt * 16 + fr) * D + kh * 1024 + fq * 8;
            const bf16_t* al = w.ablo + (size_t)(t0 + rt * 16 + fr) * D + kh * 1024 + fq * 8;
            const bf16_t* bh = wh + (size_t)fr * D + kh * 1024 + fq * 8;
            const bf16_t* bl = wlo + (size_t)fr * D + kh * 1024 + fq * 8;
            f32x4 acc[3];
#pragma unroll
            for (int nt = 0; nt < 3; ++nt) acc[nt] = (f32x4){0.f, 0.f, 0.f, 0.f};
#pragma unroll 4
            for (int sidx = 0; sidx < 32; ++sidx) {
                const bf16x8 fah = *(const bf16x8*)(ah + sidx * 32), fal = *(const bf16x8*)(al + sidx * 32);
#pragma unroll
                for (int nt = 0; nt < 3; ++nt) { const bf16x8 fbh = *(const bf16x8*)(bh + (size_t)nt * 16 * D + sidx * 32), fbl = *(const bf16x8*)(bl + (size_t)nt * 16 * D + sidx * 32);
                    acc[nt] = __builtin_amdgcn_mfma_f32_16x16x32_bf16(fah, fbh, acc[nt], 0, 0, 0);
                    acc[nt] = __builtin_amdgcn_mfma_f32_16x16x32_bf16(fah, fbl, acc[nt], 0, 0, 0);
                    acc[nt] = __builtin_amdgcn_mfma_f32_16x16x32_bf16(fal, fbh, acc[nt], 0, 0, 0); }
            }
            if (kh == 1) {
#pragma unroll
                for (int nt = 0; nt < 3; ++nt) *(MK_LAS f32x4*)(part + ((rt * 3 + nt) * 64 + F.lane) * 4) = acc[nt];
            }
            __syncthreads();
            if (kh == 0) {
#pragma unroll
                for (int nt = 0; nt < 3; ++nt) { const f32x4 o = acc[nt] + *(const MK_LAS f32x4*)(part + ((rt * 3 + nt) * 64 + F.lane) * 4);
#pragma unroll
                    for (int r = 0; r < 4; ++r) lg[(rt * 16 + fq * 4 + r) * 49 + nt * 16 + fr] = o[r]; }
            }
            __syncthreads();
        }
#endif
        if (F.tid < 64) {
            const int t = t0 + F.tid; const MK_LAS float* lr = lg + F.tid * 49;
            float gl[4]; int gi = 0;
#pragma unroll
            for (int i = 0; i < 4; ++i) gl[i] = lr[i] + bg[i];
            float gm = gl[0];
#pragma unroll
            for (int i = 1; i < 4; ++i) if (gl[i] > gm) { gm = gl[i]; gi = i; }
            float gsum = 0.f;
#pragma unroll
            for (int i = 0; i < 4; ++i) gsum += expf(gl[i] - gm);
            const float gp = 1.0f / gsum;
            float el[8];
#pragma unroll
            for (int j = 0; j < 8; ++j) el[j] = lr[4 + gi * 8 + j] + br[gi * 8 + j];
            int i0 = 0; float v0 = el[0];
#pragma unroll
            for (int j = 1; j < 8; ++j) if (el[j] > v0) { v0 = el[j]; i0 = j; }
            int i1 = 0; float v1 = -INFINITY;
#pragma unroll
            for (int j = 0; j < 8; ++j) if (j != i0 && el[j] > v1) { v1 = el[j]; i1 = j; }
            const float e1 = expf(v1 - v0);
            const float w0 = gp / (1.0f + e1), w1 = gp * e1 / (1.0f + e1);
            const int ea = gi * 8 + i0, eb = gi * 8 + i1;
#ifdef MK_RANKAGG
            MK_LAS int* hist = (MK_LAS int*)(F.lds + 32768);
            if (F.tid < 32) hist[F.tid] = 0;
            asm volatile("s_waitcnt lgkmcnt(0)" ::: "memory"); __builtin_amdgcn_wave_barrier();
            const int la = __atomic_fetch_add(hist + ea, 1, __ATOMIC_RELAXED), lb = __atomic_fetch_add(hist + eb, 1, __ATOMIC_RELAXED);
            asm volatile("s_waitcnt lgkmcnt(0)" ::: "memory"); __builtin_amdgcn_wave_barrier();
#ifdef MK_XCNT
            if (F.tid < 32) { const int c = hist[F.tid]; hist[32 + F.tid] = c ? atomicAdd(&cnt[(t0 >> 11) * 32 + F.tid], c) : 0; }
#else
            if (F.tid < 32) { const int c = hist[F.tid]; hist[32 + F.tid] = c ? atomicAdd(&cnt[F.tid], c) : 0; }
#endif
            asm volatile("s_waitcnt vmcnt(0) lgkmcnt(0)" ::: "memory"); __builtin_amdgcn_wave_barrier();
            const int ra = hist[32 + ea] + la, rb = hist[32 + eb] + lb;
#else
            const int ra = atomicAdd(&cnt[ea], 1), rb = atomicAdd(&cnt[eb], 1);
#endif
#ifdef MK_XCNT
            w.tok_of[(ea * 8 + (t >> 11)) * 2048 + ra] = t; w.tok_of[(eb * 8 + (t >> 11)) * 2048 + rb] = t;
#else
            w.tok_of[ea * M + ra] = t; w.tok_of[eb * M + rb] = t;
#endif
            *(int4*)(w.tokinfo + 4 * t) = make_int4(ea, ra, eb, rb);
            *(float2*)(w.tokw + 2 * t) = make_float2(w0, w1);
        }
        __syncthreads();
    }
}

__device__ __forceinline__ void moe_tables(const Frame& F, const Ws& w, int l) {
    MK_LAS int* pexp = (MK_LAS int*)(F.lds + LDS_PEXP);
    MK_LAS int* pbase = (MK_LAS int*)(F.lds + LDS_PBASE);
    MK_LAS int* cl = (MK_LAS int*)(F.lds + LDS_CNT);
#ifdef MK_XCNT
    const int* cnt = (const int*)(w.ctl + CTL_CNT) + l * 256;
    MK_LAS unsigned short* xoff = (MK_LAS unsigned short*)(F.lds + LDS_XOFF);
    __syncthreads();
    if (F.tid < 32) { int cx[8];
#pragma unroll
        for (int x = 0; x < 8; ++x) cx[x] = cnt[x * 32 + F.tid];
        int p = 0;
#pragma unroll
        for (int x = 0; x < 8; ++x) { xoff[F.tid * 8 + x] = (unsigned short)p; p += cx[x]; }
        cl[F.tid] = p; }
#else
    const int* cnt = (const int*)(w.ctl + CTL_CNT) + l * 32;
    __syncthreads();
    if (F.tid < 32) cl[F.tid] = cnt[F.tid];
#endif
    __syncthreads();
    if (F.tid == 0) { int p = 0; for (int e = 0; e < NE; ++e) { pbase[e] = p; const int np = (cl[e] + 255) >> 8; for (int i = 0; i < np; ++i) pexp[p + i] = e; p += np; } pbase[NE] = p; }
    __syncthreads();
}
template <class Sched>
__device__ __forceinline__ void moe_gather_table(const Frame& F, const Ws& w, const Sched& Sc) {
    MK_LAS int* tokl = (MK_LAS int*)(F.lds + LDS_TOKL);
    const MK_LAS int* pbase = (const MK_LAS int*)(F.lds + LDS_PBASE);
    const MK_LAS int* cl = (const MK_LAS int*)(F.lds + LDS_CNT);
    for (int i = 0; i < MAXU; ++i) { Unit u; if (!Sc.next(i, u)) break;
        if (F.tid < 256) { const int e = u.e; int rank = (u.pm - pbase[e]) * 256 + F.tid; const int ce = cl[e]; rank = rank < ce ? rank : ce - 1;
#ifdef MK_XCNT
            const MK_LAS unsigned short* xo = (const MK_LAS unsigned short*)(F.lds + LDS_XOFF) + e * 8;
            int x = 0;
#pragma unroll
            for (int k = 1; k < 8; ++k) x += (rank >= (int)xo[k]) ? 1 : 0;
            tokl[i * 256 + F.tid] = w.tok_of[(e * 8 + x) * 2048 + rank - (int)xo[x]]; } }
#else
            tokl[i * 256 + F.tid] = w.tok_of[e * M + rank]; } }
#endif
    __syncthreads();
}

__device__ __forceinline__ void phase_ln2(const Frame& F, const In& in, const Ws& w, int l, float* __restrict__ xout, const float* __restrict__ nmod) {
    const float* modl = w.mod + (size_t)l * NB * 6 * D;
    const float* lng = in.ln_g + (size_t)(l * 2 + 1) * D; const float* lnb = in.ln_b + (size_t)(l * 2 + 1) * D;
    const MK_LAS int* pbase = (const MK_LAS int*)(F.lds + LDS_PBASE);
    const int gw = F.vcu * NWAVES + F.wave, NGW = F.G * NWAVES;
    const unsigned of0 = (unsigned)F.lane * 16u, of1 = of0 + 4096u, oh0 = (unsigned)F.lane * 8u;
    for (int tb = gw * 8; tb < M; tb += NGW * 8) {
        const int bidx = tb / S;
        const float* mb = modl + (size_t)bidx * 6 * D;
#ifdef MK_LNPAR
        { MK_LAS f32x4* pl = (MK_LAS f32x4*)(F.lds + 40960);
          __syncthreads();
          pl[F.tid] = *(const f32x4*)(mb + 5 * D + F.tid * 4); pl[512 + F.tid] = *(const f32x4*)(lng + F.tid * 4); pl[1024 + F.tid] = *(const f32x4*)(lnb + F.tid * 4);
          if (nmod) { const float* nbp = nmod + (size_t)bidx * 6 * D; pl[1536 + F.tid] = *(const f32x4*)(nbp + F.tid * 4); pl[2048 + F.tid] = *(const f32x4*)(nbp + D + F.tid * 4); }
          __syncthreads(); }
#ifndef PARL
#define PARL(k, j) (*(const MK_LAS f32x4*)(F.lds + 40960 + (k) * 8192 + F.lane * 16 + (j) * 1024))
#endif
#endif
#ifdef MK_BF16RES
        u32x2 xv[8], ya[8], yb[8]; float2 tw, tw_n;
#define LN2_LOADX(_xr, j) xv[j] = *ROWH4((const bf16_t*)w.x1 + (size_t)(_xr) * D, j)
#define LN2_X(j) ((f32x4){bf16_lo(xv[j].x), bf16_hi(xv[j].x), bf16_lo(xv[j].y), bf16_hi(xv[j].y)})
#else
        f32x4 xv[8]; u32x2 ya[8], yb[8]; float2 tw, tw_n;
#define LN2_LOADX(_xr, j) xv[j] = *ROWF4(w.x1 + (size_t)(_xr) * D, j)
#define LN2_X(j) xv[j]
#endif
#ifdef MK_XCNT
#define LN2_XOFF(e_, t_) ((int)((const MK_LAS unsigned short*)(F.lds + LDS_XOFF))[(e_) * 8 + ((t_) >> 11)])
#else
#define LN2_XOFF(e_, t_) 0
#endif
#define LN2_FETCH(t) do { const int4 _ti = *(const int4*)(w.tokinfo + 4 * (t)); tw_n = *(const float2*)(w.tokw + 2 * (t)); \
            const int _r0 = __builtin_amdgcn_readfirstlane(pbase[_ti.x] * 256 + _ti.y + LN2_XOFF(_ti.x, t)), _r1 = __builtin_amdgcn_readfirstlane(pbase[_ti.z] * 256 + _ti.w + LN2_XOFF(_ti.z, t)); \
            const bf16_t* _y0 = w.Yb + (size_t)_r0 * D; const bf16_t* _y1 = w.Yb + (size_t)_r1 * D; \
            _Pragma("unroll") for (int j = 0; j < 8; ++j) { LN2_LOADX(t, j); ya[j] = *ROWH4(_y0, j); yb[j] = *ROWH4(_y1, j); } } while (0)
        LN2_FETCH(tb); tw = tw_n;
#pragma unroll 1
        for (int i = 0; i < 8; ++i) {
            const int t = tb + i;
            f32x4 v[8]; float s = 0.f;
#pragma unroll
            for (int j = 0; j < 8; ++j) {
                const u32x2 a = ya[j], c2 = yb[j];
                f32x4 y; y[0] = tw.x * bf16_lo(a.x) + tw.y * bf16_lo(c2.x); y[1] = tw.x * bf16_hi(a.x) + tw.y * bf16_hi(c2.x);
                y[2] = tw.x * bf16_lo(a.y) + tw.y * bf16_lo(c2.y); y[3] = tw.x * bf16_hi(a.y) + tw.y * bf16_hi(c2.y);
#ifdef MK_LNPAR
                const f32x4 g2 = PARL(0, j) + 1.0f;
#else
                const f32x4 g2 = *ROWF4(mb + 5 * D, j) + 1.0f;
#endif
                v[j] = LN2_X(j) * ALPHA + g2 * y;
                s += (v[j][0] + v[j][1]) + (v[j][2] + v[j][3]); }
            if (i < 7) { LN2_FETCH(t + 1); }
            const float mu = wave_sum(s) * (1.0f / D);
            float s2 = 0.f;
#pragma unroll
            for (int j = 0; j < 8; ++j) { v[j] = v[j] - mu; s2 += (v[j][0] * v[j][0] + v[j][1] * v[j][1]) + (v[j][2] * v[j][2] + v[j][3] * v[j][3]); }
            const float rs = rsqrtf(wave_sum(s2) * (1.0f / D) + LN_EPS);
            float* xor_ = xout + (size_t)t * D; bf16_t* abr = w.ab + (size_t)t * D;
#pragma unroll
            for (int j = 0; j < 8; ++j) {
#ifdef MK_LNPAR
                const f32x4 gg = PARL(1, j), bb = PARL(2, j);
#else
                const f32x4 gg = *ROWF4(lng, j), bb = *ROWF4(lnb, j);
#endif
                const f32x4 xo = v[j] * rs * gg + bb;
#ifdef MK_BF16RES
                if (nmod) { u32x2 xp; xp.x = cvt_pk_bf16(xo[0], xo[1]); xp.y = cvt_pk_bf16(xo[2], xo[3]); *ROWH4((bf16_t*)xout + (size_t)t * D, j) = xp; }
                else *ROWF4(xor_, j) = xo;
#else
                *ROWF4(xor_, j) = xo;
#endif
#ifdef MK_LNPAR
                if (nmod) { const f32x4 sh = PARL(3, j), scv = PARL(4, j);
#else
                if (nmod) { const float* nb = nmod + (size_t)bidx * 6 * D; const f32x4 sh = *ROWF4(nb, j), scv = *ROWF4(nb + D, j);
#endif
                    const f32x4 u = xo * (scv + 1.0f) + sh; u32x2 o; o.x = cvt_pk_bf16(u[0], u[1]); o.y = cvt_pk_bf16(u[2], u[3]); *ROWH4(abr, j) = o; }
            }
            tw = tw_n;
        }
#undef LN2_FETCH
#undef LN2_XOFF
#undef LN2_LOADX
#undef LN2_X
    }
}
struct Args { In in; Ws w; float* out; int l, cv_lo, cv_hi, pad; };

__device__ __forceinline__ Frame make_frame(unsigned char* lds_generic) {
    Frame F; F.lds = (MK_LAS unsigned char*)lds_generic;
    F.tid = ltid(); F.lane = F.tid & 63; F.wave = __builtin_amdgcn_readfirstlane(F.tid >> 6);
    F.G = gridDim.x; { const int bx = blockIdx.x; F.vcu = (F.G % 8 == 0) ? (bx % 8) * (F.G / 8) + bx / 8 : bx; }
    return F;
}

#ifdef MK_TABREUSE
#define MOE_TABLES_AGAIN(F_, w_, l_) do { } while (0)
#else
#define MOE_TABLES_AGAIN(F_, w_, l_) moe_tables(F_, w_, l_)
#endif
template <int PH>
__device__ __forceinline__ void run_phase(const Frame& F, const Args& a, int l) {
    const In& in = a.in; const Ws& w = a.w;
    if constexpr (PH == 0) { phase_convert(F, in, w, a.cv_lo, a.cv_hi); phase_mod(F, in, w); phase_router_t(F, in, w); }
    if constexpr (PH == 1) { phase_modulate(F, in.x, w.mod, w.ab); }
    if constexpr (PH == 2) { SchedDense Sd; Sd.init(w.ab, w.wt_in + (size_t)l * INC * D, M, INC, D, F.G, (int)blockIdx.x); EpiProj E{w.proj}; gemm_phase(F.lds, D, Sd, E); }
    if constexpr (PH == 3) { phase_attention(F, in, w, l); }
    if constexpr (PH == 31) { phase_attention(F, in, w, l, 1); }
    if constexpr (PH == 32) { phase_attention(F, in, w, l, 2); }
    if constexpr (PH == 34) { phase_attention(F, in, w, l, 3 | 16); }
    if constexpr (PH == 35) { phase_attention(F, in, w, l, 3 | 32); }
    if constexpr (PH == 33) { phase_attention(F, in, w, l, 7); }
    if constexpr (PH == 4) { SchedDense Sd; Sd.init(w.mixin, w.wt_o + (size_t)l * D * D, M, D, D, F.G, (int)blockIdx.x);
        EpiDown E{w.mixb}; gemm_phase(F.lds, D, Sd, E); }
    if constexpr (PH == 5) { phase_ln1_route(F, in, w, l); }
    if constexpr (PH == 6) { moe_tables(F, w, l);
        SchedMoe<true> Sm; Sm.A = w.ab; Sm.Bt = w.wt_gu + (size_t)l * NE * 2048 * D; Sm.estride = (size_t)2048 * D; Sm.K = D;
        Sm.nunits = ((const MK_LAS int*)(F.lds + LDS_PBASE))[NE] * 8; Sm.G = F.G; Sm.c = (int)blockIdx.x;
        Sm.pexp = (const MK_LAS int*)(F.lds + LDS_PEXP); Sm.tokl = (const MK_LAS int*)(F.lds + LDS_TOKL);
        moe_gather_table(F, w, Sm);
#ifdef MK_F32B_UP
        BSrcUp Bu{in.w_gate + (size_t)l * NE * D * DE, in.w_up + (size_t)l * NE * D * DE, (size_t)D * DE, DE};
        EpiGU E{w.Hb}; gemm_phase_fb(F.lds, D, Sm, Bu, E); }
#else
        EpiGU E{w.Hb}; gemm_phase(F.lds, D, Sm, E); }
#endif
    if constexpr (PH >= 60 && PH <= 69) { moe_tables(F, w, l);
        SchedMoe<true> Sm; Sm.A = w.ab; Sm.Bt = w.wt_gu + (size_t)l * NE * 2048 * D; Sm.estride = (size_t)2048 * D; Sm.K = D;
        Sm.nunits = ((const MK_LAS int*)(F.lds + LDS_PBASE))[NE] * 8; Sm.G = F.G; Sm.c = (int)blockIdx.x;
        Sm.pexp = (const MK_LAS int*)(F.lds + LDS_PEXP); Sm.tokl = (const MK_LAS int*)(F.lds + LDS_TOKL);
        moe_gather_table(F, w, Sm);
        BSrcUp Bu{in.w_gate + (size_t)l * NE * D * DE, in.w_up + (size_t)l * NE * D * DE, (size_t)D * DE, DE};
        EpiGU E{w.wt_gu}; gemm_phase_fb<PH - 60>(F.lds, D, Sm, Bu, E); }
    if constexpr (PH >= 70 && PH <= 79) { moe_tables(F, w, l);
        SchedMoe<false> Sm; Sm.A = w.Hb; Sm.Bt = w.wt_d + (size_t)l * NE * D * DE; Sm.estride = (size_t)D * DE; Sm.K = DE;
        Sm.nunits = ((const MK_LAS int*)(F.lds + LDS_PBASE))[NE] * 8; Sm.G = F.G; Sm.c = (int)blockIdx.x;
        Sm.pexp = (const MK_LAS int*)(F.lds + LDS_PEXP); Sm.tokl = nullptr;
        BSrcDown Bd{in.w_down + (size_t)l * NE * DE * D, (size_t)DE * D, D};
        EpiDown E{w.wt_gu}; gemm_phase_fb<PH - 70>(F.lds, DE, Sm, Bd, E); }
    if constexpr (PH == 7) { MOE_TABLES_AGAIN(F, w, l);
        SchedMoe<false> Sm; Sm.A = w.Hb; Sm.Bt = w.wt_d + (size_t)l * NE * D * DE; Sm.estride = (size_t)D * DE; Sm.K = DE;
        Sm.nunits = ((const MK_LAS int*)(F.lds + LDS_PBASE))[NE] * 8; Sm.G = F.G; Sm.c = (int)blockIdx.x;
        Sm.pexp = (const MK_LAS int*)(F.lds + LDS_PEXP); Sm.tokl = nullptr;
#ifdef MK_F32B_DOWN
        BSrcDown Bd{in.w_down + (size_t)l * NE * DE * D, (size_t)DE * D, D};
        EpiDown E{w.Yb}; gemm_phase_fb(F.lds, DE, Sm, Bd, E); }
#else
        EpiDown E{w.Yb}; gemm_phase(F.lds, DE, Sm, E); }
#endif
    if constexpr (PH == 8) { MOE_TABLES_AGAIN(F, w, l);
        phase_ln2(F, in, w, l, l == DEPTH - 1 ? a.out : w.xa, l == DEPTH - 1 ? nullptr : w.mod + (size_t)(l + 1) * NB * 6 * D); }
}

template <int PH>
__global__ void __launch_bounds__(NTHR, 2) k_phase(Args a) {
    extern __shared__ __attribute__((aligned(16))) unsigned char lds_raw[];
    const Frame F = make_frame(lds_raw);
    run_phase<PH>(F, a, a.l);
}

static inline Ws carve(char* base, size_t& end, int nlw = DEPTH) {
    Ws w; size_t o = 0;
    auto take = [&](size_t bytes) { char* p = base + o; o += (bytes + 255) & ~(size_t)255; return p; };
    w.ctl = (unsigned*)take((size_t)CTL_WORDS * 4);
    w.mod = (float*)take((size_t)DEPTH * NB * 6 * D * 4);
    w.wt_in = (bf16_t*)take((size_t)nlw * INC * D * 2);
    w.wt_o = (bf16_t*)take((size_t)nlw * D * D * 2);
    w.ab = (bf16_t*)take((size_t)M * D * 2);
    w.proj = (bf16_t*)take((size_t)M * INC * 2);
    w.mixin = (bf16_t*)take((size_t)M * D * 2);
    w.mixb = (bf16_t*)take((size_t)M * D * 2);
    w.ablo = (bf16_t*)take((size_t)M * D * 2);
    w.x1 = (float*)take((size_t)M * D * 4);
    w.xa = (float*)take((size_t)M * D * 4);
    w.Hb = (bf16_t*)take((size_t)PROWS * DE * 2);
    w.Yb = (bf16_t*)take((size_t)PROWS * D * 2);
    w.tok_of = (int*)take((size_t)NE * M * 4);
    w.tokinfo = (int*)take((size_t)M * 16);
    w.tokw = (float*)take((size_t)M * 8);
    w.wt_rh = (bf16_t*)take((size_t)DEPTH * 48 * D * 2);
    w.wt_rl = (bf16_t*)take((size_t)DEPTH * 48 * D * 2);
    w.wt_gu = (bf16_t*)take((size_t)nlw * NE * 2048 * D * 2);
    w.wt_d = (bf16_t*)take((size_t)nlw * NE * D * DE * 2);
    end = o; return w;
}
static inline In make_in(void* const* d_in) {
    In in; const float* const* p = (const float* const*)d_in;
    in.x = p[0]; in.c = p[1]; in.w_ada = p[2]; in.b_ada = p[3]; in.w_in = p[4]; in.lam = p[5]; in.subg = p[6]; in.relb = p[7]; in.w_o = p[8]; in.ln_g = p[9]; in.ln_b = p[10];
    in.w_group = p[11]; in.b_group = p[12]; in.w_router = p[13]; in.b_router = p[14]; in.w_gate = p[15]; in.w_up = p[16]; in.w_down = p[17];
    return in;
}
template <int PH>
static inline void launch_phase(const Args& a, int grid, hipStream_t st) {
    static bool attr = false;
    if (!attr) { attr = true; (void)hipFuncSetAttribute((const void*)k_phase<PH>, hipFuncAttributeMaxDynamicSharedMemorySize, LDS_BYTES); }
    hipLaunchKernelGGL(k_phase<PH>, dim3(grid), dim3(NTHR), LDS_BYTES, st, a);
}
}
namespace mk {
typedef const __attribute__((address_space(4))) Args* KArgsPtr;
__device__ __forceinline__ void load_args(Args& a) {
    KArgsPtr p = (KArgsPtr)__builtin_amdgcn_kernarg_segment_ptr();
    asm volatile("" : "+s"(p));
    __builtin_memcpy(&a, p, sizeof(Args));
}
#ifndef MK_REPEAT_PH
#define MK_REPEAT_PH -1
#endif
#define MK_PHASE1(PH, l) do { Args _a; load_args(_a); const Frame _F = make_frame(lds_raw); run_phase<PH>(_F, _a, (l)); } while (0)
#ifndef MK_REPEAT_AS
#define MK_REPEAT_AS MK_REPEAT_PH
#endif
#ifndef MK_REPEAT_N
#define MK_REPEAT_N 1
#endif
#define MK_PHASE(PH, l) do { MK_PHASE1(PH, l); if ((PH) == MK_REPEAT_PH && (l) == 0) { MK_BARRIER(); MK_PHASE1(MK_REPEAT_AS, l); if (MK_REPEAT_N > 1) { MK_BARRIER(); MK_PHASE1(MK_REPEAT_AS, l); } } } while (0)
#define MK_BARRIER() do { Args _a; load_args(_a); XcdBarrier _b; _b.bar = _a.w.ctl; _b.x = xb_xcc_id(); _b.st = (volatile LAS unsigned*)(F.lds + LDS_MISC); xcd_barrier(_b); } while (0)
__global__ void __launch_bounds__(NTHR, 2) k_mega(Args a) {
    extern __shared__ __attribute__((aligned(16))) unsigned char lds_raw[];
    const Frame F = make_frame(lds_raw);
    if (F.tid < 16) ((MK_LAS unsigned*)(F.lds + LDS_MISC))[F.tid] = 0u;
    __syncthreads();
    (void)xcd_barrier_post(a.w.ctl, (volatile LAS unsigned*)(F.lds + LDS_MISC));
    MK_PHASE(0, 0); MK_BARRIER();
    MK_PHASE(1, 0); MK_BARRIER();
#define MK_LAYER(l, last) do { \
        MK_PHASE(2, l); MK_BARRIER(); MK_PHASE(3, l); MK_BARRIER(); MK_PHASE(4, l); MK_BARRIER(); MK_PHASE(5, l); MK_BARRIER(); \
        MK_PHASE(6, l); MK_BARRIER(); MK_PHASE(7, l); MK_BARRIER(); MK_PHASE(8, l); if (!(last)) MK_BARRIER(); } while (0)
    MK_LAYER(0, false);
    MK_LAYER(1, true);
}
}

extern "C" void kernel_launch(void* const* d_in, const int* in_sizes, int n_in, void* d_out, int out_size, void* d_ws, size_t ws_size, hipStream_t stream) {
    static int grid = 0;
    if (grid == 0) {
        int dev = 0, cus = 0, per_cu = 0;
        (void)hipGetDevice(&dev); (void)hipDeviceGetAttribute(&cus, hipDeviceAttributeMultiprocessorCount, dev);
        if (hipFuncSetAttribute((const void*)mk::k_mega, hipFuncAttributeMaxDynamicSharedMemorySize, mk::LDS_BYTES) != hipSuccess) { fprintf(stderr, "kernel_launch: hipFuncSetAttribute failed\n"); grid = -1; return; }
        if (hipOccupancyMaxActiveBlocksPerMultiprocessor(&per_cu, (const void*)mk::k_mega, mk::NTHR, mk::LDS_BYTES) != hipSuccess || per_cu < 1)
            fprintf(stderr, "kernel_launch: occupancy query reports %d workgroups per CU\n", per_cu);
        (void)hipGetLastError();
        grid = cus > 0 ? cus : 256;
    }
    if (grid < 0) return;
    size_t end = 0;
    mk::Ws w = mk::carve((char*)d_ws, end, mk::DEPTH);
    if (end > ws_size) { fprintf(stderr, "kernel_launch: workspace too small: need %zu, have %zu\n", end, ws_size); return; }
    (void)hipMemsetAsync(w.ctl, 0, (size_t)mk::CTL_WORDS * 4, stream);
    mk::Args a; memset(&a, 0, sizeof(a));
    a.in = mk::make_in(d_in); a.w = w; a.out = (float*)d_out; a.l = 0; a.cv_lo = 0; a.cv_hi = mk::DEPTH * mk::CI_LAYER;
#ifdef MK_MULTI
    mk::launch_phase<0>(a, grid, stream); mk::launch_phase<1>(a, grid, stream);
    for (int l = 0; l < mk::DEPTH; ++l) { a.l = l;
        mk::launch_phase<2>(a, grid, stream); mk::launch_phase<3>(a, grid, stream); mk::launch_phase<4>(a, grid, stream); mk::launch_phase<5>(a, grid, stream);
        mk::launch_phase<6>(a, grid, stream); mk::launch_phase<7>(a, grid, stream); mk::launch_phase<8>(a, grid, stream); }
#else
    hipLaunchKernelGGL(mk::k_mega, dim3(grid), dim3(mk::NTHR), mk::LDS_BYTES, stream, a);
#endif
}
```
